# Optimizing an MI355X kernel written in HIP

```python
import jax, jax.numpy as jnp
from jax import lax
import numpy as np


D_MODEL = 1024
BATCH = 8
SEQ = 2048
DEPTH = 2

D_MIX = D_MODEL
ATTN_WIDTH = D_MIX // 2
ATTN_HEAD_DIM = 64
ATTN_HEADS = ATTN_WIDTH // ATTN_HEAD_DIM
DILATED_PATTERNS = ((128, 1), (512, 4), (2048, 16))
ROPE_THETA = 10000.0
MLSTM_WIDTH = D_MIX - ATTN_WIDTH
MLSTM_HEADS = 4
MLSTM_HEAD_DIM = MLSTM_WIDTH // MLSTM_HEADS
MLSTM_CHUNK = 128
MLSTM_CONV = 5
PROJ_COLS = 3 * ATTN_WIDTH + 4 * MLSTM_WIDTH + 4 * MLSTM_HEADS
D_FF = ((8 * D_MODEL // 3 + 255) // 256) * 256
FFN_CONV = 3
NORM_EPS = 1e-6
NEG_INF = -1e30

kernel_name = 'hybrid_dilated_attn_mlstm_convffn'


def rms_norm(x, g):
    xf = x.astype(jnp.float32)
    y = xf * lax.rsqrt(jnp.mean(xf * xf, axis=-1, keepdims=True) + NORM_EPS)
    return (y * g.astype(jnp.float32)).astype(x.dtype)


def depthwise_conv_centred(x, w, b):
    k = w.shape[0]
    pad = k // 2
    s = x.shape[1]
    xp = jnp.pad(x, ((0, 0), (pad, pad), (0, 0)))
    out = xp[:, 0:s] * w[0]
    for j in range(1, k):
        out = out + xp[:, j:j + s] * w[j]
    return out + b


def apply_rotary(t):
    s, dh = t.shape[2], t.shape[3]
    inv_freq = ROPE_THETA ** (-jnp.arange(0, dh, 2, dtype=jnp.float32) / dh)
    ang = jnp.arange(s, dtype=jnp.float32)[:, None] * inv_freq[None, :]
    cos, sin = jnp.cos(ang), jnp.sin(ang)
    t1, t2 = t[..., :dh // 2], t[..., dh // 2:]
    return jnp.concatenate([t1 * cos - t2 * sin, t2 * cos + t1 * sin], axis=-1)


def dilated_window_branch(q, k, v, window, dilation):
    b, h, s, dh = q.shape
    half = window // (2 * dilation)
    blk = half
    n_sub = s // dilation
    nb = -(-n_sub // blk)
    lp = nb * blk

    def to_sub(t):
        return jnp.swapaxes(t.reshape(b, h, n_sub, dilation, dh), 2, 3)

    qs = jnp.pad(to_sub(q), ((0, 0), (0, 0), (0, 0), (0, lp - n_sub), (0, 0)))
    kpad = ((0, 0), (0, 0), (0, 0), (blk, lp - n_sub + blk), (0, 0))
    ks = jnp.pad(to_sub(k), kpad)
    vs = jnp.pad(to_sub(v), kpad)

    def band(t):
        return jnp.concatenate(
            [t[:, :, :, i * blk:i * blk + lp].reshape(b, h, dilation, nb, blk, dh) for i in range(3)], axis=4)

    qb = qs.reshape(b, h, dilation, nb, blk, dh)
    kb, vb = band(ks), band(vs)
    scores = jnp.einsum('bhrnqe,bhrnke->bhrnqk', qb, kb) * (dh ** -0.5)
    qi = jnp.arange(nb)[:, None] * blk + jnp.arange(blk)[None, :]
    ki = jnp.arange(nb)[:, None] * blk - blk + jnp.arange(3 * blk)[None, :]
    off = ki[:, None, :] - qi[:, :, None]
    valid = (jnp.abs(off) <= half) & (ki[:, None, :] >= 0) & (ki[:, None, :] < n_sub)
    scores = jnp.where(valid, scores, NEG_INF)
    m = jnp.max(scores, axis=-1, keepdims=True)
    p = jnp.exp(scores - m)
    den = jnp.sum(p, axis=-1)
    out = jnp.einsum('bhrnqk,bhrnke->bhrnqe', p, vb) / den[..., None]
    lse = m[..., 0] + jnp.log(den)
    out = jnp.swapaxes(out.reshape(b, h, dilation, lp, dh)[:, :, :, :n_sub], 2, 3).reshape(b, h, s, dh)
    lse = jnp.swapaxes(lse.reshape(b, h, dilation, lp)[:, :, :, :n_sub], 2, 3).reshape(b, h, s)
    return out, lse


def dilated_attention(q, k, v):
    outs, lses = [], []
    for window, dilation in DILATED_PATTERNS:
        o, l = dilated_window_branch(q, k, v, window, dilation)
        outs.append(o)
        lses.append(l)
    wts = jax.nn.softmax(jnp.stack(lses, axis=0), axis=0)
    out = wts[0][..., None] * outs[0]
    for i in range(1, len(outs)):
        out = out + wts[i][..., None] * outs[i]
    return out


def mlstm_direction(q, k, v, log_i, log_f):
    b, h, s, dh = q.shape
    ch = MLSTM_CHUNK
    nc = s // ch
    k = k * (dh ** -0.5)

    def chunks(t):
        return jnp.moveaxis(t.reshape(b, h, nc, ch, *t.shape[3:]), 2, 0)

    causal = jnp.tril(jnp.ones((ch, ch), dtype=bool))

    def step(carry, xs):
        c_st, n_st, m_st = carry
        qc, kc, vc, lic, lfc = xs
        bcum = jnp.cumsum(lfc, axis=-1)
        dlog = bcum[..., :, None] - bcum[..., None, :] + lic[..., None, :]
        dlog = jnp.where(causal, dlog, NEG_INF)
        inter = bcum + m_st[..., None]
        m_t = jnp.maximum(inter, jnp.max(dlog, axis=-1))
        sc = jnp.einsum('bhte,bhse->bhts', qc, kc) * jnp.exp(dlog - m_t[..., None])
        g = jnp.exp(inter - m_t)
        num = jnp.einsum('bhts,bhsf->bhtf', sc, vc) + g[..., None] * jnp.einsum('bhte,bhef->bhtf', qc, c_st)
        den = jnp.sum(sc, axis=-1) + g * jnp.einsum('bhte,bhe->bht', qc, n_st)
        h_t = num / jnp.maximum(jnp.abs(den), jnp.exp(-m_t))[..., None]
        b_last = bcum[..., -1]
        wlog = b_last[..., None] - bcum + lic
        m_new = jnp.maximum(b_last + m_st, jnp.max(wlog, axis=-1))
        wexp = jnp.exp(wlog - m_new[..., None])
        decay = jnp.exp(b_last + m_st - m_new)
        c_new = decay[..., None, None] * c_st + jnp.einsum('bhs,bhse,bhsf->bhef', wexp, kc, vc)
        n_new = decay[..., None] * n_st + jnp.einsum('bhs,bhse->bhe', wexp, kc)
        return (c_new, n_new, m_new), h_t

    init = (jnp.zeros((b, h, dh, dh), jnp.float32), jnp.zeros((b, h, dh), jnp.float32),
            jnp.zeros((b, h), jnp.float32))
    _, hs = lax.scan(step, init, (chunks(q), chunks(k), chunks(v), chunks(log_i), chunks(log_f)))
    return jnp.moveaxis(hs, 0, 2).reshape(b, h, s, dh)


def hybrid_mixer(hn, w_in, mlstm_conv_w, mlstm_conv_b, mlstm_gate_b, mlstm_head_g, w_out):
    b, s, _ = hn.shape
    f32 = jnp.float32
    sizes = [ATTN_WIDTH] * 3 + [MLSTM_WIDTH] * 4 + [4 * MLSTM_HEADS]
    split_at = np.cumsum(sizes)[:-1].tolist()
    aq, ak, av, mq, mk, mv, mo, gates = jnp.split(hn @ w_in, split_at, axis=-1)

    def heads(t, n):
        return jnp.transpose(t.astype(f32).reshape(b, s, n, -1), (0, 2, 1, 3))

    q = apply_rotary(heads(aq, ATTN_HEADS))
    k = apply_rotary(heads(ak, ATTN_HEADS))
    v = heads(av, ATTN_HEADS)
    attn = dilated_attention(q, k, v)
    attn = jnp.transpose(attn, (0, 2, 1, 3)).reshape(b, s, ATTN_WIDTH).astype(hn.dtype)

    qk = jax.nn.silu(depthwise_conv_centred(jnp.concatenate([mq, mk], axis=-1), mlstm_conv_w, mlstm_conv_b))
    mq, mk = jnp.split(qk, 2, axis=-1)
    q = heads(mq, MLSTM_HEADS)
    k = heads(mk, MLSTM_HEADS)
    v = heads(mv, MLSTM_HEADS)
    g = (gates + mlstm_gate_b).astype(f32).reshape(b, s, 4, MLSTM_HEADS)
    g = jnp.transpose(g, (2, 0, 3, 1))
    h_fwd = mlstm_direction(q, k, v, g[0], jax.nn.log_sigmoid(g[1]))
    flip = lambda t: jnp.flip(t, axis=2)
    h_bwd = flip(mlstm_direction(flip(q), flip(k), flip(v), flip(g[2]), flip(jax.nn.log_sigmoid(g[3]))))
    hm = h_fwd + h_bwd
    hm = hm * lax.rsqrt(jnp.mean(hm * hm, axis=-1, keepdims=True) + NORM_EPS)
    hm = jnp.transpose(hm, (0, 2, 1, 3)).reshape(b, s, MLSTM_WIDTH)
    mlstm = (hm * mlstm_head_g.astype(f32) * jax.nn.sigmoid(mo.astype(f32))).astype(hn.dtype)

    return jnp.concatenate([attn, mlstm], axis=-1) @ w_out


def conv_ffn(hn, w_up, conv_w, conv_b, w_down):
    u = depthwise_conv_centred(hn @ w_up, conv_w, conv_b)
    gate, val = jnp.split(u, 2, axis=-1)
    return (jax.nn.gelu(gate, approximate=True) * val) @ w_down


def setup_inputs(seed: int = 0) -> dict:
    key = jax.random.key(seed)
    ks = jax.random.split(key, 16)

    def nrm(k, shape, scale):
        return jax.random.normal(k, shape, jnp.float32) * scale

    base = jnp.stack([jnp.zeros((MLSTM_HEADS,), jnp.float32),
                      jnp.linspace(3.0, 6.0, MLSTM_HEADS, dtype=jnp.float32)], axis=0)
    gate_b = (nrm(ks[5], (DEPTH, 2, 2, MLSTM_HEADS), 0.1) + base[None, None]).reshape(DEPTH, 4 * MLSTM_HEADS)
    return {
        'x': nrm(ks[0], (BATCH, SEQ, D_MODEL), 1.0),
        'mix_pre_g': 1.0 + nrm(ks[1], (DEPTH, D_MODEL), 0.02),
        'w_in': nrm(ks[2], (DEPTH, D_MODEL, PROJ_COLS), D_MODEL ** -0.5),
        'mlstm_conv_w': nrm(ks[3], (DEPTH, MLSTM_CONV, 2 * MLSTM_WIDTH), MLSTM_CONV ** -0.5),
        'mlstm_conv_b': nrm(ks[4], (DEPTH, 2 * MLSTM_WIDTH), 0.02),
        'mlstm_gate_b': gate_b,
        'mlstm_head_g': 1.0 + nrm(ks[6], (DEPTH, MLSTM_WIDTH), 0.02),
        'w_out': nrm(ks[7], (DEPTH, D_MIX, D_MODEL), D_MIX ** -0.5),
        'mix_post_g': 1.0 + nrm(ks[8], (DEPTH, D_MODEL), 0.02),
        'ffn_pre_g': 1.0 + nrm(ks[9], (DEPTH, D_MODEL), 0.02),
        'w_up': nrm(ks[10], (DEPTH, D_MODEL, 2 * D_FF), D_MODEL ** -0.5),
        'ffn_conv_w': nrm(ks[11], (DEPTH, FFN_CONV, 2 * D_FF), FFN_CONV ** -0.5),
        'ffn_conv_b': nrm(ks[12], (DEPTH, 2 * D_FF), 0.02),
        'w_down': nrm(ks[13], (DEPTH, D_FF, D_MODEL), D_FF ** -0.5),
        'ffn_post_g': 1.0 + nrm(ks[14], (DEPTH, D_MODEL), 0.02),
    }


def reference(x, mix_pre_g, w_in, mlstm_conv_w, mlstm_conv_b, mlstm_gate_b, mlstm_head_g, w_out,
              mix_post_g, ffn_pre_g, w_up, ffn_conv_w, ffn_conv_b, w_down, ffn_post_g):
    for l in range(DEPTH):
        mixed = hybrid_mixer(rms_norm(x, mix_pre_g[l]), w_in[l], mlstm_conv_w[l], mlstm_conv_b[l],
                             mlstm_gate_b[l], mlstm_head_g[l], w_out[l])
        x = x + rms_norm(mixed, mix_post_g[l])
        ff = conv_ffn(rms_norm(x, ffn_pre_g[l]), w_up[l], ffn_conv_w[l], ffn_conv_b[l], w_down[l])
        x = x + rms_norm(ff, ffn_post_g[l])
    return x
```

```cpp
#include <hip/hip_runtime.h>
#include <hip/hip_cooperative_groups.h>
#include <cstdio>
#include <cstdint>
namespace cg = cooperative_groups;
namespace pg8 {
#define PG8_LAS __attribute__((address_space(3)))
typedef unsigned short bf16_t;
typedef short bf16x8 __attribute__((ext_vector_type(8)));
typedef float f32x4 __attribute__((ext_vector_type(4)));
typedef unsigned u32x4 __attribute__((ext_vector_type(4)));
constexpr int BM = 256, BK = 64, HALF = 128, HTB = HALF * BK * 2  , STAGE_BYTES = 8 * HTB, NXCD = 8, WGM = 8;

__host__ __device__ __forceinline__ int lds_byte(int r, int c) { const int st = (r >> 4) * 2 + (c >> 5), rr = r & 15, cc = c & 31, ob = rr * 64 + cc * 2; return st * 1024 + (ob ^ (((ob >> 9) & 1) << 5)); }
__host__ __device__ __forceinline__ void stage_rc(int b, int& R, int& C) { const int st = b / 1024, sb = b % 1024, swz = sb ^ (((sb >> 9) & 1) << 5); R = (st >> 1) * 16 + swz / 64; C = (st & 1) * 32 + (swz % 64) / 2; }
__host__ __device__ __forceinline__ int perm32(int rho) { const int n = rho >> 4, i = rho & 15; return 8 * (i >> 2) + 4 * n + (i & 3); }

struct Unit { int pm, pn; };
struct Gemm { const bf16_t* A; const bf16_t* Bt; int M, N, K; };

struct StaticOrder {
    int nM, nN, nwg, G, c;
    __host__ __device__ void init(int M, int N, int G_, int c_) { nM = M / BM; nN = N / BM; nwg = nM * nN; G = G_; c = c_; }
    __host__ __device__ bool next(int i, Unit& u) const {
        const long L = (long)i * G + c; if (L >= nwg) return false;
        int wgid = (int)L; { const int q = nwg / NXCD, r = nwg % NXCD, xcd = wgid % NXCD, off = wgid / NXCD; wgid = (xcd < r ? xcd * (q + 1) : r * (q + 1) + (xcd - r) * q) + off; }
        const int nig = WGM * nN, gid = wgid / nig, fm = gid * WGM, gsz = (nM - fm) < WGM ? (nM - fm) : WGM;
        u.pm = fm + ((wgid % nig) % gsz); u.pn = (wgid % nig) / gsz; return true;
    }
    __device__ __forceinline__ void a_ready(const Unit&) const {}
    __device__ __forceinline__ void done(const Unit&) const {}
};

__device__ __forceinline__ unsigned cvt_pk_bf16(float lo, float hi) { unsigned r; asm volatile("v_cvt_pk_bf16_f32 %0, %1, %2" : "=v"(r) : "v"(lo), "v"(hi)); return r; }
typedef float f32x2 __attribute__((ext_vector_type(2)));
__device__ __forceinline__ f32x2 gelu_pk(f32x2 v) {
    const f32x2 av = __builtin_elementwise_abs(v), d = av * 0.2316418882f + 1.0f;
    f32x2 t; t.x = __builtin_amdgcn_rcpf(d.x); t.y = __builtin_amdgcn_rcpf(d.y);
    f32x2 q = t * 0.5307027145f + (-0.7265760135f); q = q * t + 0.7107068705f; q = q * t + (-0.142248368f); q = q * t + 0.127414796f; q = q * t;
    const f32x2 s = (v * v) * (-0.72134752044f);
    f32x2 e; e.x = __builtin_amdgcn_exp2f(s.x); e.y = __builtin_amdgcn_exp2f(s.y);
    const f32x2 m = v * (q * e), r = v - m;
    f32x2 o; o.x = v.x < 0.f ? m.x : r.x; o.y = v.y < 0.f ? m.y : r.y; return o;
}

template <int ACT  > struct EpiBf16 {
    static constexpr bool PERM = true, AFTER_DRAIN = false; static_assert(ACT == 0 || ACT == 1, "EpiBf16: ACT is 0 (none) or 1 (gelu_pk)");
    bf16_t* O; int ldc; const float* bias; int split_cols; size_t split_stride; float scale0;
    __device__ __forceinline__ void operator()(const f32x4 (&acc)[2][2][4][2], const Unit& u, int wr, int wc, int fr, int fq) const {
        const int row0 = u.pm * BM + wr * 64 + fr; int colt = u.pn * BM; bf16_t* base = O;
        float sc = 1.f; if (split_cols) { const int t = colt / split_cols; base += (size_t)t * split_stride; colt -= t * split_cols; if (t == 0) sc = scale0; }
        const int col0 = colt + wc * 32 + 8 * fq, bcol0 = u.pn * BM + wc * 32 + 8 * fq;
        f32x4 bv[2][2];
#pragma unroll
        for (int bj = 0; bj < 2; ++bj)
#pragma unroll
            for (int n = 0; n < 2; ++n) bv[bj][n] = bias ? *(const f32x4*)(bias + bcol0 + bj * HALF + 4 * n) : (f32x4){0.f, 0.f, 0.f, 0.f};
#pragma unroll
        for (int ai = 0; ai < 2; ++ai)
#pragma unroll
            for (int m = 0; m < 4; ++m) { bf16_t* rowp = base + (size_t)(row0 + ai * HALF + m * 16) * ldc + col0;
#pragma unroll
                for (int bj = 0; bj < 2; ++bj) { f32x4 v0 = acc[ai][bj][m][0] + bv[bj][0], v1 = acc[ai][bj][m][1] + bv[bj][1];
                    if (ACT == 1) { f32x2 a = gelu_pk((f32x2){v0[0], v0[1]}), b = gelu_pk((f32x2){v0[2], v0[3]}), c = gelu_pk((f32x2){v1[0], v1[1]}), d = gelu_pk((f32x2){v1[2], v1[3]});
                        v0 = (f32x4){a.x, a.y, b.x, b.y}; v1 = (f32x4){c.x, c.y, d.x, d.y}; }
                    v0 = v0 * sc; v1 = v1 * sc; u32x4 w; w.x = cvt_pk_bf16(v0[0], v0[1]); w.y = cvt_pk_bf16(v0[2], v0[3]); w.z = cvt_pk_bf16(v1[0], v1[1]); w.w = cvt_pk_bf16(v1[2], v1[3]);
                    *(u32x4*)(rowp + bj * HALF) = w; } }
    }
};
struct EpiF32 {
    static constexpr bool PERM = false, AFTER_DRAIN = false;
    float* C; int ldc; const float* bias;
    __device__ __forceinline__ void operator()(const f32x4 (&acc)[2][2][4][2], const Unit& u, int wr, int wc, int fr, int fq) const {
        const int row0 = u.pm * BM + wr * 64 + fr, col0 = u.pn * BM + wc * 32 + 4 * fq;
        f32x4 bv[2][2];
#pragma unroll
        for (int bj = 0; bj < 2; ++bj)
#pragma unroll
            for (int n = 0; n < 2; ++n) bv[bj][n] = bias ? *(const f32x4*)(bias + col0 + bj * HALF + n * 16) : (f32x4){0.f, 0.f, 0.f, 0.f};
#pragma unroll
        for (int ai = 0; ai < 2; ++ai)
#pragma unroll
            for (int m = 0; m < 4; ++m) { float* rowp = C + (size_t)(row0 + ai * HALF + m * 16) * ldc + col0;
#pragma unroll
                for (int bj = 0; bj < 2; ++bj)
#pragma unroll
                    for (int n = 0; n < 2; ++n) *(f32x4*)(rowp + bj * HALF + n * 16) = acc[ai][bj][m][n] + bv[bj][n]; }
    }
};
template <class Epi, class Sched, bool ALIGN_EPI = false, bool SP2 = false>
__device__ __forceinline__ void gemm_phase(PG8_LAS unsigned char* lds, const Gemm g, const Sched& S, const Epi& E) {
    int tid_ = threadIdx.x; asm volatile("" : "+v"(tid_));
    const int tid = tid_, wid = __builtin_amdgcn_readfirstlane(tid >> 6), lane = tid & 63, wr = wid >> 2, wc = wid & 3, fr = lane & 15, fq = lane >> 4;
    const int K = g.K, nt = K / BK;
    unsigned voffA[2], voffB[2];
#pragma unroll
    for (int i = 0; i < 2; ++i) { int R, C; stage_rc(tid * 16 + i * 8192, R, C); const int Rb = Epi::PERM ? ((R & ~31) + perm32(R & 31)) : R;
        voffA[i] = (unsigned)(R * K + C) * 2u; voffB[i] = (unsigned)(Rb * K + C) * 2u; }
    const size_t kstep = (size_t)(BK * 2);
    const size_t hstep = (size_t)HALF * K * 2;
    const size_t tstep = 2 * hstep;
    const unsigned ldsw = (unsigned)wid * 1024u;
    const int aoff = lds_byte(wr * 64 + fr, fq * 8), boff = lds_byte(wc * 32 + fr, fq * 8);
#define PG8_SA(b, h) (((b) * 2 + (h)) * HTB)
#define PG8_SB(b, h) ((4 + (b) * 2 + (h)) * HTB)
#define PG8_STAGE(bufoff, gbase, voff) do { _Pragma("unroll") for (int _i = 0; _i < 2; ++_i) \
        __builtin_amdgcn_global_load_lds((const unsigned*)((const char*)(gbase) + (voff)[_i]), (PG8_LAS unsigned*)(lds + (bufoff) + ldsw + _i * 8192), 16, 0, 0); } while (0)
#define PG8_LDA(dst, b, h) do { _Pragma("unroll") for (int m = 0; m < 4; ++m) _Pragma("unroll") for (int k = 0; k < 2; ++k) dst[m][k] = *(const PG8_LAS bf16x8*)(lds + PG8_SA(b, h) + aoff + m * 2048 + k * 1024); } while (0)
#define PG8_LDB(dst, b, h) do { _Pragma("unroll") for (int n = 0; n < 2; ++n) _Pragma("unroll") for (int k = 0; k < 2; ++k) dst[n][k] = *(const PG8_LAS bf16x8*)(lds + PG8_SB(b, h) + boff + n * 2048 + k * 1024); } while (0)
#define PG8_MMA(ai, bj, At, Bt) do { __builtin_amdgcn_s_setprio(1); _Pragma("unroll") for (int m = 0; m < 4; ++m) _Pragma("unroll") for (int n = 0; n < 2; ++n) _Pragma("unroll") for (int k = 0; k < 2; ++k) \
        acc[ai][bj][m][n] = __builtin_amdgcn_mfma_f32_16x16x32_bf16(Bt[n][k], At[m][k], acc[ai][bj][m][n], 0, 0, 0); __builtin_amdgcn_s_setprio(0); } while (0)
#define PG8_WAIT_V(n) asm volatile("s_waitcnt vmcnt(" #n ")" ::: "memory")
#define PG8_WAIT_L(n) asm volatile("s_waitcnt lgkmcnt(" #n ")" ::: "memory")
#define PG8_BAR __builtin_amdgcn_s_barrier()
#define PG8_SCHED __builtin_amdgcn_sched_barrier(0)
    Unit cur, nxt; int ui = 0;
    if (!S.next(0, cur)) return;
    f32x4 acc[2][2][4][2];
#pragma unroll
    for (int a = 0; a < 2; ++a)
#pragma unroll
        for (int b = 0; b < 2; ++b)
#pragma unroll
            for (int m = 0; m < 4; ++m)
#pragma unroll
                for (int n = 0; n < 2; ++n) acc[a][b][m][n] = (f32x4){0.f, 0.f, 0.f, 0.f};
    bf16x8 At[4][2], B0[2][2], B1[2][2];
    const char* cA = (const char*)g.A + (size_t)cur.pm * tstep; const char* cB = (const char*)g.Bt + (size_t)cur.pn * tstep;
    S.a_ready(cur);
    if constexpr (SP2) {
        PG8_STAGE(PG8_SB(0, 0), cB, voffB); PG8_STAGE(PG8_SB(0, 1), cB + hstep, voffB); PG8_STAGE(PG8_SA(0, 0), cA, voffA); PG8_STAGE(PG8_SA(0, 1), cA + hstep, voffA);
        if (wr == 1) PG8_BAR;
        PG8_WAIT_V(2); PG8_BAR;
        PG8_STAGE(PG8_SB(1, 0), cB + kstep, voffB); PG8_STAGE(PG8_SA(1, 0), cA + kstep, voffA); PG8_STAGE(PG8_SB(1, 1), cB + hstep + kstep, voffB);
        PG8_WAIT_V(6); PG8_BAR;
    } else {
        PG8_STAGE(PG8_SB(0, 0), cB, voffB); PG8_STAGE(PG8_SA(0, 0), cA, voffA); PG8_STAGE(PG8_SB(0, 1), cB + hstep, voffB); PG8_STAGE(PG8_SA(0, 1), cA + hstep, voffA);
        if (wr == 1) PG8_BAR;
        PG8_WAIT_V(4); PG8_BAR;
        PG8_STAGE(PG8_SB(1, 0), cB + kstep, voffB); PG8_STAGE(PG8_SA(1, 0), cA + kstep, voffA); PG8_STAGE(PG8_SB(1, 1), cB + hstep + kstep, voffB);
        PG8_WAIT_V(6); PG8_BAR;
    }
    for (;;) {
        const bool has_next = S.next(ui + 1, nxt);
        const char* nA = has_next ? (const char*)g.A + (size_t)nxt.pm * tstep : cA; const char* nB = has_next ? (const char*)g.Bt + (size_t)nxt.pn * tstep : cB;
        for (int t = 0; t < nt; t += 2) {
            const bool last = (t == nt - 2);
            const char* a1 = cA + (size_t)(t + 1) * kstep;
            const char* a2 = last ? nA : cA + (size_t)(t + 2) * kstep; const char* b2 = last ? nB : cB + (size_t)(t + 2) * kstep;
            const char* a3 = a2 + kstep; const char* b3 = b2 + kstep;
            if (last && has_next) S.a_ready(nxt);
            if constexpr (SP2) {
            PG8_LDB(B0, 0, 0); PG8_LDB(B1, 0, 1); PG8_SCHED; PG8_LDA(At, 0, 0); PG8_STAGE(PG8_SA(1, 1), a1 + hstep, voffA);
            PG8_WAIT_V(8); PG8_WAIT_L(0); PG8_BAR; PG8_MMA(0, 0, At, B0); PG8_MMA(0, 1, At, B1); PG8_BAR; PG8_SCHED;
            PG8_LDA(At, 0, 1); PG8_STAGE(PG8_SB(0, 0), b2, voffB); PG8_STAGE(PG8_SB(0, 1), b2 + hstep, voffB); PG8_STAGE(PG8_SA(0, 0), a2, voffA);
            PG8_WAIT_V(8); PG8_WAIT_L(0); PG8_BAR; PG8_MMA(1, 0, At, B0); PG8_MMA(1, 1, At, B1); PG8_BAR; PG8_SCHED;
            PG8_LDB(B0, 1, 0); PG8_LDB(B1, 1, 1); PG8_SCHED; PG8_LDA(At, 1, 0); PG8_STAGE(PG8_SA(0, 1), a2 + hstep, voffA);
            PG8_WAIT_V(8); PG8_WAIT_L(0); PG8_BAR; PG8_MMA(0, 0, At, B0); PG8_MMA(0, 1, At, B1); PG8_BAR; PG8_SCHED;
            PG8_LDA(At, 1, 1); PG8_STAGE(PG8_SB(1, 0), b3, voffB); PG8_STAGE(PG8_SB(1, 1), b3 + hstep, voffB); PG8_STAGE(PG8_SA(1, 0), a3, voffA);
            PG8_WAIT_V(8); PG8_WAIT_L(0); PG8_BAR; PG8_MMA(1, 0, At, B0); PG8_MMA(1, 1, At, B1); PG8_BAR; PG8_SCHED;
            } else {
            PG8_LDB(B0, 0, 0); PG8_SCHED; PG8_LDA(At, 0, 0); PG8_STAGE(PG8_SA(1, 1), a1 + hstep, voffA);
            PG8_WAIT_L(8); PG8_BAR; PG8_WAIT_L(0); PG8_MMA(0, 0, At, B0); PG8_BAR; PG8_SCHED;
            PG8_LDB(B1, 0, 1); PG8_STAGE(PG8_SB(0, 0), b2, voffB);
            PG8_BAR; PG8_WAIT_L(0); PG8_MMA(0, 1, At, B1); PG8_BAR;
            PG8_LDA(At, 0, 1); PG8_STAGE(PG8_SA(0, 0), a2, voffA);
            PG8_BAR; PG8_WAIT_L(0); PG8_MMA(1, 0, At, B0); PG8_BAR; PG8_SCHED;
            PG8_STAGE(PG8_SB(0, 1), b2 + hstep, voffB);
            PG8_WAIT_V(6); PG8_BAR; PG8_MMA(1, 1, At, B1); PG8_BAR;
            PG8_LDB(B0, 1, 0); PG8_SCHED; PG8_LDA(At, 1, 0); PG8_STAGE(PG8_SA(0, 1), a2 + hstep, voffA);
            PG8_WAIT_L(8); PG8_BAR; PG8_WAIT_L(0); PG8_MMA(0, 0, At, B0); PG8_BAR; PG8_SCHED;
            PG8_LDB(B1, 1, 1); PG8_STAGE(PG8_SB(1, 0), b3, voffB);
            PG8_BAR; PG8_WAIT_L(0); PG8_MMA(0, 1, At, B1); PG8_BAR;
            PG8_LDA(At, 1, 1); PG8_STAGE(PG8_SA(1, 0), a3, voffA);
            PG8_BAR; PG8_WAIT_L(0); PG8_MMA(1, 0, At, B0); PG8_BAR; PG8_SCHED;
            PG8_STAGE(PG8_SB(1, 1), b3 + hstep, voffB);
            PG8_WAIT_V(6); PG8_BAR; PG8_MMA(1, 1, At, B1); PG8_BAR;
            }
        }
        if constexpr (ALIGN_EPI) { if (wr == 0) PG8_BAR; }
        if constexpr (!Epi::AFTER_DRAIN) { E(acc, cur, wr, wc, fr, fq); S.done(cur); }
        if (!has_next) break;
#pragma unroll
        for (int a = 0; a < 2; ++a)
#pragma unroll
            for (int b = 0; b < 2; ++b)
#pragma unroll
                for (int m = 0; m < 4; ++m)
#pragma unroll
                    for (int n = 0; n < 2; ++n) acc[a][b][m][n] = (f32x4){0.f, 0.f, 0.f, 0.f};
        cur = nxt; cA = nA; cB = nB; ++ui;
        if constexpr (ALIGN_EPI) { if (wr == 1) PG8_BAR; }
    }
    PG8_WAIT_V(0);
    if constexpr (!ALIGN_EPI) { if (wr == 0) PG8_BAR; }
    PG8_BAR;
    if constexpr (Epi::AFTER_DRAIN) { E.fused(acc, cur, wr, wc, fr, fq, lds, wid, lane); S.done(cur); }
#undef PG8_SA
#undef PG8_SB
#undef PG8_STAGE
#undef PG8_LDA
#undef PG8_LDB
#undef PG8_MMA
#undef PG8_WAIT_V
#undef PG8_WAIT_L
#undef PG8_BAR
#undef PG8_SCHED
}
}
#define GAS __attribute__((address_space(1)))
#define LAS __attribute__((address_space(3)))
typedef unsigned short bf16;
typedef unsigned v4u __attribute__((ext_vector_type(4)));
typedef float f32x4 __attribute__((ext_vector_type(4)));
typedef short bf16x8 __attribute__((ext_vector_type(8)));
typedef GAS unsigned gu32;
typedef GAS unsigned long long gu64;
#define RLX_AGENT __ATOMIC_RELAXED, __HIP_MEMORY_SCOPE_AGENT
#define LDS_WAIT() asm volatile("s_waitcnt lgkmcnt(0)" ::: "memory")
#define VM_WAIT() asm volatile("s_waitcnt vmcnt(0)" ::: "memory")
__device__ __forceinline__ unsigned long long rt() { return __builtin_amdgcn_s_memrealtime(); }
__device__ __forceinline__ unsigned f2bf(float f) { unsigned u = __builtin_bit_cast(unsigned, f); return (u + 0x7fffu + ((u >> 16) & 1u)) >> 16; }
__device__ __forceinline__ unsigned pk2(float lo, float hi) { return f2bf(lo) | (f2bf(hi) << 16); }

#define XB_TMO      128
#define XB_XCNT(j)  (256  + 64 * (j))
#define XB_XSUB(j)  (1280 + 64 * (j))
#define XB_XGEN(j)  (2304 + 64 * (j))
#define XB_TOP      3328
#define XB_TOPGEN   3392
#define XCD_BAR_WORDS 3456
#define XB_SPIN_CAP (1u << 18)

__device__ __forceinline__ unsigned xb_ld(unsigned* p)              { return __hip_atomic_load(p, __ATOMIC_RELAXED, __HIP_MEMORY_SCOPE_AGENT); }
__device__ __forceinline__ unsigned xb_add(unsigned* p, unsigned v) { return __hip_atomic_fetch_add(p, v, __ATOMIC_RELAXED, __HIP_MEMORY_SCOPE_AGENT); }
__device__ __forceinline__ unsigned xb_xcc_id() { return (unsigned)__builtin_amdgcn_s_getreg((3 << 11) | 20) & 0xFu; }
#define XB_SPIN(cond, bar) do { unsigned _sp = 0; while (cond) { __builtin_amdgcn_s_sleep(1); \
    if ((++_sp & 255u) == 0u) { if (xb_ld(&(bar)[XB_TMO])) break; if (_sp > XB_SPIN_CAP) { atomicAdd(&(bar)[XB_TMO], 1u); break; } } } } while (0)

struct XcdBarrier {
    unsigned* bar; unsigned x;
    volatile LAS unsigned* st;
};

__device__ __forceinline__ XcdBarrier xcd_barrier_post(unsigned* bar, volatile LAS unsigned* st) {
    XcdBarrier b; b.bar = bar; b.x = xb_xcc_id(); b.st = st;
    if (threadIdx.x == 0) (void)xb_add(&bar[XB_XCNT(b.x)], 1u);
    return b;
}
__device__ __forceinline__ void xcd_barrier_complete(unsigned* bar, unsigned x, unsigned& nloc, unsigned& nx) {
    const unsigned G = gridDim.x * gridDim.y * gridDim.z;
    unsigned sum, cnt, mine, sp = 0u;
    for (;;) {
        sum = 0u; cnt = 0u; mine = 0u;
#pragma unroll
        for (unsigned j = 0; j < 16; ++j) { const unsigned c = xb_ld(&bar[XB_XCNT(j)]); sum += c; cnt += (c > 0u) ? 1u : 0u; mine = (j == x) ? c : mine; }
        if (sum == G) break;
        __builtin_amdgcn_s_sleep(1);
        if ((++sp & 255u) == 0u) { if (xb_ld(&bar[XB_TMO])) break; if (sp > XB_SPIN_CAP) { atomicAdd(&bar[XB_TMO], 1u); break; } }
    }
    nloc = mine > 0u ? mine : 1u; nx = cnt > 0u ? cnt : 1u;
}

__device__ __forceinline__ void xcd_barrier(const XcdBarrier& b) {
    asm volatile("s_waitcnt vmcnt(0)" ::: "memory");
    __syncthreads();
    if (threadIdx.x == 0) {
        unsigned* bar = b.bar;
        __builtin_amdgcn_s_waitcnt(0);
        unsigned nloc = b.st[0], nx = b.st[1];
        if (nloc == 0u) { xcd_barrier_complete(bar, b.x, nloc, nx); b.st[0] = nloc; b.st[1] = nx; }
        const unsigned old = xb_add(&bar[XB_XSUB(b.x)], 1u);
        const unsigned gen = old / nloc;
        if (old + 1u == (gen + 1u) * nloc) {
            __builtin_amdgcn_fence(__ATOMIC_RELEASE, "agent");
            asm volatile("s_waitcnt vmcnt(0)" ::: "memory");
            const unsigned og = xb_add(&bar[XB_TOP], 1u);
            const unsigned tg = og / nx;
            if (og + 1u == (tg + 1u) * nx) xb_add(&bar[XB_TOPGEN], 1u);
            else XB_SPIN(xb_ld(&bar[XB_TOPGEN]) == tg, bar);
            __builtin_amdgcn_fence(__ATOMIC_ACQUIRE, "agent");
            xb_add(&bar[XB_XGEN(b.x)], 1u);
            asm volatile("s_waitcnt vmcnt(0)" ::: "memory");
        } else {
            XB_SPIN(xb_ld(&bar[XB_XGEN(b.x)]) == gen, bar);
            __builtin_amdgcn_fence(__ATOMIC_ACQUIRE, "agent");
            asm volatile("s_waitcnt vmcnt(0)" ::: "memory");
        }
    }
    __syncthreads();
}

constexpr int NWAVES = 8, NTHR = 512;
constexpr int BATCH = 8, SEQ = 2048, DM = 1024, M = BATCH * SEQ, DEPTH = 2;
constexpr int AW = 512, AH = 8, AD = 64;
constexpr int MW = 512, MH = 4, MD = 128;
constexpr int PROJ_COLS = 3600, NPROJ = 3584;
constexpr int DFF = 2816, NUP = 2 * DFF;
constexpr float EPS = 1e-6f;
constexpr size_t MiB = 1u << 20;
constexpr size_t WS_CTL = 0, CTL_ZERO_BYTES = 1 * MiB;
constexpr size_t WS_WIN = 1 * MiB;
constexpr size_t WS_WOUT = 15 * MiB;
constexpr size_t WS_WUP = 19 * MiB;
constexpr size_t WS_WDN = 41 * MiB;
constexpr size_t WS_ROPE = 52 * MiB;
constexpr size_t WS_GATES = 53 * MiB;
constexpr size_t WS_HN = 54 * MiB;
constexpr size_t WS_SCR = 86 * MiB;
constexpr size_t WS_PROJ = WS_SCR;
constexpr size_t WS_HFB = 198 * MiB;
constexpr size_t WS_H = WS_SCR;
constexpr size_t WS_U = 174 * MiB;
constexpr size_t WS_T = 174 * MiB;
constexpr size_t WS_END = 256 * MiB;
constexpr int CW_BAR = 4096;
constexpr int RING_BYTES = 131072, LDSCTL_OFF = RING_BYTES, MISC_OFF = LDSCTL_OFF + 320, LDS_BYTES = 147456;

struct Args {
    const float* x; const float* mix_pre_g; const float* w_in; const float* mconv_w; const float* mconv_b; const float* gate_b; const float* head_g;
    const float* w_out; const float* mix_post_g; const float* ffn_pre_g; const float* w_up; const float* fconv_w; const float* fconv_b; const float* w_down; const float* ffn_post_g;
    float* out; unsigned char* ws;
};

__device__ __forceinline__ float wave_sum(float v) {
#pragma unroll
    for (int o = 1; o < 64; o <<= 1) v += __shfl_xor(v, o);
    return v;
}
__device__ __forceinline__ int lndv(int v) { asm volatile("" : "+v"(v)); return v; }
template <class T> __device__ __forceinline__ T* lnd(T* p) { asm volatile("" : "+s"(p)); return p; }
__device__ __forceinline__ float bf2f(unsigned short b) { return __builtin_bit_cast(float, (unsigned)b << 16); }
__device__ __forceinline__ float bflo(unsigned w) { return __builtin_bit_cast(float, w << 16); }
__device__ __forceinline__ float bfhi(unsigned w) { return __builtin_bit_cast(float, w & 0xffff0000u); }

__device__ __forceinline__ void transpose_item(const float* W, int K, int ldw, int ncols, bf16* WT, LAS float* scr, int item, int lane) {
    const int nblk = ncols / 32, kb = item / nblk, nb = item % nblk, k0 = 64 * kb, n0 = 32 * nb;
#pragma unroll 8
    for (int i = 0; i < 32; ++i) { const int kk = 2 * i + (lane >> 5); scr[kk * 33 + (lane & 31)] = W[(size_t)(k0 + kk) * ldw + n0 + (lane & 31)]; }
    LDS_WAIT(); asm volatile("" ::: "memory");
    const int c = lane & 7;
#pragma unroll
    for (int j = 0; j < 4; ++j) { const int n = (lane >> 3) + 8 * j; const LAS float* s = scr + (8 * c) * 33 + n;
        v4u o; o.x = pk2(s[0 * 33], s[1 * 33]); o.y = pk2(s[2 * 33], s[3 * 33]); o.z = pk2(s[4 * 33], s[5 * 33]); o.w = pk2(s[6 * 33], s[7 * 33]);
        *(GAS v4u*)(WT + (size_t)(n0 + n) * K + k0 + 8 * c) = o; }
    LDS_WAIT(); asm volatile("" ::: "memory");
}

__device__ __forceinline__ void rms_row(f32x4 (&v)[4], const f32x4 (&g)[4]) {
    float s = 0.f;
#pragma unroll
    for (int j = 0; j < 4; ++j) s += (v[j].x * v[j].x + v[j].y * v[j].y) + (v[j].z * v[j].z + v[j].w * v[j].w);
    const float rs = 1.0f / sqrtf(wave_sum(s) * (1.f / DM) + EPS);
#pragma unroll
    for (int j = 0; j < 4; ++j) v[j] = v[j] * rs * g[j];
}
__device__ __forceinline__ void store_row_bf16(bf16* orow, const f32x4 (&v)[4], int lane) {
    GAS unsigned long long* o8 = (GAS unsigned long long*)orow + lane;
#pragma unroll
    for (int j = 0; j < 4; ++j) o8[64 * j] = (unsigned long long)pk2(v[j].x, v[j].y) | ((unsigned long long)pk2(v[j].z, v[j].w) << 32);
}
__device__ __forceinline__ void gates_row(const f32x4 (&y)[4], const LAS float* wg, const float* gb, float* grow, int lane) {
    float p[16];
#pragma unroll
    for (int q = 0; q < 16; ++q) p[q] = 0.f;
#pragma unroll
    for (int j = 0; j < 4; ++j)
#pragma unroll
        for (int c = 0; c < 4; ++c) {
            const int k = 256 * j + 4 * lane + c; const float yk = y[j][c];
            const LAS f32x4* w4 = (const LAS f32x4*)(wg + k * 16);
#pragma unroll
            for (int q = 0; q < 4; ++q) { const f32x4 w = w4[q]; p[4 * q + 0] += yk * w.x; p[4 * q + 1] += yk * w.y; p[4 * q + 2] += yk * w.z; p[4 * q + 3] += yk * w.w; }
        }
    float r = 0.f;
#pragma unroll
    for (int q = 0; q < 16; ++q) { const float t = wave_sum(p[q]); r = (lane == q) ? t : r; }
    if (lane < 16) grow[lane] = r + gb[lane];
}

__device__ __forceinline__ float gelu_tanh(float x) {
    const float u = 0.7978845608028654f * (x + 0.044715f * x * x * x);
    const float e = __expf(2.f * u);
    const float th = 1.f - 2.f / (1.f + e);
    return 0.5f * x * (1.f + th);
}
__device__ __forceinline__ float sigmoidf_(float x) { return 1.f / (1.f + __expf(-x)); }
__device__ __forceinline__ float log_sigmoid(float x) { return fminf(x, 0.f) - log1pf(__expf(-fabsf(x))); }

#define PHASE_PTRS() const int tid = lndv((int)threadIdx.x), lane = tid & 63, wave = __builtin_amdgcn_readfirstlane(tid >> 6); const int gw = bid * NWAVES + wave, gt = bid * NTHR + tid; (void)lane; (void)gw; (void)gt; \
    Args a = a0; a.x = lnd(a.x); a.mix_pre_g = lnd(a.mix_pre_g); a.w_in = lnd(a.w_in); a.mconv_w = lnd(a.mconv_w); a.mconv_b = lnd(a.mconv_b); a.gate_b = lnd(a.gate_b); \
    a.head_g = lnd(a.head_g); a.w_out = lnd(a.w_out); a.mix_post_g = lnd(a.mix_post_g); a.ffn_pre_g = lnd(a.ffn_pre_g); a.w_up = lnd(a.w_up); a.fconv_w = lnd(a.fconv_w); a.fconv_b = lnd(a.fconv_b); \
    a.w_down = lnd(a.w_down); a.ffn_post_g = lnd(a.ffn_post_g); unsigned char* wsl = lnd(a.ws); \
    bf16* Win_t = (bf16*)(wsl + WS_WIN); bf16* Wout_t = (bf16*)(wsl + WS_WOUT); bf16* Wup_t = (bf16*)(wsl + WS_WUP); bf16* Wdn_t = (bf16*)(wsl + WS_WDN); \
    float* rope_c = (float*)(wsl + WS_ROPE); float* rope_s = rope_c + SEQ * 32; float* GATES = (float*)(wsl + WS_GATES); \
    bf16* HN = (bf16*)(wsl + WS_HN); bf16* PROJ = (bf16*)(wsl + WS_PROJ); bf16* HFB = (bf16*)(wsl + WS_HFB); bf16* HB16 = (bf16*)(wsl + WS_H); bf16* UB = (bf16*)(wsl + WS_U); \
    float* T = (float*)(wsl + WS_T); float* R = lnd(a.out); \
    (void)Win_t; (void)Wout_t; (void)Wup_t; (void)Wdn_t; (void)rope_c; (void)rope_s; (void)GATES; (void)HN; (void)PROJ; (void)HFB; (void)HB16; (void)UB; (void)T; (void)R;
__global__ void __launch_bounds__(NTHR, 2) hybrid_fwd(Args a0) {
    extern __shared__ __attribute__((aligned(16))) unsigned char lds_raw[];
    LAS unsigned char* lds = (LAS unsigned char*)lds_raw;
    volatile LAS unsigned* MISC = (volatile LAS unsigned*)(lds + MISC_OFF);
    const int tid = threadIdx.x, lane = tid & 63, wave = __builtin_amdgcn_readfirstlane(tid >> 6);
    const int G = gridDim.x, bid = blockIdx.x;
    unsigned char* ws = a0.ws;
    gu32* ctl = (gu32*)(ws + WS_CTL);
    for (int u = tid; u < (LDS_BYTES - LDSCTL_OFF) / 4; u += NTHR) ((LAS unsigned*)(lds + LDSCTL_OFF))[u] = 0u;
    __syncthreads();
    XcdBarrier bar = xcd_barrier_post((unsigned*)(ctl + CW_BAR), MISC + 8);
#define GRID_BAR() xcd_barrier(bar)
    const int gw = bid * NWAVES + wave, NGW = G * NWAVES;
    const int gt = bid * NTHR + tid, NGT = G * NTHR;


    {
            PHASE_PTRS();
        LAS float* scr = (LAS float*)(lds + wave * 16384);
        constexpr int I_IN = (DM / 64) * (NPROJ / 32), I_OUT = (DM / 64) * (DM / 32), I_UP = (DM / 64) * (NUP / 32), I_DN = (DFF / 64) * (DM / 32);
        constexpr int PER_L = I_IN + I_OUT + I_UP + I_DN;
        for (int it = gw; it < DEPTH * PER_L; it += NGW) {
            const int l = it / PER_L; int r = it % PER_L;
            if (r < I_IN) { transpose_item(a.w_in + (size_t)l * DM * PROJ_COLS, DM, PROJ_COLS, NPROJ, Win_t + (size_t)l * NPROJ * DM, scr, r, lane); continue; } r -= I_IN;
            if (r < I_OUT) { transpose_item(a.w_out + (size_t)l * DM * DM, DM, DM, DM, Wout_t + (size_t)l * DM * DM, scr, r, lane); continue; } r -= I_OUT;
            if (r < I_UP) { transpose_item(a.w_up + (size_t)l * DM * NUP, DM, NUP, NUP, Wup_t + (size_t)l * NUP * DM, scr, r, lane); continue; } r -= I_UP;
            transpose_item(a.w_down + (size_t)l * DFF * DM, DFF, DM, DM, Wdn_t + (size_t)l * DM * DFF, scr, r, lane);
        }
        for (int i = gt; i < SEQ * 32; i += NGT) {
            const int pos = i >> 5, fi = i & 31;
            const float inv = powf(10000.0f, -(float)(2 * fi) / 64.0f);
            const float ang = (float)pos * inv;
            const double ad = (double)ang; const double kk = rint(ad * 0.15915494309189535); const float rr = (float)(ad - kk * 6.283185307179586);
            rope_c[i] = cosf(rr); rope_s[i] = sinf(rr);
        }
    }
    __syncthreads();
    for (int l = 0; l < DEPTH; ++l) {
        if (l == 0) {
            PHASE_PTRS();
            const float* w_in_l = a.w_in + (size_t)l * DM * PROJ_COLS;
            LAS float* wg = (LAS float*)lds;
            for (int i = tid; i < DM * 16; i += NTHR) wg[i] = w_in_l[(size_t)(i >> 4) * PROJ_COLS + NPROJ + (i & 15)];
            __syncthreads();
            f32x4 g[4];
#pragma unroll
            for (int j = 0; j < 4; ++j) g[j] = ((const GAS f32x4*)(a.mix_pre_g + (size_t)l * DM))[lane + 64 * j];
            for (int m = gw; m < M; m += NGW) {
                f32x4 v[4];
#pragma unroll
                for (int j = 0; j < 4; ++j) v[j] = ((const GAS f32x4*)(a.x + (size_t)m * DM))[lane + 64 * j];
                rms_row(v, g);
                store_row_bf16(HN + (size_t)m * DM, v, lane);
                gates_row(v, wg, a.gate_b + l * 16, GATES + (size_t)m * 16, lane);
            }
            __syncthreads();
        }
        if (l == 0) { cg::this_grid().sync(); } else { GRID_BAR(); }

        {
            PHASE_PTRS();
            pg8::Gemm g{HN, Win_t + (size_t)l * NPROJ * DM, M, NPROJ, DM}; pg8::StaticOrder S; S.init(M, NPROJ, G, bid);
            pg8::EpiBf16<0> E{PROJ, NPROJ, nullptr, 0, 0, 1.f};
            pg8::gemm_phase<pg8::EpiBf16<0>, pg8::StaticOrder, true, true>(lds, g, S, E);
        }
        GRID_BAR();
        {
            PHASE_PTRS();
            for (int i = gt; i < M * 64; i += NGT) {
                const int m = i >> 6, hs = (i >> 2) & 15, i8 = i & 3, pos = m & (SEQ - 1);
                bf16* p1 = PROJ + (size_t)m * NPROJ + hs * 64 + 8 * i8;
                const v4u a1 = *(const GAS v4u*)p1, a2 = *(const GAS v4u*)(p1 + 32);
                const f32x4 c0 = *(const GAS f32x4*)(rope_c + pos * 32 + 8 * i8), c1 = *(const GAS f32x4*)(rope_c + pos * 32 + 8 * i8 + 4);
                const f32x4 s0 = *(const GAS f32x4*)(rope_s + pos * 32 + 8 * i8), s1 = *(const GAS f32x4*)(rope_s + pos * 32 + 8 * i8 + 4);
                const float sc = hs < 8 ? 0.125f : 1.f;
                float t1[8] = {bflo(a1.x), bfhi(a1.x), bflo(a1.y), bfhi(a1.y), bflo(a1.z), bfhi(a1.z), bflo(a1.w), bfhi(a1.w)};
                float t2[8] = {bflo(a2.x), bfhi(a2.x), bflo(a2.y), bfhi(a2.y), bflo(a2.z), bfhi(a2.z), bflo(a2.w), bfhi(a2.w)};
                float cc[8] = {c0.x, c0.y, c0.z, c0.w, c1.x, c1.y, c1.z, c1.w}, ss[8] = {s0.x, s0.y, s0.z, s0.w, s1.x, s1.y, s1.z, s1.w};
                float o1[8], o2[8];
#pragma unroll
                for (int q = 0; q < 8; ++q) { o1[q] = (t1[q] * cc[q] - t2[q] * ss[q]) * sc; o2[q] = (t2[q] * cc[q] + t1[q] * ss[q]) * sc; }
                v4u w1, w2; w1.x = pk2(o1[0], o1[1]); w1.y = pk2(o1[2], o1[3]); w1.z = pk2(o1[4], o1[5]); w1.w = pk2(o1[6], o1[7]);
                w2.x = pk2(o2[0], o2[1]); w2.y = pk2(o2[2], o2[3]); w2.z = pk2(o2[4], o2[5]); w2.w = pk2(o2[6], o2[7]);
                *(GAS v4u*)p1 = w1; *(GAS v4u*)(p1 + 32) = w2;
            }
            const float* cw = a.mconv_w + (size_t)l * 5 * 1024; const float* cb = a.mconv_b + (size_t)l * 1024;
            for (int i = gt; i < M * 128; i += NGT) {
                const int m = i >> 7, c8 = (i & 127) * 8, pos = m & (SEQ - 1);
                float acc[8];
#pragma unroll
                for (int q = 0; q < 8; ++q) acc[q] = cb[c8 + q];
#pragma unroll
                for (int j = 0; j < 5; ++j) {
                    const int pp = pos + j - 2;
                    if (pp >= 0 && pp < SEQ) {
                        const v4u xv = *(const GAS v4u*)(PROJ + (size_t)(m + j - 2) * NPROJ + 1536 + c8);
                        const f32x4 w0 = *(const GAS f32x4*)(cw + j * 1024 + c8), w1 = *(const GAS f32x4*)(cw + j * 1024 + c8 + 4);
                        acc[0] += bflo(xv.x) * w0.x; acc[1] += bfhi(xv.x) * w0.y; acc[2] += bflo(xv.y) * w0.z; acc[3] += bfhi(xv.y) * w0.w;
                        acc[4] += bflo(xv.z) * w1.x; acc[5] += bfhi(xv.z) * w1.y; acc[6] += bflo(xv.w) * w1.z; acc[7] += bfhi(xv.w) * w1.w;
                    }
                }
#pragma unroll
                for (int q = 0; q < 8; ++q) acc[q] = acc[q] * sigmoidf_(acc[q]);
                v4u o; o.x = pk2(acc[0], acc[1]); o.y = pk2(acc[2], acc[3]); o.z = pk2(acc[4], acc[5]); o.w = pk2(acc[6], acc[7]);
                *(GAS v4u*)(HN + (size_t)m * 1024 + c8) = o;
            }
        }
        GRID_BAR();
        if (bid < 64) {
            PHASE_PTRS();
            const int b = bid >> 3, h = (bid >> 1) & 3, dir = bid & 1;
            const int f = tid & 127, eg = tid >> 7;
            LAS float* sq = (LAS float*)lds;
            LAS float* sk = sq + 8 * 128;
            LAS float* sv = sk + 8 * 128;
            LAS float* sg = sv + 8 * 128;
            LAS float* part = sg + 64;
            LAS float* dpart = part + 8 * 4 * 128;
            LAS float* mm = dpart + 64;
            float C[32], nn[32];
#pragma unroll
            for (int i = 0; i < 32; ++i) { C[i] = 0.f; nn[i] = 0.f; }
            float mst = 0.f;
            bf16* Hout = HFB + (size_t)dir * M * MW;
            for (int s0 = 0; s0 < SEQ; s0 += 8) {
                for (int i = tid; i < 3 * 8 * 128; i += NTHR) {
                    const int which = i >> 10, tk = (i >> 7) & 7, d = i & 127;
                    const int s = s0 + tk, pos = dir ? (SEQ - 1 - s) : s; const size_t m = (size_t)b * SEQ + pos;
                    float val;
                    if (which == 0) val = bf2f(HN[m * 1024 + h * 128 + d]);
                    else if (which == 1) val = bf2f(HN[m * 1024 + 512 + h * 128 + d]) * 0.08838834764831845f;
                    else val = bf2f(PROJ[m * NPROJ + 2560 + h * 128 + d]);
                    sq[i] = val;
                }
                if (tid < 16) {
                    const int tk = tid >> 1, w = tid & 1; const int s = s0 + tk, pos = dir ? (SEQ - 1 - s) : s; const size_t m = (size_t)b * SEQ + pos;
                    const float gv = GATES[m * 16 + (2 * dir + w) * 4 + h];
                    sg[tid] = w ? log_sigmoid(gv) : gv;
                }
                __syncthreads();
#pragma unroll 1
                for (int tk = 0; tk < 8; ++tk) {
                    const float li = sg[2 * tk], lf = sg[2 * tk + 1];
                    const float mnew = fmaxf(lf + mst, li);
                    const float ad = __expf(lf + mst - mnew), bb = __expf(li - mnew);
                    mst = mnew;
                    const float vf = sv[tk * 128 + f] * bb;
                    float pn = 0.f, pd = 0.f;
#pragma unroll
                    for (int i4 = 0; i4 < 8; ++i4) {
                        const f32x4 k4 = *(const LAS f32x4*)(sk + tk * 128 + eg * 32 + 4 * i4);
                        const f32x4 q4 = *(const LAS f32x4*)(sq + tk * 128 + eg * 32 + 4 * i4);
#pragma unroll
                        for (int c = 0; c < 4; ++c) {
                            const int i = 4 * i4 + c;
                            C[i] = ad * C[i] + k4[c] * vf;
                            nn[i] = ad * nn[i] + k4[c] * bb;
                            pn += C[i] * q4[c]; pd += nn[i] * q4[c];
                        }
                    }
                    part[(tk * 4 + eg) * 128 + f] = pn;
                    if (f == 0) dpart[tk * 4 + eg] = pd;
                    if (tid == 0) mm[tk] = mst;
                }
                __syncthreads();
                for (int i = tid; i < 8 * 128; i += NTHR) {
                    const int tk = i >> 7, ff = i & 127;
                    const float num = (part[(tk * 4 + 0) * 128 + ff] + part[(tk * 4 + 1) * 128 + ff]) + (part[(tk * 4 + 2) * 128 + ff] + part[(tk * 4 + 3) * 128 + ff]);
                    const float den = (dpart[tk * 4 + 0] + dpart[tk * 4 + 1]) + (dpart[tk * 4 + 2] + dpart[tk * 4 + 3]);
                    const float hv = num / fmaxf(fabsf(den), __expf(-mm[tk]));
                    const int s = s0 + tk, pos = dir ? (SEQ - 1 - s) : s; const size_t m = (size_t)b * SEQ + pos;
                    Hout[m * MW + h * 128 + ff] = (bf16)f2bf(hv);
                }
                __syncthreads();
            }
        } else {
            PHASE_PTRS();
            const int NA = G - 64;
            for (int u = bid - 64; u < BATCH * AH * 4; u += NA) {
                const int b = u >> 5, h = (u >> 2) & 7, p = (u & 3) * 512 + tid;
                bf16* base = PROJ + (size_t)b * SEQ * NPROJ + h * 64;
                float q[64], acc[64];
                {
                    const GAS v4u* qp = (const GAS v4u*)(base + (size_t)p * NPROJ);
#pragma unroll
                    for (int i = 0; i < 8; ++i) { const v4u w = qp[i]; q[8 * i + 0] = bflo(w.x); q[8 * i + 1] = bfhi(w.x); q[8 * i + 2] = bflo(w.y); q[8 * i + 3] = bfhi(w.y);
                        q[8 * i + 4] = bflo(w.z); q[8 * i + 5] = bfhi(w.z); q[8 * i + 6] = bflo(w.w); q[8 * i + 7] = bfhi(w.w); }
                }
#pragma unroll
                for (int i = 0; i < 64; ++i) acc[i] = 0.f;
                float mx = -1e30f, l = 0.f;
#pragma unroll 1
                for (int br = 0; br < 3; ++br) {
                    const int r = br == 0 ? 1 : (br == 1 ? 4 : 16);
#pragma unroll 1
                    for (int j = -64; j <= 64; ++j) {
                        const int kp = p + j * r;
                        if (kp >= 0 && kp < SEQ) {
                            const GAS v4u* kr = (const GAS v4u*)(base + (size_t)kp * NPROJ + 512);
                            float s = 0.f;
#pragma unroll
                            for (int i = 0; i < 8; ++i) { const v4u w = kr[i];
                                s += q[8 * i + 0] * bflo(w.x) + q[8 * i + 1] * bfhi(w.x) + q[8 * i + 2] * bflo(w.y) + q[8 * i + 3] * bfhi(w.y)
                                   + q[8 * i + 4] * bflo(w.z) + q[8 * i + 5] * bfhi(w.z) + q[8 * i + 6] * bflo(w.w) + q[8 * i + 7] * bfhi(w.w); }
                            if (s > mx) { const float corr = __expf(mx - s); l *= corr;
#pragma unroll
                                for (int i = 0; i < 64; ++i) acc[i] *= corr;
                                mx = s; }
                            const float pw = __expf(s - mx); l += pw;
                            const GAS v4u* vr = (const GAS v4u*)(base + (size_t)kp * NPROJ + 1024);
#pragma unroll
                            for (int i = 0; i < 8; ++i) { const v4u w = vr[i];
                                acc[8 * i + 0] += pw * bflo(w.x); acc[8 * i + 1] += pw * bfhi(w.x); acc[8 * i + 2] += pw * bflo(w.y); acc[8 * i + 3] += pw * bfhi(w.y);
                                acc[8 * i + 4] += pw * bflo(w.z); acc[8 * i + 5] += pw * bfhi(w.z); acc[8 * i + 6] += pw * bflo(w.w); acc[8 * i + 7] += pw * bfhi(w.w); }
                        }
                    }
                }
                const float il = 1.f / l;
                GAS v4u* op = (GAS v4u*)(base + (size_t)p * NPROJ);
#pragma unroll
                for (int i = 0; i < 8; ++i) { v4u w; w.x = pk2(acc[8 * i + 0] * il, acc[8 * i + 1] * il); w.y = pk2(acc[8 * i + 2] * il, acc[8 * i + 3] * il);
                    w.z = pk2(acc[8 * i + 4] * il, acc[8 * i + 5] * il); w.w = pk2(acc[8 * i + 6] * il, acc[8 * i + 7] * il); op[i] = w; }
            }
        }
        GRID_BAR();
        {
            PHASE_PTRS();
            const float* hg = a.head_g + (size_t)l * MW;
            for (int m = gw; m < M; m += NGW) {
                const v4u ao = *(const GAS v4u*)(PROJ + (size_t)m * NPROJ + 8 * lane);
                *(GAS v4u*)(HN + (size_t)m * 1024 + 8 * lane) = ao;
                const v4u hf = *(const GAS v4u*)(HFB + (size_t)m * MW + 8 * lane), hb = *(const GAS v4u*)(HFB + (size_t)M * MW + (size_t)m * MW + 8 * lane);
                const v4u mo = *(const GAS v4u*)(PROJ + (size_t)m * NPROJ + 3072 + 8 * lane);
                float hm[8] = {bflo(hf.x) + bflo(hb.x), bfhi(hf.x) + bfhi(hb.x), bflo(hf.y) + bflo(hb.y), bfhi(hf.y) + bfhi(hb.y),
                               bflo(hf.z) + bflo(hb.z), bfhi(hf.z) + bfhi(hb.z), bflo(hf.w) + bflo(hb.w), bfhi(hf.w) + bfhi(hb.w)};
                float ov[8] = {bflo(mo.x), bfhi(mo.x), bflo(mo.y), bfhi(mo.y), bflo(mo.z), bfhi(mo.z), bflo(mo.w), bfhi(mo.w)};
                float s = 0.f;
#pragma unroll
                for (int q = 0; q < 8; ++q) s += hm[q] * hm[q];
                s += __shfl_xor(s, 1); s += __shfl_xor(s, 2); s += __shfl_xor(s, 4); s += __shfl_xor(s, 8);
                const float rs = 1.0f / sqrtf(s * (1.f / 128.f) + EPS);
                const f32x4 g0 = *(const GAS f32x4*)(hg + 8 * lane), g1 = *(const GAS f32x4*)(hg + 8 * lane + 4);
                const float gg[8] = {g0.x, g0.y, g0.z, g0.w, g1.x, g1.y, g1.z, g1.w};
                float o[8];
#pragma unroll
                for (int q = 0; q < 8; ++q) o[q] = hm[q] * rs * gg[q] * sigmoidf_(ov[q]);
                v4u w; w.x = pk2(o[0], o[1]); w.y = pk2(o[2], o[3]); w.z = pk2(o[4], o[5]); w.w = pk2(o[6], o[7]);
                *(GAS v4u*)(HN + (size_t)m * 1024 + 512 + 8 * lane) = w;
            }
        }
        GRID_BAR();
        {
            PHASE_PTRS();
            pg8::Gemm g{HN, Wout_t + (size_t)l * DM * DM, M, DM, DM}; pg8::StaticOrder S; S.init(M, DM, G, bid);
            pg8::EpiF32 E{T, DM, nullptr};
            pg8::gemm_phase<pg8::EpiF32, pg8::StaticOrder, true, true>(lds, g, S, E);
        }
        GRID_BAR();
        {
            PHASE_PTRS();
            f32x4 g1[4], g2[4];
#pragma unroll
            for (int j = 0; j < 4; ++j) { g1[j] = ((const GAS f32x4*)(a.mix_post_g + (size_t)l * DM))[lane + 64 * j]; g2[j] = ((const GAS f32x4*)(a.ffn_pre_g + (size_t)l * DM))[lane + 64 * j]; }
            const float* xin = (l == 0) ? a.x : R;
            for (int m = gw; m < M; m += NGW) {
                f32x4 v[4], xb[4];
#pragma unroll
                for (int j = 0; j < 4; ++j) { v[j] = ((const GAS f32x4*)(T + (size_t)m * DM))[lane + 64 * j]; xb[j] = ((const GAS f32x4*)(xin + (size_t)m * DM))[lane + 64 * j]; }
                rms_row(v, g1);
#pragma unroll
                for (int j = 0; j < 4; ++j) { v[j] = v[j] + xb[j]; ((GAS f32x4*)(R + (size_t)m * DM))[lane + 64 * j] = v[j]; }
                rms_row(v, g2);
                store_row_bf16(HN + (size_t)m * DM, v, lane);
            }
        }
        GRID_BAR();
        for (int qd = 0; qd < 4; ++qd) {
            PHASE_PTRS();
            {
                pg8::Gemm g{HN + (size_t)qd * 4096 * DM, Wup_t + (size_t)l * NUP * DM, 4096, NUP, DM}; pg8::StaticOrder S; S.init(4096, NUP, G, bid);
                pg8::EpiBf16<0> E{UB, NUP, nullptr, 0, 0, 1.f};
                pg8::gemm_phase<pg8::EpiBf16<0>, pg8::StaticOrder, true, true>(lds, g, S, E);
            }
            GRID_BAR();
            {
                const float* cw = a.fconv_w + (size_t)l * 3 * NUP; const float* cb = a.fconv_b + (size_t)l * NUP;
                for (int i = gt; i < 4096 * (DFF / 8); i += NGT) {
                    const int t = i / (DFF / 8), c8 = (i % (DFF / 8)) * 8, pos = t & (SEQ - 1);
                    float ga[8], va[8];
                    { const f32x4 b0 = *(const GAS f32x4*)(cb + c8), b1 = *(const GAS f32x4*)(cb + c8 + 4), b2 = *(const GAS f32x4*)(cb + DFF + c8), b3 = *(const GAS f32x4*)(cb + DFF + c8 + 4);
                      ga[0] = b0.x; ga[1] = b0.y; ga[2] = b0.z; ga[3] = b0.w; ga[4] = b1.x; ga[5] = b1.y; ga[6] = b1.z; ga[7] = b1.w;
                      va[0] = b2.x; va[1] = b2.y; va[2] = b2.z; va[3] = b2.w; va[4] = b3.x; va[5] = b3.y; va[6] = b3.z; va[7] = b3.w; }
#pragma unroll
                    for (int j = 0; j < 3; ++j) {
                        const int pp = pos + j - 1;
                        if (pp >= 0 && pp < SEQ) {
                            const v4u xg = *(const GAS v4u*)(UB + (size_t)(t + j - 1) * NUP + c8), xv = *(const GAS v4u*)(UB + (size_t)(t + j - 1) * NUP + DFF + c8);
                            const f32x4 w0 = *(const GAS f32x4*)(cw + j * NUP + c8), w1 = *(const GAS f32x4*)(cw + j * NUP + c8 + 4);
                            const f32x4 w2 = *(const GAS f32x4*)(cw + j * NUP + DFF + c8), w3 = *(const GAS f32x4*)(cw + j * NUP + DFF + c8 + 4);
                            ga[0] += bflo(xg.x) * w0.x; ga[1] += bfhi(xg.x) * w0.y; ga[2] += bflo(xg.y) * w0.z; ga[3] += bfhi(xg.y) * w0.w;
                            ga[4] += bflo(xg.z) * w1.x; ga[5] += bfhi(xg.z) * w1.y; ga[6] += bflo(xg.w) * w1.z; ga[7] += bfhi(xg.w) * w1.w;
                            va[0] += bflo(xv.x) * w2.x; va[1] += bfhi(xv.x) * w2.y; va[2] += bflo(xv.y) * w2.z; va[3] += bfhi(xv.y) * w2.w;
                            va[4] += bflo(xv.z) * w3.x; va[5] += bfhi(xv.z) * w3.y; va[6] += bflo(xv.w) * w3.z; va[7] += bfhi(xv.w) * w3.w;
                        }
                    }
                    float o[8];
#pragma unroll
                    for (int q = 0; q < 8; ++q) o[q] = gelu_tanh(ga[q]) * va[q];
                    v4u w; w.x = pk2(o[0], o[1]); w.y = pk2(o[2], o[3]); w.z = pk2(o[4], o[5]); w.w = pk2(o[6], o[7]);
                    *(GAS v4u*)(HB16 + (size_t)(qd * 4096 + t) * DFF + c8) = w;
                }
            }
            GRID_BAR();
        }
        {
            PHASE_PTRS();
            pg8::Gemm g{HB16, Wdn_t + (size_t)l * DM * DFF, M, DM, DFF}; pg8::StaticOrder S; S.init(M, DM, G, bid);
            pg8::EpiF32 E{T, DM, nullptr};
            pg8::gemm_phase<pg8::EpiF32, pg8::StaticOrder, true, true>(lds, g, S, E);
        }
        GRID_BAR();
        {
            PHASE_PTRS();
            const bool more = (l + 1 < DEPTH);
            LAS float* wg = (LAS float*)lds;
            if (more) {
                const float* w_in_n = a.w_in + (size_t)(l + 1) * DM * PROJ_COLS;
                for (int i = tid; i < DM * 16; i += NTHR) wg[i] = w_in_n[(size_t)(i >> 4) * PROJ_COLS + NPROJ + (i & 15)];
                __syncthreads();
            }
            f32x4 g1[4], g2[4];
#pragma unroll
            for (int j = 0; j < 4; ++j) { g1[j] = ((const GAS f32x4*)(a.ffn_post_g + (size_t)l * DM))[lane + 64 * j];
                g2[j] = more ? ((const GAS f32x4*)(a.mix_pre_g + (size_t)(l + 1) * DM))[lane + 64 * j] : (f32x4){0.f, 0.f, 0.f, 0.f}; }
            for (int m = gw; m < M; m += NGW) {
                f32x4 v[4], xb[4];
#pragma unroll
                for (int j = 0; j < 4; ++j) { v[j] = ((const GAS f32x4*)(T + (size_t)m * DM))[lane + 64 * j]; xb[j] = ((const GAS f32x4*)(R + (size_t)m * DM))[lane + 64 * j]; }
                rms_row(v, g1);
#pragma unroll
                for (int j = 0; j < 4; ++j) { v[j] = v[j] + xb[j]; ((GAS f32x4*)(R + (size_t)m * DM))[lane + 64 * j] = v[j]; }
                if (more) {
                    rms_row(v, g2);
                    store_row_bf16(HN + (size_t)m * DM, v, lane);
                    gates_row(v, wg, a.gate_b + (l + 1) * 16, GATES + (size_t)m * 16, lane);
                }
            }
            __syncthreads();
        }
    }
}

extern "C" void kernel_launch(void* const* d_in, const int* in_sizes, int n_in, void* d_out, int out_size, void* d_ws, size_t ws_size, hipStream_t stream) {
    static int grid = 0;
    if (grid == 0) {
        if (n_in != 15 || in_sizes[0] != M * DM || out_size != M * DM || ws_size < WS_END) { fprintf(stderr, "kernel_launch: unexpected shapes n_in %d in0 %d out %d ws %zu\n", n_in, n_in > 0 ? in_sizes[0] : -1, out_size, ws_size); grid = -1; return; }
        int dev = 0, cus = 0, per_cu = 0;
        hipGetDevice(&dev); hipDeviceGetAttribute(&cus, hipDeviceAttributeMultiprocessorCount, dev);
        if (hipFuncSetAttribute((const void*)hybrid_fwd, hipFuncAttributeMaxDynamicSharedMemorySize, LDS_BYTES) != hipSuccess) { fprintf(stderr, "kernel_launch: hipFuncSetAttribute failed\n"); grid = -1; return; }
        if (hipOccupancyMaxActiveBlocksPerMultiprocessor(&per_cu, (const void*)hybrid_fwd, NTHR, LDS_BYTES) != hipSuccess || per_cu < 1) { fprintf(stderr, "kernel_launch: occupancy query says %d\n", per_cu); per_cu = 1; }
        (void)hipGetLastError();
        grid = cus;
        if (grid > 256) grid = 256;
    }
    if (grid < 0) return;
    if (hipMemsetAsync((char*)d_ws + WS_CTL, 0, CTL_ZERO_BYTES, stream) != hipSuccess) { fprintf(stderr, "kernel_launch: memset failed\n"); return; }
    Args a{};
    a.x = (const float*)d_in[0]; a.mix_pre_g = (const float*)d_in[1]; a.w_in = (const float*)d_in[2]; a.mconv_w = (const float*)d_in[3]; a.mconv_b = (const float*)d_in[4];
    a.gate_b = (const float*)d_in[5]; a.head_g = (const float*)d_in[6]; a.w_out = (const float*)d_in[7]; a.mix_post_g = (const float*)d_in[8]; a.ffn_pre_g = (const float*)d_in[9];
    a.w_up = (const float*)d_in[10]; a.fconv_w = (const float*)d_in[11]; a.fconv_b = (const float*)d_in[12]; a.w_down = (const float*)d_in[13]; a.ffn_post_g = (const float*)d_in[14];
    a.out = (float*)d_out; a.ws = (unsigned char*)d_ws;
    void* args[] = {&a};
    hipError_t e = hipLaunchCooperativeKernel((const void*)hybrid_fwd, dim3(grid), dim3(NTHR), args, LDS_BYTES, stream);
    if (e != hipSuccess) fprintf(stderr, "cooperative launch failed: %s (grid %d)\n", hipGetErrorString(e), grid);
}
```

```cpp
#include <hip/hip_runtime.h>
#include <hip/hip_cooperative_groups.h>
#include <cstdio>
#include <cstdint>
namespace cg = cooperative_groups;
namespace pg8 {
#define PG8_LAS __attribute__((address_space(3)))
typedef unsigned short bf16_t;
typedef short bf16x8 __attribute__((ext_vector_type(8)));
typedef float f32x4 __attribute__((ext_vector_type(4)));
typedef unsigned u32x4 __attribute__((ext_vector_type(4)));
constexpr int BM = 256, BK = 64, HALF = 128, HTB = HALF * BK * 2  , STAGE_BYTES = 8 * HTB, NXCD = 8, WGM = 8;

__host__ __device__ __forceinline__ int lds_byte(int r, int c) { const int st = (r >> 4) * 2 + (c >> 5), rr = r & 15, cc = c & 31, ob = rr * 64 + cc * 2; return st * 1024 + (ob ^ (((ob >> 9) & 1) << 5)); }
__host__ __device__ __forceinline__ void stage_rc(int b, int& R, int& C) { const int st = b / 1024, sb = b % 1024, swz = sb ^ (((sb >> 9) & 1) << 5); R = (st >> 1) * 16 + swz / 64; C = (st & 1) * 32 + (swz % 64) / 2; }
__host__ __device__ __forceinline__ int perm32(int rho) { const int n = rho >> 4, i = rho & 15; return 8 * (i >> 2) + 4 * n + (i & 3); }

struct Unit { int pm, pn; };
struct Gemm { const bf16_t* A; const bf16_t* Bt; int M, N, K; };

struct StaticOrder {
    int nM, nN, nwg, G, c;
    __host__ __device__ void init(int M, int N, int G_, int c_) { nM = M / BM; nN = N / BM; nwg = nM * nN; G = G_; c = c_; }
    __host__ __device__ bool next(int i, Unit& u) const {
        const long L = (long)i * G + c; if (L >= nwg) return false;
        int wgid = (int)L; { const int q = nwg / NXCD, r = nwg % NXCD, xcd = wgid % NXCD, off = wgid / NXCD; wgid = (xcd < r ? xcd * (q + 1) : r * (q + 1) + (xcd - r) * q) + off; }
        const int nig = WGM * nN, gid = wgid / nig, fm = gid * WGM, gsz = (nM - fm) < WGM ? (nM - fm) : WGM;
        u.pm = fm + ((wgid % nig) % gsz); u.pn = (wgid % nig) / gsz; return true;
    }
    __device__ __forceinline__ void a_ready(const Unit&) const {}
    __device__ __forceinline__ void done(const Unit&) const {}
};

__device__ __forceinline__ unsigned cvt_pk_bf16(float lo, float hi) { unsigned r; asm volatile("v_cvt_pk_bf16_f32 %0, %1, %2" : "=v"(r) : "v"(lo), "v"(hi)); return r; }
typedef float f32x2 __attribute__((ext_vector_type(2)));
__device__ __forceinline__ f32x2 gelu_pk(f32x2 v) {
    const f32x2 av = __builtin_elementwise_abs(v), d = av * 0.2316418882f + 1.0f;
    f32x2 t; t.x = __builtin_amdgcn_rcpf(d.x); t.y = __builtin_amdgcn_rcpf(d.y);
    f32x2 q = t * 0.5307027145f + (-0.7265760135f); q = q * t + 0.7107068705f; q = q * t + (-0.142248368f); q = q * t + 0.127414796f; q = q * t;
    const f32x2 s = (v * v) * (-0.72134752044f);
    f32x2 e; e.x = __builtin_amdgcn_exp2f(s.x); e.y = __builtin_amdgcn_exp2f(s.y);
    const f32x2 m = v * (q * e), r = v - m;
    f32x2 o; o.x = v.x < 0.f ? m.x : r.x; o.y = v.y < 0.f ? m.y : r.y; return o;
}

template <int ACT  > struct EpiBf16 {
    static constexpr bool PERM = true, AFTER_DRAIN = false; static_assert(ACT == 0 || ACT == 1, "EpiBf16: ACT is 0 (none) or 1 (gelu_pk)");
    bf16_t* O; int ldc; const float* bias; int split_cols; size_t split_stride; float scale0;
    __device__ __forceinline__ void operator()(const f32x4 (&acc)[2][2][4][2], const Unit& u, int wr, int wc, int fr, int fq) const {
        const int row0 = u.pm * BM + wr * 64 + fr; int colt = u.pn * BM; bf16_t* base = O;
        float sc = 1.f; if (split_cols) { const int t = colt / split_cols; base += (size_t)t * split_stride; colt -= t * split_cols; if (t == 0) sc = scale0; }
        const int col0 = colt + wc * 32 + 8 * fq, bcol0 = u.pn * BM + wc * 32 + 8 * fq;
        f32x4 bv[2][2];
#pragma unroll
        for (int bj = 0; bj < 2; ++bj)
#pragma unroll
            for (int n = 0; n < 2; ++n) bv[bj][n] = bias ? *(const f32x4*)(bias + bcol0 + bj * HALF + 4 * n) : (f32x4){0.f, 0.f, 0.f, 0.f};
#pragma unroll
        for (int ai = 0; ai < 2; ++ai)
#pragma unroll
            for (int m = 0; m < 4; ++m) { bf16_t* rowp = base + (size_t)(row0 + ai * HALF + m * 16) * ldc + col0;
#pragma unroll
                for (int bj = 0; bj < 2; ++bj) { f32x4 v0 = acc[ai][bj][m][0] + bv[bj][0], v1 = acc[ai][bj][m][1] + bv[bj][1];
                    if (ACT == 1) { f32x2 a = gelu_pk((f32x2){v0[0], v0[1]}), b = gelu_pk((f32x2){v0[2], v0[3]}), c = gelu_pk((f32x2){v1[0], v1[1]}), d = gelu_pk((f32x2){v1[2], v1[3]});
                        v0 = (f32x4){a.x, a.y, b.x, b.y}; v1 = (f32x4){c.x, c.y, d.x, d.y}; }
                    v0 = v0 * sc; v1 = v1 * sc; u32x4 w; w.x = cvt_pk_bf16(v0[0], v0[1]); w.y = cvt_pk_bf16(v0[2], v0[3]); w.z = cvt_pk_bf16(v1[0], v1[1]); w.w = cvt_pk_bf16(v1[2], v1[3]);
                    *(u32x4*)(rowp + bj * HALF) = w; } }
    }
};
struct EpiF32 {
    static constexpr bool PERM = false, AFTER_DRAIN = false;
    float* C; int ldc; const float* bias;
    __device__ __forceinline__ void operator()(const f32x4 (&acc)[2][2][4][2], const Unit& u, int wr, int wc, int fr, int fq) const {
        const int row0 = u.pm * BM + wr * 64 + fr, col0 = u.pn * BM + wc * 32 + 4 * fq;
        f32x4 bv[2][2];
#pragma unroll
        for (int bj = 0; bj < 2; ++bj)
#pragma unroll
            for (int n = 0; n < 2; ++n) bv[bj][n] = bias ? *(const f32x4*)(bias + col0 + bj * HALF + n * 16) : (f32x4){0.f, 0.f, 0.f, 0.f};
#pragma unroll
        for (int ai = 0; ai < 2; ++ai)
#pragma unroll
            for (int m = 0; m < 4; ++m) { float* rowp = C + (size_t)(row0 + ai * HALF + m * 16) * ldc + col0;
#pragma unroll
                for (int bj = 0; bj < 2; ++bj)
#pragma unroll
                    for (int n = 0; n < 2; ++n) *(f32x4*)(rowp + bj * HALF + n * 16) = acc[ai][bj][m][n] + bv[bj][n]; }
    }
};
template <class Epi, class Sched, bool ALIGN_EPI = false, bool SP2 = false>
__device__ __forceinline__ void gemm_phase(PG8_LAS unsigned char* lds, const Gemm g, const Sched& S, const Epi& E) {
    int tid_ = threadIdx.x; asm volatile("" : "+v"(tid_));
    const int tid = tid_, wid = __builtin_amdgcn_readfirstlane(tid >> 6), lane = tid & 63, wr = wid >> 2, wc = wid & 3, fr = lane & 15, fq = lane >> 4;
    const int K = g.K, nt = K / BK;
    unsigned voffA[2], voffB[2];
#pragma unroll
    for (int i = 0; i < 2; ++i) { int R, C; stage_rc(tid * 16 + i * 8192, R, C); const int Rb = Epi::PERM ? ((R & ~31) + perm32(R & 31)) : R;
        voffA[i] = (unsigned)(R * K + C) * 2u; voffB[i] = (unsigned)(Rb * K + C) * 2u; }
    const size_t kstep = (size_t)(BK * 2);
    const size_t hstep = (size_t)HALF * K * 2;
    const size_t tstep = 2 * hstep;
    const unsigned ldsw = (unsigned)wid * 1024u;
    const int aoff = lds_byte(wr * 64 + fr, fq * 8), boff = lds_byte(wc * 32 + fr, fq * 8);
#define PG8_SA(b, h) (((b) * 2 + (h)) * HTB)
#define PG8_SB(b, h) ((4 + (b) * 2 + (h)) * HTB)
#define PG8_STAGE(bufoff, gbase, voff) do { _Pragma("unroll") for (int _i = 0; _i < 2; ++_i) \
        __builtin_amdgcn_global_load_lds((const unsigned*)((const char*)(gbase) + (voff)[_i]), (PG8_LAS unsigned*)(lds + (bufoff) + ldsw + _i * 8192), 16, 0, 0); } while (0)
#define PG8_LDA(dst, b, h) do { _Pragma("unroll") for (int m = 0; m < 4; ++m) _Pragma("unroll") for (int k = 0; k < 2; ++k) dst[m][k] = *(const PG8_LAS bf16x8*)(lds + PG8_SA(b, h) + aoff + m * 2048 + k * 1024); } while (0)
#define PG8_LDB(dst, b, h) do { _Pragma("unroll") for (int n = 0; n < 2; ++n) _Pragma("unroll") for (int k = 0; k < 2; ++k) dst[n][k] = *(const PG8_LAS bf16x8*)(lds + PG8_SB(b, h) + boff + n * 2048 + k * 1024); } while (0)
#define PG8_MMA(ai, bj, At, Bt) do { __builtin_amdgcn_s_setprio(1); _Pragma("unroll") for (int m = 0; m < 4; ++m) _Pragma("unroll") for (int n = 0; n < 2; ++n) _Pragma("unroll") for (int k = 0; k < 2; ++k) \
        acc[ai][bj][m][n] = __builtin_amdgcn_mfma_f32_16x16x32_bf16(Bt[n][k], At[m][k], acc[ai][bj][m][n], 0, 0, 0); __builtin_amdgcn_s_setprio(0); } while (0)
#define PG8_WAIT_V(n) asm volatile("s_waitcnt vmcnt(" #n ")" ::: "memory")
#define PG8_WAIT_L(n) asm volatile("s_waitcnt lgkmcnt(" #n ")" ::: "memory")
#define PG8_BAR __builtin_amdgcn_s_barrier()
#define PG8_SCHED __builtin_amdgcn_sched_barrier(0)
    Unit cur, nxt; int ui = 0;
    if (!S.next(0, cur)) return;
    f32x4 acc[2][2][4][2];
#pragma unroll
    for (int a = 0; a < 2; ++a)
#pragma unroll
        for (int b = 0; b < 2; ++b)
#pragma unroll
            for (int m = 0; m < 4; ++m)
#pragma unroll
                for (int n = 0; n < 2; ++n) acc[a][b][m][n] = (f32x4){0.f, 0.f, 0.f, 0.f};
    bf16x8 At[4][2], B0[2][2], B1[2][2];
    const char* cA = (const char*)g.A + (size_t)cur.pm * tstep; const char* cB = (const char*)g.Bt + (size_t)cur.pn * tstep;
    S.a_ready(cur);
    if constexpr (SP2) {
        PG8_STAGE(PG8_SB(0, 0), cB, voffB); PG8_STAGE(PG8_SB(0, 1), cB + hstep, voffB); PG8_STAGE(PG8_SA(0, 0), cA, voffA); PG8_STAGE(PG8_SA(0, 1), cA + hstep, voffA);
        if (wr == 1) PG8_BAR;
        PG8_WAIT_V(2); PG8_BAR;
        PG8_STAGE(PG8_SB(1, 0), cB + kstep, voffB); PG8_STAGE(PG8_SA(1, 0), cA + kstep, voffA); PG8_STAGE(PG8_SB(1, 1), cB + hstep + kstep, voffB);
        PG8_WAIT_V(6); PG8_BAR;
    } else {
        PG8_STAGE(PG8_SB(0, 0), cB, voffB); PG8_STAGE(PG8_SA(0, 0), cA, voffA); PG8_STAGE(PG8_SB(0, 1), cB + hstep, voffB); PG8_STAGE(PG8_SA(0, 1), cA + hstep, voffA);
        if (wr == 1) PG8_BAR;
        PG8_WAIT_V(4); PG8_BAR;
        PG8_STAGE(PG8_SB(1, 0), cB + kstep, voffB); PG8_STAGE(PG8_SA(1, 0), cA + kstep, voffA); PG8_STAGE(PG8_SB(1, 1), cB + hstep + kstep, voffB);
        PG8_WAIT_V(6); PG8_BAR;
    }
    for (;;) {
        const bool has_next = S.next(ui + 1, nxt);
        const char* nA = has_next ? (const char*)g.A + (size_t)nxt.pm * tstep : cA; const char* nB = has_next ? (const char*)g.Bt + (size_t)nxt.pn * tstep : cB;
        for (int t = 0; t < nt; t += 2) {
            const bool last = (t == nt - 2);
            const char* a1 = cA + (size_t)(t + 1) * kstep;
            const char* a2 = last ? nA : cA + (size_t)(t + 2) * kstep; const char* b2 = last ? nB : cB + (size_t)(t + 2) * kstep;
            const char* a3 = a2 + kstep; const char* b3 = b2 + kstep;
            if (last && has_next) S.a_ready(nxt);
            if constexpr (SP2) {
            PG8_LDB(B0, 0, 0); PG8_LDB(B1, 0, 1); PG8_SCHED; PG8_LDA(At, 0, 0); PG8_STAGE(PG8_SA(1, 1), a1 + hstep, voffA);
            PG8_WAIT_V(8); PG8_WAIT_L(0); PG8_BAR; PG8_MMA(0, 0, At, B0); PG8_MMA(0, 1, At, B1); PG8_BAR; PG8_SCHED;
            PG8_LDA(At, 0, 1); PG8_STAGE(PG8_SB(0, 0), b2, voffB); PG8_STAGE(PG8_SB(0, 1), b2 + hstep, voffB); PG8_STAGE(PG8_SA(0, 0), a2, voffA);
            PG8_WAIT_V(8); PG8_WAIT_L(0); PG8_BAR; PG8_MMA(1, 0, At, B0); PG8_MMA(1, 1, At, B1); PG8_BAR; PG8_SCHED;
            PG8_LDB(B0, 1, 0); PG8_LDB(B1, 1, 1); PG8_SCHED; PG8_LDA(At, 1, 0); PG8_STAGE(PG8_SA(0, 1), a2 + hstep, voffA);
            PG8_WAIT_V(8); PG8_WAIT_L(0); PG8_BAR; PG8_MMA(0, 0, At, B0); PG8_MMA(0, 1, At, B1); PG8_BAR; PG8_SCHED;
            PG8_LDA(At, 1, 1); PG8_STAGE(PG8_SB(1, 0), b3, voffB); PG8_STAGE(PG8_SB(1, 1), b3 + hstep, voffB); PG8_STAGE(PG8_SA(1, 0), a3, voffA);
            PG8_WAIT_V(8); PG8_WAIT_L(0); PG8_BAR; PG8_MMA(1, 0, At, B0); PG8_MMA(1, 1, At, B1); PG8_BAR; PG8_SCHED;
            } else {
            PG8_LDB(B0, 0, 0); PG8_SCHED; PG8_LDA(At, 0, 0); PG8_STAGE(PG8_SA(1, 1), a1 + hstep, voffA);
            PG8_WAIT_L(8); PG8_BAR; PG8_WAIT_L(0); PG8_MMA(0, 0, At, B0); PG8_BAR; PG8_SCHED;
            PG8_LDB(B1, 0, 1); PG8_STAGE(PG8_SB(0, 0), b2, voffB);
            PG8_BAR; PG8_WAIT_L(0); PG8_MMA(0, 1, At, B1); PG8_BAR;
            PG8_LDA(At, 0, 1); PG8_STAGE(PG8_SA(0, 0), a2, voffA);
            PG8_BAR; PG8_WAIT_L(0); PG8_MMA(1, 0, At, B0); PG8_BAR; PG8_SCHED;
            PG8_STAGE(PG8_SB(0, 1), b2 + hstep, voffB);
            PG8_WAIT_V(6); PG8_BAR; PG8_MMA(1, 1, At, B1); PG8_BAR;
            PG8_LDB(B0, 1, 0); PG8_SCHED; PG8_LDA(At, 1, 0); PG8_STAGE(PG8_SA(0, 1), a2 + hstep, voffA);
            PG8_WAIT_L(8); PG8_BAR; PG8_WAIT_L(0); PG8_MMA(0, 0, At, B0); PG8_BAR; PG8_SCHED;
            PG8_LDB(B1, 1, 1); PG8_STAGE(PG8_SB(1, 0), b3, voffB);
            PG8_BAR; PG8_WAIT_L(0); PG8_MMA(0, 1, At, B1); PG8_BAR;
            PG8_LDA(At, 1, 1); PG8_STAGE(PG8_SA(1, 0), a3, voffA);
            PG8_BAR; PG8_WAIT_L(0); PG8_MMA(1, 0, At, B0); PG8_BAR; PG8_SCHED;
            PG8_STAGE(PG8_SB(1, 1), b3 + hstep, voffB);
            PG8_WAIT_V(6); PG8_BAR; PG8_MMA(1, 1, At, B1); PG8_BAR;
            }
        }
        if constexpr (ALIGN_EPI) { if (wr == 0) PG8_BAR; }
        if constexpr (!Epi::AFTER_DRAIN) { E(acc, cur, wr, wc, fr, fq); S.done(cur); }
        if (!has_next) break;
#pragma unroll
        for (int a = 0; a < 2; ++a)
#pragma unroll
            for (int b = 0; b < 2; ++b)
#pragma unroll
                for (int m = 0; m < 4; ++m)
#pragma unroll
                    for (int n = 0; n < 2; ++n) acc[a][b][m][n] = (f32x4){0.f, 0.f, 0.f, 0.f};
        cur = nxt; cA = nA; cB = nB; ++ui;
        if constexpr (ALIGN_EPI) { if (wr == 1) PG8_BAR; }
    }
    PG8_WAIT_V(0);
    if constexpr (!ALIGN_EPI) { if (wr == 0) PG8_BAR; }
    PG8_BAR;
    if constexpr (Epi::AFTER_DRAIN) { E.fused(acc, cur, wr, wc, fr, fq, lds, wid, lane); S.done(cur); }
#undef PG8_SA
#undef PG8_SB
#undef PG8_STAGE
#undef PG8_LDA
#undef PG8_LDB
#undef PG8_MMA
#undef PG8_WAIT_V
#undef PG8_WAIT_L
#undef PG8_BAR
#undef PG8_SCHED
}
}
#define GAS __attribute__((address_space(1)))
#define LAS __attribute__((address_space(3)))
typedef unsigned short bf16;
typedef unsigned v4u __attribute__((ext_vector_type(4)));
typedef float f32x4 __attribute__((ext_vector_type(4)));
typedef short bf16x8 __attribute__((ext_vector_type(8)));
typedef GAS unsigned gu32;
typedef GAS unsigned long long gu64;
#define RLX_AGENT __ATOMIC_RELAXED, __HIP_MEMORY_SCOPE_AGENT
#define LDS_WAIT() asm volatile("s_waitcnt lgkmcnt(0)" ::: "memory")
#define VM_WAIT() asm volatile("s_waitcnt vmcnt(0)" ::: "memory")
__device__ __forceinline__ unsigned long long rt() { return __builtin_amdgcn_s_memrealtime(); }
__device__ __forceinline__ unsigned f2bf(float f) { unsigned u = __builtin_bit_cast(unsigned, f); return (u + 0x7fffu + ((u >> 16) & 1u)) >> 16; }
__device__ __forceinline__ unsigned pk2(float lo, float hi) { return f2bf(lo) | (f2bf(hi) << 16); }

#define XB_TMO      128
#define XB_XCNT(j)  (256  + 64 * (j))
#define XB_XSUB(j)  (1280 + 64 * (j))
#define XB_XGEN(j)  (2304 + 64 * (j))
#define XB_TOP      3328
#define XB_TOPGEN   3392
#define XCD_BAR_WORDS 3456
#define XB_SPIN_CAP (1u << 18)

__device__ __forceinline__ unsigned xb_ld(unsigned* p)              { return __hip_atomic_load(p, __ATOMIC_RELAXED, __HIP_MEMORY_SCOPE_AGENT); }
__device__ __forceinline__ unsigned xb_add(unsigned* p, unsigned v) { return __hip_atomic_fetch_add(p, v, __ATOMIC_RELAXED, __HIP_MEMORY_SCOPE_AGENT); }
__device__ __forceinline__ unsigned xb_xcc_id() { return (unsigned)__builtin_amdgcn_s_getreg((3 << 11) | 20) & 0xFu; }
#define XB_SPIN(cond, bar) do { unsigned _sp = 0; while (cond) { __builtin_amdgcn_s_sleep(1); \
    if ((++_sp & 255u) == 0u) { if (xb_ld(&(bar)[XB_TMO])) break; if (_sp > XB_SPIN_CAP) { atomicAdd(&(bar)[XB_TMO], 1u); break; } } } } while (0)

struct XcdBarrier {
    unsigned* bar; unsigned x;
    volatile LAS unsigned* st;
};

__device__ __forceinline__ XcdBarrier xcd_barrier_post(unsigned* bar, volatile LAS unsigned* st) {
    XcdBarrier b; b.bar = bar; b.x = xb_xcc_id(); b.st = st;
    if (threadIdx.x == 0) (void)xb_add(&bar[XB_XCNT(b.x)], 1u);
    return b;
}
__device__ __forceinline__ void xcd_barrier_complete(unsigned* bar, unsigned x, unsigned& nloc, unsigned& nx) {
    const unsigned G = gridDim.x * gridDim.y * gridDim.z;
    unsigned sum, cnt, mine, sp = 0u;
    for (;;) {
        sum = 0u; cnt = 0u; mine = 0u;
#pragma unroll
        for (unsigned j = 0; j < 16; ++j) { const unsigned c = xb_ld(&bar[XB_XCNT(j)]); sum += c; cnt += (c > 0u) ? 1u : 0u; mine = (j == x) ? c : mine; }
        if (sum == G) break;
        __builtin_amdgcn_s_sleep(1);
        if ((++sp & 255u) == 0u) { if (xb_ld(&bar[XB_TMO])) break; if (sp > XB_SPIN_CAP) { atomicAdd(&bar[XB_TMO], 1u); break; } }
    }
    nloc = mine > 0u ? mine : 1u; nx = cnt > 0u ? cnt : 1u;
}

__device__ __forceinline__ void xcd_barrier(const XcdBarrier& b) {
    asm volatile("s_waitcnt vmcnt(0)" ::: "memory");
    __syncthreads();
    if (threadIdx.x == 0) {
        unsigned* bar = b.bar;
        __builtin_amdgcn_s_waitcnt(0);
        unsigned nloc = b.st[0], nx = b.st[1];
        if (nloc == 0u) { xcd_barrier_complete(bar, b.x, nloc, nx); b.st[0] = nloc; b.st[1] = nx; }
        const unsigned old = xb_add(&bar[XB_XSUB(b.x)], 1u);
        const unsigned gen = old / nloc;
        if (old + 1u == (gen + 1u) * nloc) {
            __builtin_amdgcn_fence(__ATOMIC_RELEASE, "agent");
            asm volatile("s_waitcnt vmcnt(0)" ::: "memory");
            const unsigned og = xb_add(&bar[XB_TOP], 1u);
            const unsigned tg = og / nx;
            if (og + 1u == (tg + 1u) * nx) xb_add(&bar[XB_TOPGEN], 1u);
            else XB_SPIN(xb_ld(&bar[XB_TOPGEN]) == tg, bar);
            __builtin_amdgcn_fence(__ATOMIC_ACQUIRE, "agent");
            xb_add(&bar[XB_XGEN(b.x)], 1u);
            asm volatile("s_waitcnt vmcnt(0)" ::: "memory");
        } else {
            XB_SPIN(xb_ld(&bar[XB_XGEN(b.x)]) == gen, bar);
            __builtin_amdgcn_fence(__ATOMIC_ACQUIRE, "agent");
            asm volatile("s_waitcnt vmcnt(0)" ::: "memory");
        }
    }
    __syncthreads();
}

constexpr int NWAVES = 8, NTHR = 512;
constexpr int BATCH = 8, SEQ = 2048, DM = 1024, M = BATCH * SEQ, DEPTH = 2;
constexpr int AW = 512, AH = 8, AD = 64;
constexpr int MW = 512, MH = 4, MD = 128;
constexpr int PROJ_COLS = 3600, NPROJ = 3584;
constexpr int DFF = 2816, NUP = 2 * DFF;
constexpr float EPS = 1e-6f;
constexpr size_t MiB = 1u << 20;
constexpr size_t WS_CTL = 0, CTL_ZERO_BYTES = 1 * MiB;
constexpr size_t WS_WIN = 1 * MiB;
constexpr size_t WS_WOUT = 15 * MiB;
constexpr size_t WS_WUP = 19 * MiB;
constexpr size_t WS_WDN = 41 * MiB;
constexpr size_t WS_ROPE = 52 * MiB;
constexpr size_t WS_GATES = 53 * MiB;
constexpr size_t WS_HN = 54 * MiB;
constexpr size_t WS_SCR = 86 * MiB;
constexpr size_t WS_PROJ = WS_SCR;
constexpr size_t WS_HFB = 198 * MiB;
constexpr size_t WS_H = WS_SCR;
constexpr size_t WS_U = 174 * MiB;
constexpr size_t WS_T = 174 * MiB;
constexpr size_t WS_O1 = 230 * MiB;
constexpr size_t WS_LSE = 246 * MiB;
constexpr size_t WS_END = 256 * MiB;
constexpr int CW_BAR = 4096;
constexpr int RING_BYTES = 131072, LDSCTL_OFF = RING_BYTES, MISC_OFF = LDSCTL_OFF + 320, LDS_BYTES = 147456;

struct Args {
    const float* x; const float* mix_pre_g; const float* w_in; const float* mconv_w; const float* mconv_b; const float* gate_b; const float* head_g;
    const float* w_out; const float* mix_post_g; const float* ffn_pre_g; const float* w_up; const float* fconv_w; const float* fconv_b; const float* w_down; const float* ffn_post_g;
    float* out; unsigned char* ws;
};

__device__ __forceinline__ float wave_sum(float v) {
#pragma unroll
    for (int o = 1; o < 64; o <<= 1) v += __shfl_xor(v, o);
    return v;
}
__device__ __forceinline__ int lndv(int v) { asm volatile("" : "+v"(v)); return v; }
template <class T> __device__ __forceinline__ T* lnd(T* p) { asm volatile("" : "+s"(p)); return p; }
__device__ __forceinline__ float bf2f(unsigned short b) { return __builtin_bit_cast(float, (unsigned)b << 16); }
__device__ __forceinline__ float bflo(unsigned w) { return __builtin_bit_cast(float, w << 16); }
__device__ __forceinline__ float bfhi(unsigned w) { return __builtin_bit_cast(float, w & 0xffff0000u); }

__device__ __forceinline__ void transpose_item(const float* W, int K, int ldw, int ncols, bf16* WT, LAS float* scr, int item, int lane) {
    const int nblk = ncols / 32, kb = item / nblk, nb = item % nblk, k0 = 64 * kb, n0 = 32 * nb;
#pragma unroll 8
    for (int i = 0; i < 32; ++i) { const int kk = 2 * i + (lane >> 5); scr[kk * 33 + (lane & 31)] = W[(size_t)(k0 + kk) * ldw + n0 + (lane & 31)]; }
    LDS_WAIT(); asm volatile("" ::: "memory");
    const int c = lane & 7;
#pragma unroll
    for (int j = 0; j < 4; ++j) { const int n = (lane >> 3) + 8 * j; const LAS float* s = scr + (8 * c) * 33 + n;
        v4u o; o.x = pk2(s[0 * 33], s[1 * 33]); o.y = pk2(s[2 * 33], s[3 * 33]); o.z = pk2(s[4 * 33], s[5 * 33]); o.w = pk2(s[6 * 33], s[7 * 33]);
        *(GAS v4u*)(WT + (size_t)(n0 + n) * K + k0 + 8 * c) = o; }
    LDS_WAIT(); asm volatile("" ::: "memory");
}

__device__ __forceinline__ void rms_row(f32x4 (&v)[4], const f32x4 (&g)[4]) {
    float s = 0.f;
#pragma unroll
    for (int j = 0; j < 4; ++j) s += (v[j].x * v[j].x + v[j].y * v[j].y) + (v[j].z * v[j].z + v[j].w * v[j].w);
    const float rs = 1.0f / sqrtf(wave_sum(s) * (1.f / DM) + EPS);
#pragma unroll
    for (int j = 0; j < 4; ++j) v[j] = v[j] * rs * g[j];
}
__device__ __forceinline__ void store_row_bf16(bf16* orow, const f32x4 (&v)[4], int lane) {
    GAS unsigned long long* o8 = (GAS unsigned long long*)orow + lane;
#pragma unroll
    for (int j = 0; j < 4; ++j) o8[64 * j] = (unsigned long long)pk2(v[j].x, v[j].y) | ((unsigned long long)pk2(v[j].z, v[j].w) << 32);
}
__device__ __forceinline__ void gates_row(const f32x4 (&y)[4], const LAS float* wg, const float* gb, float* grow, int lane) {
    float p[16];
#pragma unroll
    for (int q = 0; q < 16; ++q) p[q] = 0.f;
#pragma unroll
    for (int j = 0; j < 4; ++j)
#pragma unroll
        for (int c = 0; c < 4; ++c) {
            const int k = 256 * j + 4 * lane + c; const float yk = y[j][c];
            const LAS f32x4* w4 = (const LAS f32x4*)(wg + k * 16);
#pragma unroll
            for (int q = 0; q < 4; ++q) { const f32x4 w = w4[q]; p[4 * q + 0] += yk * w.x; p[4 * q + 1] += yk * w.y; p[4 * q + 2] += yk * w.z; p[4 * q + 3] += yk * w.w; }
        }
    float r = 0.f;
#pragma unroll
    for (int q = 0; q < 16; ++q) { const float t = wave_sum(p[q]); r = (lane == q) ? t : r; }
    if (lane < 16) grow[lane] = r + gb[lane];
}

__device__ __forceinline__ float gelu_tanh(float x) {
    const float u = 0.7978845608028654f * (x + 0.044715f * x * x * x);
    const float e = __expf(2.f * u);
    const float th = 1.f - 2.f / (1.f + e);
    return 0.5f * x * (1.f + th);
}
__device__ __forceinline__ float sigmoidf_(float x) { return 1.f / (1.f + __expf(-x)); }
__device__ __forceinline__ float log_sigmoid(float x) { return fminf(x, 0.f) - log1pf(__expf(-fabsf(x))); }


typedef short s16x4 __attribute__((ext_vector_type(4)));
typedef float f32x16 __attribute__((ext_vector_type(16)));
typedef float f32x2_t __attribute__((ext_vector_type(2))); typedef __bf16 bf16x2_t __attribute__((ext_vector_type(2)));
__device__ __forceinline__ unsigned cvtpk(float lo, float hi) { f32x2_t v = {lo, hi}; bf16x2_t b = __builtin_convertvector(v, bf16x2_t); return __builtin_bit_cast(unsigned, b); }
__device__ __forceinline__ s16x4 vtr(const LAS unsigned char* p) { return __builtin_bit_cast(s16x4, __builtin_amdgcn_ds_read_tr16_b64_v4i16((LAS s16x4*)p)); }
#define MFMA32(a, b, c) __builtin_amdgcn_mfma_f32_32x32x16_bf16((a), (b), (c), 0, 0, 0)
__device__ __forceinline__ bf16x8 pack8(const f32x16& x, int s8) {
    v4u p; p.x = cvtpk(x[s8 + 0], x[s8 + 1]); p.y = cvtpk(x[s8 + 2], x[s8 + 3]); p.z = cvtpk(x[s8 + 4], x[s8 + 5]); p.w = cvtpk(x[s8 + 6], x[s8 + 7]);
    return __builtin_bit_cast(bf16x8, p);
}
__device__ __forceinline__ void attn_task(const bf16* base, bf16* obase, int ostride, float* lsep, int br, int ti, LAS unsigned char* wl, int lane) {
    const int r_l = lane & 31, hh = lane >> 5;
    int r, rho, a, nsub;
    if (br == 0) { r = 1; rho = 0; a = ti; nsub = 2048; } else if (br == 1) { r = 4; rho = ti >> 4; a = ti & 15; nsub = 512; } else { r = 16; rho = ti >> 2; a = ti & 3; nsub = 128; }
    const int q0 = 32 * a;
    bf16x8 qf[4];
    { const bf16* qrow = base + (size_t)(rho + r * (q0 + r_l)) * NPROJ + 8 * hh;
#pragma unroll
      for (int s = 0; s < 4; ++s) qf[s] = *(const GAS bf16x8*)(qrow + 16 * s); }
    f32x16 S[5];
    float mx = -1e30f;
#pragma unroll
    for (int kt = 0; kt < 5; ++kt) {
        const int ks0 = q0 - 64 + 32 * kt;
        if (ks0 + 32 <= 0 || ks0 >= nsub) {
#pragma unroll
            for (int reg = 0; reg < 16; ++reg) S[kt][reg] = -1e30f;
        } else {
            const int kr = min(max(ks0 + r_l, 0), nsub - 1);
            const bf16* krow = base + (size_t)(rho + r * kr) * NPROJ + 512 + 8 * hh;
            bf16x8 kf[4];
#pragma unroll
            for (int s = 0; s < 4; ++s) kf[s] = *(const GAS bf16x8*)(krow + 16 * s);
            f32x16 acc;
#pragma unroll
            for (int reg = 0; reg < 16; ++reg) acc[reg] = 0.f;
#pragma unroll
            for (int s = 0; s < 4; ++s) acc = MFMA32(kf[s], qf[s], acc);
            const int kb = ks0 + 4 * hh, dq = kb - (q0 + r_l);
#pragma unroll
            for (int reg = 0; reg < 16; ++reg) {
                const int cr = (reg & 3) + 8 * (reg >> 2); const int d = dq + cr, ks = kb + cr;
                const bool ok = (d >= -64) && (d <= 64) && (ks >= 0) && (ks < nsub);
                const float v = ok ? acc[reg] : -1e30f; acc[reg] = v; mx = fmaxf(mx, v);
            }
            S[kt] = acc;
        }
    }
    mx = fmaxf(mx, __shfl_xor(mx, 32));
    float l = 0.f;
#pragma unroll
    for (int kt = 0; kt < 5; ++kt)
#pragma unroll
        for (int reg = 0; reg < 16; ++reg) { const float p = __expf(S[kt][reg] - mx); S[kt][reg] = p; l += p; }
    l += __shfl_xor(l, 32);
    f32x16 O0, O1;
#pragma unroll
    for (int reg = 0; reg < 16; ++reg) { O0[reg] = 0.f; O1[reg] = 0.f; }
    const int rowi = lane >> 3, chv = lane & 7, blk = (lane >> 4) & 1, qq = (lane & 15) >> 2, pp = lane & 3;
#pragma unroll
    for (int kt = 0; kt < 5; ++kt) {
        const int ks0 = q0 - 64 + 32 * kt;
        if (ks0 + 32 <= 0 || ks0 >= nsub) continue;
        v4u vv[4];
#pragma unroll
        for (int i = 0; i < 4; ++i) { const int kr = min(max(ks0 + 8 * i + rowi, 0), nsub - 1); vv[i] = *(const GAS v4u*)(base + (size_t)(rho + r * kr) * NPROJ + 1024 + 8 * chv); }
#pragma unroll
        for (int i = 0; i < 4; ++i) { const int row = 8 * i + rowi; *(LAS v4u*)(wl + 128 * row + 16 * (chv ^ (((row >> 1) & 1) << 2))) = vv[i]; }
#pragma unroll
        for (int s = 0; s < 2; ++s) {
            const bf16x8 A = pack8(S[kt], 8 * s);
            const int row0 = 16 * s + 4 * hh + qq, sw = ((row0 >> 1) & 1) << 2;
#pragma unroll
            for (int c = 0; c < 2; ++c) {
                const int ch = (4 * c + 2 * blk + (pp >> 1)) ^ sw;
                const LAS unsigned char* p0 = wl + 128 * row0 + 16 * ch + 8 * (pp & 1);
                const s16x4 lo = vtr(p0), hi = vtr(p0 + 8 * 128);
                const bf16x8 B = __builtin_shufflevector(lo, hi, 0, 1, 2, 3, 4, 5, 6, 7);
                if (c == 0) O0 = MFMA32(A, B, O0); else O1 = MFMA32(A, B, O1);
            }
        }
    }
    LAS float* lb = (LAS float*)(wl + 4096);
    if (lane < 32) lb[lane] = 1.f / l;
    f32x4 li4[4];
#pragma unroll
    for (int g = 0; g < 4; ++g) li4[g] = *(const LAS f32x4*)(lb + 4 * hh + 8 * g);
#pragma unroll
    for (int reg = 0; reg < 16; ++reg) {
        const float sc = li4[reg >> 2][reg & 3]; const int qs = q0 + (reg & 3) + 8 * (reg >> 2) + 4 * hh;
        bf16* orow = obase + (size_t)(rho + r * qs) * ostride;
        orow[r_l] = (bf16)f2bf(O0[reg] * sc); orow[32 + r_l] = (bf16)f2bf(O1[reg] * sc);
    }
    if (lane < 32) lsep[(size_t)(rho + r * (q0 + lane)) * 8] = mx + __logf(l);
}

#define PHASE_PTRS() const int tid = lndv((int)threadIdx.x), lane = tid & 63, wave = __builtin_amdgcn_readfirstlane(tid >> 6); const int gw = bid * NWAVES + wave, gt = bid * NTHR + tid; (void)lane; (void)gw; (void)gt; \
    Args a = a0; a.x = lnd(a.x); a.mix_pre_g = lnd(a.mix_pre_g); a.w_in = lnd(a.w_in); a.mconv_w = lnd(a.mconv_w); a.mconv_b = lnd(a.mconv_b); a.gate_b = lnd(a.gate_b); \
    a.head_g = lnd(a.head_g); a.w_out = lnd(a.w_out); a.mix_post_g = lnd(a.mix_post_g); a.ffn_pre_g = lnd(a.ffn_pre_g); a.w_up = lnd(a.w_up); a.fconv_w = lnd(a.fconv_w); a.fconv_b = lnd(a.fconv_b); \
    a.w_down = lnd(a.w_down); a.ffn_post_g = lnd(a.ffn_post_g); unsigned char* wsl = lnd(a.ws); \
    bf16* Win_t = (bf16*)(wsl + WS_WIN); bf16* Wout_t = (bf16*)(wsl + WS_WOUT); bf16* Wup_t = (bf16*)(wsl + WS_WUP); bf16* Wdn_t = (bf16*)(wsl + WS_WDN); \
    float* rope_c = (float*)(wsl + WS_ROPE); float* rope_s = rope_c + SEQ * 32; float* GATES = (float*)(wsl + WS_GATES); \
    bf16* HN = (bf16*)(wsl + WS_HN); bf16* PROJ = (bf16*)(wsl + WS_PROJ); bf16* HFB = (bf16*)(wsl + WS_HFB); bf16* HB16 = (bf16*)(wsl + WS_H); bf16* UB = (bf16*)(wsl + WS_U); \
    float* T = (float*)(wsl + WS_T); float* R = lnd(a.out); bf16* O1 = (bf16*)(wsl + WS_O1); float* LSE = (float*)(wsl + WS_LSE); (void)O1; (void)LSE; \
    (void)Win_t; (void)Wout_t; (void)Wup_t; (void)Wdn_t; (void)rope_c; (void)rope_s; (void)GATES; (void)HN; (void)PROJ; (void)HFB; (void)HB16; (void)UB; (void)T; (void)R;
__global__ void __launch_bounds__(NTHR, 2) hybrid_fwd(Args a0) {
    extern __shared__ __attribute__((aligned(16))) unsigned char lds_raw[];
    LAS unsigned char* lds = (LAS unsigned char*)lds_raw;
    volatile LAS unsigned* MISC = (volatile LAS unsigned*)(lds + MISC_OFF);
    const int tid = threadIdx.x, lane = tid & 63, wave = __builtin_amdgcn_readfirstlane(tid >> 6);
    const int G = gridDim.x, bid = blockIdx.x;
    unsigned char* ws = a0.ws;
    gu32* ctl = (gu32*)(ws + WS_CTL);
    for (int u = tid; u < (LDS_BYTES - LDSCTL_OFF) / 4; u += NTHR) ((LAS unsigned*)(lds + LDSCTL_OFF))[u] = 0u;
    __syncthreads();
    XcdBarrier bar = xcd_barrier_post((unsigned*)(ctl + CW_BAR), MISC + 8);
#define GRID_BAR() xcd_barrier(bar)
    const int gw = bid * NWAVES + wave, NGW = G * NWAVES;
    const int gt = bid * NTHR + tid, NGT = G * NTHR;


    {
            PHASE_PTRS();
        LAS float* scr = (LAS float*)(lds + wave * 16384);
        constexpr int I_IN = (DM / 64) * (NPROJ / 32), I_OUT = (DM / 64) * (DM / 32), I_UP = (DM / 64) * (NUP / 32), I_DN = (DFF / 64) * (DM / 32);
        constexpr int PER_L = I_IN + I_OUT + I_UP + I_DN;
        for (int it = gw; it < DEPTH * PER_L; it += NGW) {
            const int l = it / PER_L; int r = it % PER_L;
            if (r < I_IN) { transpose_item(a.w_in + (size_t)l * DM * PROJ_COLS, DM, PROJ_COLS, NPROJ, Win_t + (size_t)l * NPROJ * DM, scr, r, lane); continue; } r -= I_IN;
            if (r < I_OUT) { transpose_item(a.w_out + (size_t)l * DM * DM, DM, DM, DM, Wout_t + (size_t)l * DM * DM, scr, r, lane); continue; } r -= I_OUT;
            if (r < I_UP) { transpose_item(a.w_up + (size_t)l * DM * NUP, DM, NUP, NUP, Wup_t + (size_t)l * NUP * DM, scr, r, lane); continue; } r -= I_UP;
            transpose_item(a.w_down + (size_t)l * DFF * DM, DFF, DM, DM, Wdn_t + (size_t)l * DM * DFF, scr, r, lane);
        }
        for (int i = gt; i < SEQ * 32; i += NGT) {
            const int pos = i >> 5, fi = i & 31;
            const float inv = powf(10000.0f, -(float)(2 * fi) / 64.0f);
            const float ang = (float)pos * inv;
            const double ad = (double)ang; const double kk = rint(ad * 0.15915494309189535); const float rr = (float)(ad - kk * 6.283185307179586);
            rope_c[i] = cosf(rr); rope_s[i] = sinf(rr);
        }
    }
    __syncthreads();
    for (int l = 0; l < DEPTH; ++l) {
        if (l == 0) {
            PHASE_PTRS();
            const float* w_in_l = a.w_in + (size_t)l * DM * PROJ_COLS;
            LAS float* wg = (LAS float*)lds;
            for (int i = tid; i < DM * 16; i += NTHR) wg[i] = w_in_l[(size_t)(i >> 4) * PROJ_COLS + NPROJ + (i & 15)];
            __syncthreads();
            f32x4 g[4];
#pragma unroll
            for (int j = 0; j < 4; ++j) g[j] = ((const GAS f32x4*)(a.mix_pre_g + (size_t)l * DM))[lane + 64 * j];
            for (int m = gw; m < M; m += NGW) {
                f32x4 v[4];
#pragma unroll
                for (int j = 0; j < 4; ++j) v[j] = ((const GAS f32x4*)(a.x + (size_t)m * DM))[lane + 64 * j];
                rms_row(v, g);
                store_row_bf16(HN + (size_t)m * DM, v, lane);
                gates_row(v, wg, a.gate_b + l * 16, GATES + (size_t)m * 16, lane);
            }
            __syncthreads();
        }
        if (l == 0) { cg::this_grid().sync(); } else { GRID_BAR(); }

        {
            PHASE_PTRS();
            pg8::Gemm g{HN, Win_t + (size_t)l * NPROJ * DM, M, NPROJ, DM}; pg8::StaticOrder S; S.init(M, NPROJ, G, bid);
            pg8::EpiBf16<0> E{PROJ, NPROJ, nullptr, 0, 0, 1.f};
            pg8::gemm_phase<pg8::EpiBf16<0>, pg8::StaticOrder, true, true>(lds, g, S, E);
        }
        GRID_BAR();
        {
            PHASE_PTRS();
            for (int i = gt; i < M * 64; i += NGT) {
                const int m = i >> 6, hs = (i >> 2) & 15, i8 = i & 3, pos = m & (SEQ - 1);
                bf16* p1 = PROJ + (size_t)m * NPROJ + hs * 64 + 8 * i8;
                const v4u a1 = *(const GAS v4u*)p1, a2 = *(const GAS v4u*)(p1 + 32);
                const f32x4 c0 = *(const GAS f32x4*)(rope_c + pos * 32 + 8 * i8), c1 = *(const GAS f32x4*)(rope_c + pos * 32 + 8 * i8 + 4);
                const f32x4 s0 = *(const GAS f32x4*)(rope_s + pos * 32 + 8 * i8), s1 = *(const GAS f32x4*)(rope_s + pos * 32 + 8 * i8 + 4);
                const float sc = hs < 8 ? 0.125f : 1.f;
                float t1[8] = {bflo(a1.x), bfhi(a1.x), bflo(a1.y), bfhi(a1.y), bflo(a1.z), bfhi(a1.z), bflo(a1.w), bfhi(a1.w)};
                float t2[8] = {bflo(a2.x), bfhi(a2.x), bflo(a2.y), bfhi(a2.y), bflo(a2.z), bfhi(a2.z), bflo(a2.w), bfhi(a2.w)};
                float cc[8] = {c0.x, c0.y, c0.z, c0.w, c1.x, c1.y, c1.z, c1.w}, ss[8] = {s0.x, s0.y, s0.z, s0.w, s1.x, s1.y, s1.z, s1.w};
                float o1[8], o2[8];
#pragma unroll
                for (int q = 0; q < 8; ++q) { o1[q] = (t1[q] * cc[q] - t2[q] * ss[q]) * sc; o2[q] = (t2[q] * cc[q] + t1[q] * ss[q]) * sc; }
                v4u w1, w2; w1.x = pk2(o1[0], o1[1]); w1.y = pk2(o1[2], o1[3]); w1.z = pk2(o1[4], o1[5]); w1.w = pk2(o1[6], o1[7]);
                w2.x = pk2(o2[0], o2[1]); w2.y = pk2(o2[2], o2[3]); w2.z = pk2(o2[4], o2[5]); w2.w = pk2(o2[6], o2[7]);
                *(GAS v4u*)p1 = w1; *(GAS v4u*)(p1 + 32) = w2;
            }
            const float* cw = a.mconv_w + (size_t)l * 5 * 1024; const float* cb = a.mconv_b + (size_t)l * 1024;
            for (int i = gt; i < M * 128; i += NGT) {
                const int m = i >> 7, c8 = (i & 127) * 8, pos = m & (SEQ - 1);
                float acc[8];
#pragma unroll
                for (int q = 0; q < 8; ++q) acc[q] = cb[c8 + q];
#pragma unroll
                for (int j = 0; j < 5; ++j) {
                    const int pp = pos + j - 2;
                    if (pp >= 0 && pp < SEQ) {
                        const v4u xv = *(const GAS v4u*)(PROJ + (size_t)(m + j - 2) * NPROJ + 1536 + c8);
                        const f32x4 w0 = *(const GAS f32x4*)(cw + j * 1024 + c8), w1 = *(const GAS f32x4*)(cw + j * 1024 + c8 + 4);
                        acc[0] += bflo(xv.x) * w0.x; acc[1] += bfhi(xv.x) * w0.y; acc[2] += bflo(xv.y) * w0.z; acc[3] += bfhi(xv.y) * w0.w;
                        acc[4] += bflo(xv.z) * w1.x; acc[5] += bfhi(xv.z) * w1.y; acc[6] += bflo(xv.w) * w1.z; acc[7] += bfhi(xv.w) * w1.w;
                    }
                }
#pragma unroll
                for (int q = 0; q < 8; ++q) acc[q] = acc[q] * sigmoidf_(acc[q]);
                v4u o; o.x = pk2(acc[0], acc[1]); o.y = pk2(acc[2], acc[3]); o.z = pk2(acc[4], acc[5]); o.w = pk2(acc[6], acc[7]);
                *(GAS v4u*)(HN + (size_t)m * 1024 + c8) = o;
            }
        }
        GRID_BAR();
        if (bid < 64) {
            PHASE_PTRS();
            const int b = bid >> 3, h = (bid >> 1) & 3, dir = bid & 1;
            const int f = tid & 127, eg = tid >> 7;
            LAS float* sq = (LAS float*)lds;
            LAS float* sk = sq + 8 * 128;
            LAS float* sv = sk + 8 * 128;
            LAS float* sg = sv + 8 * 128;
            LAS float* part = sg + 64;
            LAS float* dpart = part + 8 * 4 * 128;
            LAS float* mm = dpart + 64;
            float C[32], nn[32];
#pragma unroll
            for (int i = 0; i < 32; ++i) { C[i] = 0.f; nn[i] = 0.f; }
            float mst = 0.f;
            bf16* Hout = HFB + (size_t)dir * M * MW;
            for (int s0 = 0; s0 < SEQ; s0 += 8) {
                for (int i = tid; i < 3 * 8 * 128; i += NTHR) {
                    const int which = i >> 10, tk = (i >> 7) & 7, d = i & 127;
                    const int s = s0 + tk, pos = dir ? (SEQ - 1 - s) : s; const size_t m = (size_t)b * SEQ + pos;
                    float val;
                    if (which == 0) val = bf2f(HN[m * 1024 + h * 128 + d]);
                    else if (which == 1) val = bf2f(HN[m * 1024 + 512 + h * 128 + d]) * 0.08838834764831845f;
                    else val = bf2f(PROJ[m * NPROJ + 2560 + h * 128 + d]);
                    sq[i] = val;
                }
                if (tid < 16) {
                    const int tk = tid >> 1, w = tid & 1; const int s = s0 + tk, pos = dir ? (SEQ - 1 - s) : s; const size_t m = (size_t)b * SEQ + pos;
                    const float gv = GATES[m * 16 + (2 * dir + w) * 4 + h];
                    sg[tid] = w ? log_sigmoid(gv) : gv;
                }
                __syncthreads();
#pragma unroll 1
                for (int tk = 0; tk < 8; ++tk) {
                    const float li = sg[2 * tk], lf = sg[2 * tk + 1];
                    const float mnew = fmaxf(lf + mst, li);
                    const float ad = __expf(lf + mst - mnew), bb = __expf(li - mnew);
                    mst = mnew;
                    const float vf = sv[tk * 128 + f] * bb;
                    float pn = 0.f, pd = 0.f;
#pragma unroll
                    for (int i4 = 0; i4 < 8; ++i4) {
                        const f32x4 k4 = *(const LAS f32x4*)(sk + tk * 128 + eg * 32 + 4 * i4);
                        const f32x4 q4 = *(const LAS f32x4*)(sq + tk * 128 + eg * 32 + 4 * i4);
#pragma unroll
                        for (int c = 0; c < 4; ++c) {
                            const int i = 4 * i4 + c;
                            C[i] = ad * C[i] + k4[c] * vf;
                            nn[i] = ad * nn[i] + k4[c] * bb;
                            pn += C[i] * q4[c]; pd += nn[i] * q4[c];
                        }
                    }
                    part[(tk * 4 + eg) * 128 + f] = pn;
                    if (f == 0) dpart[tk * 4 + eg] = pd;
                    if (tid == 0) mm[tk] = mst;
                }
                __syncthreads();
                for (int i = tid; i < 8 * 128; i += NTHR) {
                    const int tk = i >> 7, ff = i & 127;
                    const float num = (part[(tk * 4 + 0) * 128 + ff] + part[(tk * 4 + 1) * 128 + ff]) + (part[(tk * 4 + 2) * 128 + ff] + part[(tk * 4 + 3) * 128 + ff]);
                    const float den = (dpart[tk * 4 + 0] + dpart[tk * 4 + 1]) + (dpart[tk * 4 + 2] + dpart[tk * 4 + 3]);
                    const float hv = num / fmaxf(fabsf(den), __expf(-mm[tk]));
                    const int s = s0 + tk, pos = dir ? (SEQ - 1 - s) : s; const size_t m = (size_t)b * SEQ + pos;
                    Hout[m * MW + h * 128 + ff] = (bf16)f2bf(hv);
                }
                __syncthreads();
            }
        } else {
            PHASE_PTRS();
            const int NWA = (G - 64) * NWAVES;
            LAS unsigned char* wl = lds + wave * 8192;
            for (int t = (bid - 64) * NWAVES + wave; t < BATCH * AH * 192; t += NWA) {
                const int bh = t / 192, rem = t % 192, br = rem >> 6, ti = rem & 63, b = bh >> 3, h = bh & 7;
                const bf16* base = PROJ + (size_t)b * SEQ * NPROJ + h * 64;
                bf16* obase; int ostride;
                if (br == 0) { obase = O1 + (size_t)b * SEQ * AW + h * 64; ostride = AW; }
                else { obase = PROJ + (size_t)b * SEQ * NPROJ + (br == 1 ? 1536 : 2048) + h * 64; ostride = NPROJ; }
                attn_task(base, obase, ostride, LSE + (size_t)br * M * 8 + (size_t)b * SEQ * 8 + h, br, ti, wl, lane);
            }
        }
        GRID_BAR();
        {
            PHASE_PTRS();
            const float* hg = a.head_g + (size_t)l * MW;
            for (int m = gw; m < M; m += NGW) {
                {
                    const v4u o1 = *(const GAS v4u*)(O1 + (size_t)m * AW + 8 * lane), o2 = *(const GAS v4u*)(PROJ + (size_t)m * NPROJ + 1536 + 8 * lane), o3 = *(const GAS v4u*)(PROJ + (size_t)m * NPROJ + 2048 + 8 * lane);
                    const float l1 = LSE[(size_t)m * 8 + (lane >> 3)], l2 = LSE[(size_t)M * 8 + (size_t)m * 8 + (lane >> 3)], l3 = LSE[(size_t)2 * M * 8 + (size_t)m * 8 + (lane >> 3)];
                    const float lm = fmaxf(l1, fmaxf(l2, l3));
                    float w1 = __expf(l1 - lm), w2 = __expf(l2 - lm), w3 = __expf(l3 - lm); const float wi = 1.f / (w1 + w2 + w3); w1 *= wi; w2 *= wi; w3 *= wi;
                    v4u w;
                    w.x = pk2(w1 * bflo(o1.x) + w2 * bflo(o2.x) + w3 * bflo(o3.x), w1 * bfhi(o1.x) + w2 * bfhi(o2.x) + w3 * bfhi(o3.x));
                    w.y = pk2(w1 * bflo(o1.y) + w2 * bflo(o2.y) + w3 * bflo(o3.y), w1 * bfhi(o1.y) + w2 * bfhi(o2.y) + w3 * bfhi(o3.y));
                    w.z = pk2(w1 * bflo(o1.z) + w2 * bflo(o2.z) + w3 * bflo(o3.z), w1 * bfhi(o1.z) + w2 * bfhi(o2.z) + w3 * bfhi(o3.z));
                    w.w = pk2(w1 * bflo(o1.w) + w2 * bflo(o2.w) + w3 * bflo(o3.w), w1 * bfhi(o1.w) + w2 * bfhi(o2.w) + w3 * bfhi(o3.w));
                    *(GAS v4u*)(HN + (size_t)m * 1024 + 8 * lane) = w;
                }
                const v4u hf = *(const GAS v4u*)(HFB + (size_t)m * MW + 8 * lane), hb = *(const GAS v4u*)(HFB + (size_t)M * MW + (size_t)m * MW + 8 * lane);
                const v4u mo = *(const GAS v4u*)(PROJ + (size_t)m * NPROJ + 3072 + 8 * lane);
                float hm[8] = {bflo(hf.x) + bflo(hb.x), bfhi(hf.x) + bfhi(hb.x), bflo(hf.y) + bflo(hb.y), bfhi(hf.y) + bfhi(hb.y),
                               bflo(hf.z) + bflo(hb.z), bfhi(hf.z) + bfhi(hb.z), bflo(hf.w) + bflo(hb.w), bfhi(hf.w) + bfhi(hb.w)};
                float ov[8] = {bflo(mo.x), bfhi(mo.x), bflo(mo.y), bfhi(mo.y), bflo(mo.z), bfhi(mo.z), bflo(mo.w), bfhi(mo.w)};
                float s = 0.f;
#pragma unroll
                for (int q = 0; q < 8; ++q) s += hm[q] * hm[q];
                s += __shfl_xor(s, 1); s += __shfl_xor(s, 2); s += __shfl_xor(s, 4); s += __shfl_xor(s, 8);
                const float rs = 1.0f / sqrtf(s * (1.f / 128.f) + EPS);
                const f32x4 g0 = *(const GAS f32x4*)(hg + 8 * lane), g1 = *(const GAS f32x4*)(hg + 8 * lane + 4);
                const float gg[8] = {g0.x, g0.y, g0.z, g0.w, g1.x, g1.y, g1.z, g1.w};
                float o[8];
#pragma unroll
                for (int q = 0; q < 8; ++q) o[q] = hm[q] * rs * gg[q] * sigmoidf_(ov[q]);
                v4u w; w.x = pk2(o[0], o[1]); w.y = pk2(o[2], o[3]); w.z = pk2(o[4], o[5]); w.w = pk2(o[6], o[7]);
                *(GAS v4u*)(HN + (size_t)m * 1024 + 512 + 8 * lane) = w;
            }
        }
        GRID_BAR();
        {
            PHASE_PTRS();
            pg8::Gemm g{HN, Wout_t + (size_t)l * DM * DM, M, DM, DM}; pg8::StaticOrder S; S.init(M, DM, G, bid);
            pg8::EpiF32 E{T, DM, nullptr};
            pg8::gemm_phase<pg8::EpiF32, pg8::StaticOrder, true, true>(lds, g, S, E);
        }
        GRID_BAR();
        {
            PHASE_PTRS();
            f32x4 g1[4], g2[4];
#pragma unroll
            for (int j = 0; j < 4; ++j) { g1[j] = ((const GAS f32x4*)(a.mix_post_g + (size_t)l * DM))[lane + 64 * j]; g2[j] = ((const GAS f32x4*)(a.ffn_pre_g + (size_t)l * DM))[lane + 64 * j]; }
            const float* xin = (l == 0) ? a.x : R;
            for (int m = gw; m < M; m += NGW) {
                f32x4 v[4], xb[4];
#pragma unroll
                for (int j = 0; j < 4; ++j) { v[j] = ((const GAS f32x4*)(T + (size_t)m * DM))[lane + 64 * j]; xb[j] = ((const GAS f32x4*)(xin + (size_t)m * DM))[lane + 64 * j]; }
                rms_row(v, g1);
#pragma unroll
                for (int j = 0; j < 4; ++j) { v[j] = v[j] + xb[j]; ((GAS f32x4*)(R + (size_t)m * DM))[lane + 64 * j] = v[j]; }
                rms_row(v, g2);
                store_row_bf16(HN + (size_t)m * DM, v, lane);
            }
        }
        GRID_BAR();
        for (int qd = 0; qd < 4; ++qd) {
            PHASE_PTRS();
            {
                pg8::Gemm g{HN + (size_t)qd * 4096 * DM, Wup_t + (size_t)l * NUP * DM, 4096, NUP, DM}; pg8::StaticOrder S; S.init(4096, NUP, G, bid);
                pg8::EpiBf16<0> E{UB, NUP, nullptr, 0, 0, 1.f};
                pg8::gemm_phase<pg8::EpiBf16<0>, pg8::StaticOrder, true, true>(lds, g, S, E);
            }
            GRID_BAR();
            {
                const float* cw = a.fconv_w + (size_t)l * 3 * NUP; const float* cb = a.fconv_b + (size_t)l * NUP;
                for (int i = gt; i < 4096 * (DFF / 8); i += NGT) {
                    const int t = i / (DFF / 8), c8 = (i % (DFF / 8)) * 8, pos = t & (SEQ - 1);
                    float ga[8], va[8];
                    { const f32x4 b0 = *(const GAS f32x4*)(cb + c8), b1 = *(const GAS f32x4*)(cb + c8 + 4), b2 = *(const GAS f32x4*)(cb + DFF + c8), b3 = *(const GAS f32x4*)(cb + DFF + c8 + 4);
                      ga[0] = b0.x; ga[1] = b0.y; ga[2] = b0.z; ga[3] = b0.w; ga[4] = b1.x; ga[5] = b1.y; ga[6] = b1.z; ga[7] = b1.w;
                      va[0] = b2.x; va[1] = b2.y; va[2] = b2.z; va[3] = b2.w; va[4] = b3.x; va[5] = b3.y; va[6] = b3.z; va[7] = b3.w; }
#pragma unroll
                    for (int j = 0; j < 3; ++j) {
                        const int pp = pos + j - 1;
                        if (pp >= 0 && pp < SEQ) {
                            const v4u xg = *(const GAS v4u*)(UB + (size_t)(t + j - 1) * NUP + c8), xv = *(const GAS v4u*)(UB + (size_t)(t + j - 1) * NUP + DFF + c8);
                            const f32x4 w0 = *(const GAS f32x4*)(cw + j * NUP + c8), w1 = *(const GAS f32x4*)(cw + j * NUP + c8 + 4);
                            const f32x4 w2 = *(const GAS f32x4*)(cw + j * NUP + DFF + c8), w3 = *(const GAS f32x4*)(cw + j * NUP + DFF + c8 + 4);
                            ga[0] += bflo(xg.x) * w0.x; ga[1] += bfhi(xg.x) * w0.y; ga[2] += bflo(xg.y) * w0.z; ga[3] += bfhi(xg.y) * w0.w;
                            ga[4] += bflo(xg.z) * w1.x; ga[5] += bfhi(xg.z) * w1.y; ga[6] += bflo(xg.w) * w1.z; ga[7] += bfhi(xg.w) * w1.w;
                            va[0] += bflo(xv.x) * w2.x; va[1] += bfhi(xv.x) * w2.y; va[2] += bflo(xv.y) * w2.z; va[3] += bfhi(xv.y) * w2.w;
                            va[4] += bflo(xv.z) * w3.x; va[5] += bfhi(xv.z) * w3.y; va[6] += bflo(xv.w) * w3.z; va[7] += bfhi(xv.w) * w3.w;
                        }
                    }
                    float o[8];
#pragma unroll
                    for (int q = 0; q < 8; ++q) o[q] = gelu_tanh(ga[q]) * va[q];
                    v4u w; w.x = pk2(o[0], o[1]); w.y = pk2(o[2], o[3]); w.z = pk2(o[4], o[5]); w.w = pk2(o[6], o[7]);
                    *(GAS v4u*)(HB16 + (size_t)(qd * 4096 + t) * DFF + c8) = w;
                }
            }
            GRID_BAR();
        }
        {
            PHASE_PTRS();
            pg8::Gemm g{HB16, Wdn_t + (size_t)l * DM * DFF, M, DM, DFF}; pg8::StaticOrder S; S.init(M, DM, G, bid);
            pg8::EpiF32 E{T, DM, nullptr};
            pg8::gemm_phase<pg8::EpiF32, pg8::StaticOrder, true, true>(lds, g, S, E);
        }
        GRID_BAR();
        {
            PHASE_PTRS();
            const bool more = (l + 1 < DEPTH);
            LAS float* wg = (LAS float*)lds;
            if (more) {
                const float* w_in_n = a.w_in + (size_t)(l + 1) * DM * PROJ_COLS;
                for (int i = tid; i < DM * 16; i += NTHR) wg[i] = w_in_n[(size_t)(i >> 4) * PROJ_COLS + NPROJ + (i & 15)];
                __syncthreads();
            }
            f32x4 g1[4], g2[4];
#pragma unroll
            for (int j = 0; j < 4; ++j) { g1[j] = ((const GAS f32x4*)(a.ffn_post_g + (size_t)l * DM))[lane + 64 * j];
                g2[j] = more ? ((const GAS f32x4*)(a.mix_pre_g + (size_t)(l + 1) * DM))[lane + 64 * j] : (f32x4){0.f, 0.f, 0.f, 0.f}; }
            for (int m = gw; m < M; m += NGW) {
                f32x4 v[4], xb[4];
#pragma unroll
                for (int j = 0; j < 4; ++j) { v[j] = ((const GAS f32x4*)(T + (size_t)m * DM))[lane + 64 * j]; xb[j] = ((const GAS f32x4*)(R + (size_t)m * DM))[lane + 64 * j]; }
                rms_row(v, g1);
#pragma unroll
                for (int j = 0; j < 4; ++j) { v[j] = v[j] + xb[j]; ((GAS f32x4*)(R + (size_t)m * DM))[lane + 64 * j] = v[j]; }
                if (more) {
                    rms_row(v, g2);
                    store_row_bf16(HN + (size_t)m * DM, v, lane);
                    gates_row(v, wg, a.gate_b + (l + 1) * 16, GATES + (size_t)m * 16, lane);
                }
            }
            __syncthreads();
        }
    }
}

extern "C" void kernel_launch(void* const* d_in, const int* in_sizes, int n_in, void* d_out, int out_size, void* d_ws, size_t ws_size, hipStream_t stream) {
    static int grid = 0;
    if (grid == 0) {
        if (n_in != 15 || in_sizes[0] != M * DM || out_size != M * DM || ws_size < WS_END) { fprintf(stderr, "kernel_launch: unexpected shapes n_in %d in0 %d out %d ws %zu\n", n_in, n_in > 0 ? in_sizes[0] : -1, out_size, ws_size); grid = -1; return; }
        int dev = 0, cus = 0, per_cu = 0;
        hipGetDevice(&dev); hipDeviceGetAttribute(&cus, hipDeviceAttributeMultiprocessorCount, dev);
        if (hipFuncSetAttribute((const void*)hybrid_fwd, hipFuncAttributeMaxDynamicSharedMemorySize, LDS_BYTES) != hipSuccess) { fprintf(stderr, "kernel_launch: hipFuncSetAttribute failed\n"); grid = -1; return; }
        if (hipOccupancyMaxActiveBlocksPerMultiprocessor(&per_cu, (const void*)hybrid_fwd, NTHR, LDS_BYTES) != hipSuccess || per_cu < 1) { fprintf(stderr, "kernel_launch: occupancy query says %d\n", per_cu); per_cu = 1; }
        (void)hipGetLastError();
        grid = cus;
        if (grid > 256) grid = 256;
    }
    if (grid < 0) return;
    if (hipMemsetAsync((char*)d_ws + WS_CTL, 0, CTL_ZERO_BYTES, stream) != hipSuccess) { fprintf(stderr, "kernel_launch: memset failed\n"); return; }
    Args a{};
    a.x = (const float*)d_in[0]; a.mix_pre_g = (const float*)d_in[1]; a.w_in = (const float*)d_in[2]; a.mconv_w = (const float*)d_in[3]; a.mconv_b = (const float*)d_in[4];
    a.gate_b = (const float*)d_in[5]; a.head_g = (const float*)d_in[6]; a.w_out = (const float*)d_in[7]; a.mix_post_g = (const float*)d_in[8]; a.ffn_pre_g = (const float*)d_in[9];
    a.w_up = (const float*)d_in[10]; a.fconv_w = (const float*)d_in[11]; a.fconv_b = (const float*)d_in[12]; a.w_down = (const float*)d_in[13]; a.ffn_post_g = (const float*)d_in[14];
    a.out = (float*)d_out; a.ws = (unsigned char*)d_ws;
    void* args[] = {&a};
    hipError_t e = hipLaunchCooperativeKernel((const void*)hybrid_fwd, dim3(grid), dim3(NTHR), args, LDS_BYTES, stream);
    if (e != hipSuccess) fprintf(stderr, "cooperative launch failed: %s (grid %d)\n", hipGetErrorString(e), grid);
}
```

```cpp
#include <hip/hip_runtime.h>
#include <hip/hip_cooperative_groups.h>
#include <cstdio>
#include <cstdint>
namespace cg = cooperative_groups;
namespace pg8 {
#define PG8_LAS __attribute__((address_space(3)))
typedef unsigned short bf16_t;
typedef short bf16x8 __attribute__((ext_vector_type(8)));
typedef float f32x4 __attribute__((ext_vector_type(4)));
typedef unsigned u32x4 __attribute__((ext_vector_type(4)));
constexpr int BM = 256, BK = 64, HALF = 128, HTB = HALF * BK * 2  , STAGE_BYTES = 8 * HTB, NXCD = 8, WGM = 8;

__host__ __device__ __forceinline__ int lds_byte(int r, int c) { const int st = (r >> 4) * 2 + (c >> 5), rr = r & 15, cc = c & 31, ob = rr * 64 + cc * 2; return st * 1024 + (ob ^ (((ob >> 9) & 1) << 5)); }
__host__ __device__ __forceinline__ void stage_rc(int b, int& R, int& C) { const int st = b / 1024, sb = b % 1024, swz = sb ^ (((sb >> 9) & 1) << 5); R = (st >> 1) * 16 + swz / 64; C = (st & 1) * 32 + (swz % 64) / 2; }
__host__ __device__ __forceinline__ int perm32(int rho) { const int n = rho >> 4, i = rho & 15; return 8 * (i >> 2) + 4 * n + (i & 3); }

struct Unit { int pm, pn; };
struct Gemm { const bf16_t* A; const bf16_t* Bt; int M, N, K; };

struct StaticOrder {
    int nM, nN, nwg, G, c;
    __host__ __device__ void init(int M, int N, int G_, int c_) { nM = M / BM; nN = N / BM; nwg = nM * nN; G = G_; c = c_; }
    __host__ __device__ bool next(int i, Unit& u) const {
        const long L = (long)i * G + c; if (L >= nwg) return false;
        int wgid = (int)L; { const int q = nwg / NXCD, r = nwg % NXCD, xcd = wgid % NXCD, off = wgid / NXCD; wgid = (xcd < r ? xcd * (q + 1) : r * (q + 1) + (xcd - r) * q) + off; }
        const int nig = WGM * nN, gid = wgid / nig, fm = gid * WGM, gsz = (nM - fm) < WGM ? (nM - fm) : WGM;
        u.pm = fm + ((wgid % nig) % gsz); u.pn = (wgid % nig) / gsz; return true;
    }
    __device__ __forceinline__ void a_ready(const Unit&) const {}
    __device__ __forceinline__ void done(const Unit&) const {}
};

__device__ __forceinline__ unsigned cvt_pk_bf16(float lo, float hi) { unsigned r; asm volatile("v_cvt_pk_bf16_f32 %0, %1, %2" : "=v"(r) : "v"(lo), "v"(hi)); return r; }
typedef float f32x2 __attribute__((ext_vector_type(2)));
__device__ __forceinline__ f32x2 gelu_pk(f32x2 v) {
    const f32x2 av = __builtin_elementwise_abs(v), d = av * 0.2316418882f + 1.0f;
    f32x2 t; t.x = __builtin_amdgcn_rcpf(d.x); t.y = __builtin_amdgcn_rcpf(d.y);
    f32x2 q = t * 0.5307027145f + (-0.7265760135f); q = q * t + 0.7107068705f; q = q * t + (-0.142248368f); q = q * t + 0.127414796f; q = q * t;
    const f32x2 s = (v * v) * (-0.72134752044f);
    f32x2 e; e.x = __builtin_amdgcn_exp2f(s.x); e.y = __builtin_amdgcn_exp2f(s.y);
    const f32x2 m = v * (q * e), r = v - m;
    f32x2 o; o.x = v.x < 0.f ? m.x : r.x; o.y = v.y < 0.f ? m.y : r.y; return o;
}

template <int ACT  > struct EpiBf16 {
    static constexpr bool PERM = true, AFTER_DRAIN = false; static_assert(ACT == 0 || ACT == 1, "EpiBf16: ACT is 0 (none) or 1 (gelu_pk)");
    bf16_t* O; int ldc; const float* bias; int split_cols; size_t split_stride; float scale0;
    __device__ __forceinline__ void operator()(const f32x4 (&acc)[2][2][4][2], const Unit& u, int wr, int wc, int fr, int fq) const {
        const int row0 = u.pm * BM + wr * 64 + fr; int colt = u.pn * BM; bf16_t* base = O;
        float sc = 1.f; if (split_cols) { const int t = colt / split_cols; base += (size_t)t * split_stride; colt -= t * split_cols; if (t == 0) sc = scale0; }
        const int col0 = colt + wc * 32 + 8 * fq, bcol0 = u.pn * BM + wc * 32 + 8 * fq;
        f32x4 bv[2][2];
#pragma unroll
        for (int bj = 0; bj < 2; ++bj)
#pragma unroll
            for (int n = 0; n < 2; ++n) bv[bj][n] = bias ? *(const f32x4*)(bias + bcol0 + bj * HALF + 4 * n) : (f32x4){0.f, 0.f, 0.f, 0.f};
#pragma unroll
        for (int ai = 0; ai < 2; ++ai)
#pragma unroll
            for (int m = 0; m < 4; ++m) { bf16_t* rowp = base + (size_t)(row0 + ai * HALF + m * 16) * ldc + col0;
#pragma unroll
                for (int bj = 0; bj < 2; ++bj) { f32x4 v0 = acc[ai][bj][m][0] + bv[bj][0], v1 = acc[ai][bj][m][1] + bv[bj][1];
                    if (ACT == 1) { f32x2 a = gelu_pk((f32x2){v0[0], v0[1]}), b = gelu_pk((f32x2){v0[2], v0[3]}), c = gelu_pk((f32x2){v1[0], v1[1]}), d = gelu_pk((f32x2){v1[2], v1[3]});
                        v0 = (f32x4){a.x, a.y, b.x, b.y}; v1 = (f32x4){c.x, c.y, d.x, d.y}; }
                    v0 = v0 * sc; v1 = v1 * sc; u32x4 w; w.x = cvt_pk_bf16(v0[0], v0[1]); w.y = cvt_pk_bf16(v0[2], v0[3]); w.z = cvt_pk_bf16(v1[0], v1[1]); w.w = cvt_pk_bf16(v1[2], v1[3]);
                    *(u32x4*)(rowp + bj * HALF) = w; } }
    }
};
struct EpiF32 {
    static constexpr bool PERM = false, AFTER_DRAIN = false;
    float* C; int ldc; const float* bias;
    __device__ __forceinline__ void operator()(const f32x4 (&acc)[2][2][4][2], const Unit& u, int wr, int wc, int fr, int fq) const {
        const int row0 = u.pm * BM + wr * 64 + fr, col0 = u.pn * BM + wc * 32 + 4 * fq;
        f32x4 bv[2][2];
#pragma unroll
        for (int bj = 0; bj < 2; ++bj)
#pragma unroll
            for (int n = 0; n < 2; ++n) bv[bj][n] = bias ? *(const f32x4*)(bias + col0 + bj * HALF + n * 16) : (f32x4){0.f, 0.f, 0.f, 0.f};
#pragma unroll
        for (int ai = 0; ai < 2; ++ai)
#pragma unroll
            for (int m = 0; m < 4; ++m) { float* rowp = C + (size_t)(row0 + ai * HALF + m * 16) * ldc + col0;
#pragma unroll
                for (int bj = 0; bj < 2; ++bj)
#pragma unroll
                    for (int n = 0; n < 2; ++n) *(f32x4*)(rowp + bj * HALF + n * 16) = acc[ai][bj][m][n] + bv[bj][n]; }
    }
};
template <class Epi, class Sched, bool ALIGN_EPI = false, bool SP2 = false>
__device__ __forceinline__ void gemm_phase(PG8_LAS unsigned char* lds, const Gemm g, const Sched& S, const Epi& E) {
    int tid_ = threadIdx.x; asm volatile("" : "+v"(tid_));
    const int tid = tid_, wid = __builtin_amdgcn_readfirstlane(tid >> 6), lane = tid & 63, wr = wid >> 2, wc = wid & 3, fr = lane & 15, fq = lane >> 4;
    const int K = g.K, nt = K / BK;
    unsigned voffA[2], voffB[2];
#pragma unroll
    for (int i = 0; i < 2; ++i) { int R, C; stage_rc(tid * 16 + i * 8192, R, C); const int Rb = Epi::PERM ? ((R & ~31) + perm32(R & 31)) : R;
        voffA[i] = (unsigned)(R * K + C) * 2u; voffB[i] = (unsigned)(Rb * K + C) * 2u; }
    const size_t kstep = (size_t)(BK * 2);
    const size_t hstep = (size_t)HALF * K * 2;
    const size_t tstep = 2 * hstep;
    const unsigned ldsw = (unsigned)wid * 1024u;
    const int aoff = lds_byte(wr * 64 + fr, fq * 8), boff = lds_byte(wc * 32 + fr, fq * 8);
#define PG8_SA(b, h) (((b) * 2 + (h)) * HTB)
#define PG8_SB(b, h) ((4 + (b) * 2 + (h)) * HTB)
#define PG8_STAGE(bufoff, gbase, voff) do { _Pragma("unroll") for (int _i = 0; _i < 2; ++_i) \
        __builtin_amdgcn_global_load_lds((const unsigned*)((const char*)(gbase) + (voff)[_i]), (PG8_LAS unsigned*)(lds + (bufoff) + ldsw + _i * 8192), 16, 0, 0); } while (0)
#define PG8_LDA(dst, b, h) do { _Pragma("unroll") for (int m = 0; m < 4; ++m) _Pragma("unroll") for (int k = 0; k < 2; ++k) dst[m][k] = *(const PG8_LAS bf16x8*)(lds + PG8_SA(b, h) + aoff + m * 2048 + k * 1024); } while (0)
#define PG8_LDB(dst, b, h) do { _Pragma("unroll") for (int n = 0; n < 2; ++n) _Pragma("unroll") for (int k = 0; k < 2; ++k) dst[n][k] = *(const PG8_LAS bf16x8*)(lds + PG8_SB(b, h) + boff + n * 2048 + k * 1024); } while (0)
#define PG8_MMA(ai, bj, At, Bt) do { __builtin_amdgcn_s_setprio(1); _Pragma("unroll") for (int m = 0; m < 4; ++m) _Pragma("unroll") for (int n = 0; n < 2; ++n) _Pragma("unroll") for (int k = 0; k < 2; ++k) \
        acc[ai][bj][m][n] = __builtin_amdgcn_mfma_f32_16x16x32_bf16(Bt[n][k], At[m][k], acc[ai][bj][m][n], 0, 0, 0); __builtin_amdgcn_s_setprio(0); } while (0)
#define PG8_WAIT_V(n) asm volatile("s_waitcnt vmcnt(" #n ")" ::: "memory")
#define PG8_WAIT_L(n) asm volatile("s_waitcnt lgkmcnt(" #n ")" ::: "memory")
#define PG8_BAR __builtin_amdgcn_s_barrier()
#define PG8_SCHED __builtin_amdgcn_sched_barrier(0)
    Unit cur, nxt; int ui = 0;
    if (!S.next(0, cur)) return;
    f32x4 acc[2][2][4][2];
#pragma unroll
    for (int a = 0; a < 2; ++a)
#pragma unroll
        for (int b = 0; b < 2; ++b)
#pragma unroll
            for (int m = 0; m < 4; ++m)
#pragma unroll
                for (int n = 0; n < 2; ++n) acc[a][b][m][n] = (f32x4){0.f, 0.f, 0.f, 0.f};
    bf16x8 At[4][2], B0[2][2], B1[2][2];
    const char* cA = (const char*)g.A + (size_t)cur.pm * tstep; const char* cB = (const char*)g.Bt + (size_t)cur.pn * tstep;
    S.a_ready(cur);
    if constexpr (SP2) {
        PG8_STAGE(PG8_SB(0, 0), cB, voffB); PG8_STAGE(PG8_SB(0, 1), cB + hstep, voffB); PG8_STAGE(PG8_SA(0, 0), cA, voffA); PG8_STAGE(PG8_SA(0, 1), cA + hstep, voffA);
        if (wr == 1) PG8_BAR;
        PG8_WAIT_V(2); PG8_BAR;
        PG8_STAGE(PG8_SB(1, 0), cB + kstep, voffB); PG8_STAGE(PG8_SA(1, 0), cA + kstep, voffA); PG8_STAGE(PG8_SB(1, 1), cB + hstep + kstep, voffB);
        PG8_WAIT_V(6); PG8_BAR;
    } else {
        PG8_STAGE(PG8_SB(0, 0), cB, voffB); PG8_STAGE(PG8_SA(0, 0), cA, voffA); PG8_STAGE(PG8_SB(0, 1), cB + hstep, voffB); PG8_STAGE(PG8_SA(0, 1), cA + hstep, voffA);
        if (wr == 1) PG8_BAR;
        PG8_WAIT_V(4); PG8_BAR;
        PG8_STAGE(PG8_SB(1, 0), cB + kstep, voffB); PG8_STAGE(PG8_SA(1, 0), cA + kstep, voffA); PG8_STAGE(PG8_SB(1, 1), cB + hstep + kstep, voffB);
        PG8_WAIT_V(6); PG8_BAR;
    }
    for (;;) {
        const bool has_next = S.next(ui + 1, nxt);
        const char* nA = has_next ? (const char*)g.A + (size_t)nxt.pm * tstep : cA; const char* nB = has_next ? (const char*)g.Bt + (size_t)nxt.pn * tstep : cB;
        for (int t = 0; t < nt; t += 2) {
            const bool last = (t == nt - 2);
            const char* a1 = cA + (size_t)(t + 1) * kstep;
            const char* a2 = last ? nA : cA + (size_t)(t + 2) * kstep; const char* b2 = last ? nB : cB + (size_t)(t + 2) * kstep;
            const char* a3 = a2 + kstep; const char* b3 = b2 + kstep;
            if (last && has_next) S.a_ready(nxt);
            if constexpr (SP2) {
            PG8_LDB(B0, 0, 0); PG8_LDB(B1, 0, 1); PG8_SCHED; PG8_LDA(At, 0, 0); PG8_STAGE(PG8_SA(1, 1), a1 + hstep, voffA);
            PG8_WAIT_V(8); PG8_WAIT_L(0); PG8_BAR; PG8_MMA(0, 0, At, B0); PG8_MMA(0, 1, At, B1); PG8_BAR; PG8_SCHED;
            PG8_LDA(At, 0, 1); PG8_STAGE(PG8_SB(0, 0), b2, voffB); PG8_STAGE(PG8_SB(0, 1), b2 + hstep, voffB); PG8_STAGE(PG8_SA(0, 0), a2, voffA);
            PG8_WAIT_V(8); PG8_WAIT_L(0); PG8_BAR; PG8_MMA(1, 0, At, B0); PG8_MMA(1, 1, At, B1); PG8_BAR; PG8_SCHED;
            PG8_LDB(B0, 1, 0); PG8_LDB(B1, 1, 1); PG8_SCHED; PG8_LDA(At, 1, 0); PG8_STAGE(PG8_SA(0, 1), a2 + hstep, voffA);
            PG8_WAIT_V(8); PG8_WAIT_L(0); PG8_BAR; PG8_MMA(0, 0, At, B0); PG8_MMA(0, 1, At, B1); PG8_BAR; PG8_SCHED;
            PG8_LDA(At, 1, 1); PG8_STAGE(PG8_SB(1, 0), b3, voffB); PG8_STAGE(PG8_SB(1, 1), b3 + hstep, voffB); PG8_STAGE(PG8_SA(1, 0), a3, voffA);
            PG8_WAIT_V(8); PG8_WAIT_L(0); PG8_BAR; PG8_MMA(1, 0, At, B0); PG8_MMA(1, 1, At, B1); PG8_BAR; PG8_SCHED;
            } else {
            PG8_LDB(B0, 0, 0); PG8_SCHED; PG8_LDA(At, 0, 0); PG8_STAGE(PG8_SA(1, 1), a1 + hstep, voffA);
            PG8_WAIT_L(8); PG8_BAR; PG8_WAIT_L(0); PG8_MMA(0, 0, At, B0); PG8_BAR; PG8_SCHED;
            PG8_LDB(B1, 0, 1); PG8_STAGE(PG8_SB(0, 0), b2, voffB);
            PG8_BAR; PG8_WAIT_L(0); PG8_MMA(0, 1, At, B1); PG8_BAR;
            PG8_LDA(At, 0, 1); PG8_STAGE(PG8_SA(0, 0), a2, voffA);
            PG8_BAR; PG8_WAIT_L(0); PG8_MMA(1, 0, At, B0); PG8_BAR; PG8_SCHED;
            PG8_STAGE(PG8_SB(0, 1), b2 + hstep, voffB);
            PG8_WAIT_V(6); PG8_BAR; PG8_MMA(1, 1, At, B1); PG8_BAR;
            PG8_LDB(B0, 1, 0); PG8_SCHED; PG8_LDA(At, 1, 0); PG8_STAGE(PG8_SA(0, 1), a2 + hstep, voffA);
            PG8_WAIT_L(8); PG8_BAR; PG8_WAIT_L(0); PG8_MMA(0, 0, At, B0); PG8_BAR; PG8_SCHED;
            PG8_LDB(B1, 1, 1); PG8_STAGE(PG8_SB(1, 0), b3, voffB);
            PG8_BAR; PG8_WAIT_L(0); PG8_MMA(0, 1, At, B1); PG8_BAR;
            PG8_LDA(At, 1, 1); PG8_STAGE(PG8_SA(1, 0), a3, voffA);
            PG8_BAR; PG8_WAIT_L(0); PG8_MMA(1, 0, At, B0); PG8_BAR; PG8_SCHED;
            PG8_STAGE(PG8_SB(1, 1), b3 + hstep, voffB);
            PG8_WAIT_V(6); PG8_BAR; PG8_MMA(1, 1, At, B1); PG8_BAR;
            }
        }
        if constexpr (ALIGN_EPI) { if (wr == 0) PG8_BAR; }
        if constexpr (!Epi::AFTER_DRAIN) { E(acc, cur, wr, wc, fr, fq); S.done(cur); }
        if (!has_next) break;
#pragma unroll
        for (int a = 0; a < 2; ++a)
#pragma unroll
            for (int b = 0; b < 2; ++b)
#pragma unroll
                for (int m = 0; m < 4; ++m)
#pragma unroll
                    for (int n = 0; n < 2; ++n) acc[a][b][m][n] = (f32x4){0.f, 0.f, 0.f, 0.f};
        cur = nxt; cA = nA; cB = nB; ++ui;
        if constexpr (ALIGN_EPI) { if (wr == 1) PG8_BAR; }
    }
    PG8_WAIT_V(0);
    if constexpr (!ALIGN_EPI) { if (wr == 0) PG8_BAR; }
    PG8_BAR;
    if constexpr (Epi::AFTER_DRAIN) { E.fused(acc, cur, wr, wc, fr, fq, lds, wid, lane); S.done(cur); }
#undef PG8_SA
#undef PG8_SB
#undef PG8_STAGE
#undef PG8_LDA
#undef PG8_LDB
#undef PG8_MMA
#undef PG8_WAIT_V
#undef PG8_WAIT_L
#undef PG8_BAR
#undef PG8_SCHED
}
}
#define GAS __attribute__((address_space(1)))
#define LAS __attribute__((address_space(3)))
typedef unsigned short bf16;
typedef unsigned v4u __attribute__((ext_vector_type(4)));
typedef float f32x4 __attribute__((ext_vector_type(4)));
typedef short bf16x8 __attribute__((ext_vector_type(8)));
typedef GAS unsigned gu32;
typedef GAS unsigned long long gu64;
#define RLX_AGENT __ATOMIC_RELAXED, __HIP_MEMORY_SCOPE_AGENT
#define LDS_WAIT() asm volatile("s_waitcnt lgkmcnt(0)" ::: "memory")
#define VM_WAIT() asm volatile("s_waitcnt vmcnt(0)" ::: "memory")
__device__ __forceinline__ unsigned long long rt() { return __builtin_amdgcn_s_memrealtime(); }
__device__ __forceinline__ unsigned f2bf(float f) { unsigned u = __builtin_bit_cast(unsigned, f); return (u + 0x7fffu + ((u >> 16) & 1u)) >> 16; }
__device__ __forceinline__ unsigned pk2(float lo, float hi) { return f2bf(lo) | (f2bf(hi) << 16); }

#define XB_TMO      128
#define XB_XCNT(j)  (256  + 64 * (j))
#define XB_XSUB(j)  (1280 + 64 * (j))
#define XB_XGEN(j)  (2304 + 64 * (j))
#define XB_TOP      3328
#define XB_TOPGEN   3392
#define XCD_BAR_WORDS 3456
#define XB_SPIN_CAP (1u << 18)

__device__ __forceinline__ unsigned xb_ld(unsigned* p)              { return __hip_atomic_load(p, __ATOMIC_RELAXED, __HIP_MEMORY_SCOPE_AGENT); }
__device__ __forceinline__ unsigned xb_add(unsigned* p, unsigned v) { return __hip_atomic_fetch_add(p, v, __ATOMIC_RELAXED, __HIP_MEMORY_SCOPE_AGENT); }
__device__ __forceinline__ unsigned xb_xcc_id() { return (unsigned)__builtin_amdgcn_s_getreg((3 << 11) | 20) & 0xFu; }
#define XB_SPIN(cond, bar) do { unsigned _sp = 0; while (cond) { __builtin_amdgcn_s_sleep(1); \
    if ((++_sp & 255u) == 0u) { if (xb_ld(&(bar)[XB_TMO])) break; if (_sp > XB_SPIN_CAP) { atomicAdd(&(bar)[XB_TMO], 1u); break; } } } } while (0)

struct XcdBarrier {
    unsigned* bar; unsigned x;
    volatile LAS unsigned* st;
};

__device__ __forceinline__ XcdBarrier xcd_barrier_post(unsigned* bar, volatile LAS unsigned* st) {
    XcdBarrier b; b.bar = bar; b.x = xb_xcc_id(); b.st = st;
    if (threadIdx.x == 0) (void)xb_add(&bar[XB_XCNT(b.x)], 1u);
    return b;
}
__device__ __forceinline__ void xcd_barrier_complete(unsigned* bar, unsigned x, unsigned& nloc, unsigned& nx) {
    const unsigned G = gridDim.x * gridDim.y * gridDim.z;
    unsigned sum, cnt, mine, sp = 0u;
    for (;;) {
        sum = 0u; cnt = 0u; mine = 0u;
#pragma unroll
        for (unsigned j = 0; j < 16; ++j) { const unsigned c = xb_ld(&bar[XB_XCNT(j)]); sum += c; cnt += (c > 0u) ? 1u : 0u; mine = (j == x) ? c : mine; }
        if (sum == G) break;
        __builtin_amdgcn_s_sleep(1);
        if ((++sp & 255u) == 0u) { if (xb_ld(&bar[XB_TMO])) break; if (sp > XB_SPIN_CAP) { atomicAdd(&bar[XB_TMO], 1u); break; } }
    }
    nloc = mine > 0u ? mine : 1u; nx = cnt > 0u ? cnt : 1u;
}

__device__ __forceinline__ void xcd_barrier(const XcdBarrier& b) {
    asm volatile("s_waitcnt vmcnt(0)" ::: "memory");
    __syncthreads();
    if (threadIdx.x == 0) {
        unsigned* bar = b.bar;
        __builtin_amdgcn_s_waitcnt(0);
        unsigned nloc = b.st[0], nx = b.st[1];
        if (nloc == 0u) { xcd_barrier_complete(bar, b.x, nloc, nx); b.st[0] = nloc; b.st[1] = nx; }
        const unsigned old = xb_add(&bar[XB_XSUB(b.x)], 1u);
        const unsigned gen = old / nloc;
        if (old + 1u == (gen + 1u) * nloc) {
            __builtin_amdgcn_fence(__ATOMIC_RELEASE, "agent");
            asm volatile("s_waitcnt vmcnt(0)" ::: "memory");
            const unsigned og = xb_add(&bar[XB_TOP], 1u);
            const unsigned tg = og / nx;
            if (og + 1u == (tg + 1u) * nx) xb_add(&bar[XB_TOPGEN], 1u);
            else XB_SPIN(xb_ld(&bar[XB_TOPGEN]) == tg, bar);
            __builtin_amdgcn_fence(__ATOMIC_ACQUIRE, "agent");
            xb_add(&bar[XB_XGEN(b.x)], 1u);
            asm volatile("s_waitcnt vmcnt(0)" ::: "memory");
        } else {
            XB_SPIN(xb_ld(&bar[XB_XGEN(b.x)]) == gen, bar);
            __builtin_amdgcn_fence(__ATOMIC_ACQUIRE, "agent");
            asm volatile("s_waitcnt vmcnt(0)" ::: "memory");
        }
    }
    __syncthreads();
}

constexpr int NWAVES = 8, NTHR = 512;
constexpr int BATCH = 8, SEQ = 2048, DM = 1024, M = BATCH * SEQ, DEPTH = 2;
constexpr int AW = 512, AH = 8, AD = 64;
constexpr int MW = 512, MH = 4, MD = 128;
constexpr int PROJ_COLS = 3600, NPROJ = 3584;
constexpr int DFF = 2816, NUP = 2 * DFF;
constexpr float EPS = 1e-6f;
constexpr size_t MiB = 1u << 20;
constexpr size_t WS_CTL = 0, CTL_ZERO_BYTES = 1 * MiB;
constexpr size_t WS_WIN = 1 * MiB;
constexpr size_t WS_WOUT = 15 * MiB;
constexpr size_t WS_WUP = 19 * MiB;
constexpr size_t WS_WDN = 41 * MiB;
constexpr size_t WS_ROPE = 52 * MiB;
constexpr size_t WS_GATES = 53 * MiB;
constexpr size_t WS_HN = 54 * MiB;
constexpr size_t WS_SCR = 86 * MiB;
constexpr size_t WS_PROJ = WS_SCR;
constexpr size_t WS_HFB = 198 * MiB;
constexpr size_t WS_H = WS_SCR;
constexpr size_t WS_U = 174 * MiB;
constexpr size_t WS_T = 174 * MiB;
constexpr size_t WS_O1 = 230 * MiB;
constexpr size_t WS_LSE = 246 * MiB;
constexpr size_t WS_END = 256 * MiB;
constexpr int CW_BAR = 4096;
constexpr int RING_BYTES = 131072, LDSCTL_OFF = RING_BYTES, MISC_OFF = LDSCTL_OFF + 320, LDS_BYTES = 147456;

struct Args {
    const float* x; const float* mix_pre_g; const float* w_in; const float* mconv_w; const float* mconv_b; const float* gate_b; const float* head_g;
    const float* w_out; const float* mix_post_g; const float* ffn_pre_g; const float* w_up; const float* fconv_w; const float* fconv_b; const float* w_down; const float* ffn_post_g;
    float* out; unsigned char* ws;
};

__device__ __forceinline__ float shx(float v, int mask, int lane) { return __builtin_bit_cast(float, __builtin_amdgcn_ds_bpermute((lane ^ mask) << 2, __builtin_bit_cast(int, v))); }
__device__ __forceinline__ float shup(float v, int d, int lane) { return __builtin_bit_cast(float, __builtin_amdgcn_ds_bpermute((lane - d) << 2, __builtin_bit_cast(int, v))); }
__device__ __forceinline__ float rdlane(float v, int l) { return __builtin_bit_cast(float, __builtin_amdgcn_readlane(__builtin_bit_cast(int, v), l)); }
__device__ __forceinline__ float wave_sum(float v, int lane) {
#pragma unroll
    for (int o = 1; o < 64; o <<= 1) v += shx(v, o, lane);
    return v;
}
__device__ __forceinline__ int lndv(int v) { asm volatile("" : "+v"(v)); return v; }
template <class T> __device__ __forceinline__ T* lnd(T* p) { asm volatile("" : "+s"(p)); return p; }
__device__ __forceinline__ float bf2f(unsigned short b) { return __builtin_bit_cast(float, (unsigned)b << 16); }
__device__ __forceinline__ float bflo(unsigned w) { return __builtin_bit_cast(float, w << 16); }
__device__ __forceinline__ float bfhi(unsigned w) { return __builtin_bit_cast(float, w & 0xffff0000u); }

__device__ __forceinline__ void transpose_item(const float* W, int K, int ldw, int ncols, bf16* WT, LAS float* scr, int item, int lane) {
    const int nblk = ncols / 32, kb = item / nblk, nb = item % nblk, k0 = 64 * kb, n0 = 32 * nb;
#pragma unroll 8
    for (int i = 0; i < 32; ++i) { const int kk = 2 * i + (lane >> 5); scr[kk * 33 + (lane & 31)] = W[(size_t)(k0 + kk) * ldw + n0 + (lane & 31)]; }
    LDS_WAIT(); asm volatile("" ::: "memory");
    const int c = lane & 7;
#pragma unroll
    for (int j = 0; j < 4; ++j) { const int n = (lane >> 3) + 8 * j; const LAS float* s = scr + (8 * c) * 33 + n;
        v4u o; o.x = pk2(s[0 * 33], s[1 * 33]); o.y = pk2(s[2 * 33], s[3 * 33]); o.z = pk2(s[4 * 33], s[5 * 33]); o.w = pk2(s[6 * 33], s[7 * 33]);
        *(GAS v4u*)(WT + (size_t)(n0 + n) * K + k0 + 8 * c) = o; }
    LDS_WAIT(); asm volatile("" ::: "memory");
}

__device__ __forceinline__ void rms_row(f32x4 (&v)[4], const f32x4 (&g)[4], int lane) {
    float s = 0.f;
#pragma unroll
    for (int j = 0; j < 4; ++j) s += (v[j].x * v[j].x + v[j].y * v[j].y) + (v[j].z * v[j].z + v[j].w * v[j].w);
    const float rs = 1.0f / sqrtf(wave_sum(s, lane) * (1.f / DM) + EPS);
#pragma unroll
    for (int j = 0; j < 4; ++j) v[j] = v[j] * rs * g[j];
}
__device__ __forceinline__ void store_row_bf16(bf16* orow, const f32x4 (&v)[4], int lane) {
    GAS unsigned long long* o8 = (GAS unsigned long long*)orow + lane;
#pragma unroll
    for (int j = 0; j < 4; ++j) o8[64 * j] = (unsigned long long)pk2(v[j].x, v[j].y) | ((unsigned long long)pk2(v[j].z, v[j].w) << 32);
}
__device__ __forceinline__ void gates_row(const f32x4 (&y)[4], const LAS float* wg, const float* gb, float* grow, int lane) {
    float p[16];
#pragma unroll
    for (int q = 0; q < 16; ++q) p[q] = 0.f;
#pragma unroll
    for (int j = 0; j < 4; ++j)
#pragma unroll
        for (int c = 0; c < 4; ++c) {
            const int k = 256 * j + 4 * lane + c; const float yk = y[j][c];
            const LAS f32x4* w4 = (const LAS f32x4*)(wg + k * 16);
#pragma unroll
            for (int q = 0; q < 4; ++q) { const f32x4 w = w4[q]; p[4 * q + 0] += yk * w.x; p[4 * q + 1] += yk * w.y; p[4 * q + 2] += yk * w.z; p[4 * q + 3] += yk * w.w; }
        }
    float r = 0.f;
#pragma unroll
    for (int q = 0; q < 16; ++q) { const float t = wave_sum(p[q], lane); r = (lane == q) ? t : r; }
    if (lane < 16) grow[lane] = r + gb[lane];
}

__device__ __forceinline__ float gelu_tanh(float x) {
    const float u = 0.7978845608028654f * (x + 0.044715f * x * x * x);
    const float e = __expf(2.f * u);
    const float th = 1.f - 2.f / (1.f + e);
    return 0.5f * x * (1.f + th);
}
__device__ __forceinline__ float sigmoidf_(float x) { return 1.f / (1.f + __expf(-x)); }
__device__ __forceinline__ float log_sigmoid(float x) { return fminf(x, 0.f) - log1pf(__expf(-fabsf(x))); }


typedef short s16x4 __attribute__((ext_vector_type(4)));
typedef float f32x16 __attribute__((ext_vector_type(16)));
typedef float f32x2_t __attribute__((ext_vector_type(2))); typedef __bf16 bf16x2_t __attribute__((ext_vector_type(2)));
__device__ __forceinline__ unsigned cvtpk(float lo, float hi) { f32x2_t v = {lo, hi}; bf16x2_t b = __builtin_convertvector(v, bf16x2_t); return __builtin_bit_cast(unsigned, b); }
__device__ __forceinline__ s16x4 vtr(const LAS unsigned char* p) { return __builtin_bit_cast(s16x4, __builtin_amdgcn_ds_read_tr16_b64_v4i16((LAS s16x4*)p)); }
#define MFMA32(a, b, c) __builtin_amdgcn_mfma_f32_32x32x16_bf16((a), (b), (c), 0, 0, 0)
__device__ __forceinline__ bf16x8 pack8(const f32x16& x, int s8) {
    v4u p; p.x = cvtpk(x[s8 + 0], x[s8 + 1]); p.y = cvtpk(x[s8 + 2], x[s8 + 3]); p.z = cvtpk(x[s8 + 4], x[s8 + 5]); p.w = cvtpk(x[s8 + 6], x[s8 + 7]);
    return __builtin_bit_cast(bf16x8, p);
}
__device__ __forceinline__ void attn_task(const bf16* base, bf16* obase, int ostride, float* lsep, int br, int ti, LAS unsigned char* wl, int lane) {
    const int r_l = lane & 31, hh = lane >> 5;
    int r, rho, a, nsub;
    if (br == 0) { r = 1; rho = 0; a = ti; nsub = 2048; } else if (br == 1) { r = 4; rho = ti >> 4; a = ti & 15; nsub = 512; } else { r = 16; rho = ti >> 2; a = ti & 3; nsub = 128; }
    const int q0 = 32 * a;
    bf16x8 qf[4];
    { const bf16* qrow = base + (size_t)(rho + r * (q0 + r_l)) * NPROJ + 8 * hh;
#pragma unroll
      for (int s = 0; s < 4; ++s) qf[s] = *(const GAS bf16x8*)(qrow + 16 * s); }
    f32x16 S[5];
    float mx = -1e30f;
#pragma unroll
    for (int kt = 0; kt < 5; ++kt) {
        const int ks0 = q0 - 64 + 32 * kt;
        if (ks0 + 32 <= 0 || ks0 >= nsub) {
#pragma unroll
            for (int reg = 0; reg < 16; ++reg) S[kt][reg] = -1e30f;
        } else {
            const int kr = min(max(ks0 + r_l, 0), nsub - 1);
            const bf16* krow = base + (size_t)(rho + r * kr) * NPROJ + 512 + 8 * hh;
            bf16x8 kf[4];
#pragma unroll
            for (int s = 0; s < 4; ++s) kf[s] = *(const GAS bf16x8*)(krow + 16 * s);
            f32x16 acc;
#pragma unroll
            for (int reg = 0; reg < 16; ++reg) acc[reg] = 0.f;
#pragma unroll
            for (int s = 0; s < 4; ++s) acc = MFMA32(kf[s], qf[s], acc);
            const int kb = ks0 + 4 * hh, dq = kb - (q0 + r_l);
#pragma unroll
            for (int reg = 0; reg < 16; ++reg) {
                const int cr = (reg & 3) + 8 * (reg >> 2); const int d = dq + cr, ks = kb + cr;
                const bool ok = (d >= -64) && (d <= 64) && (ks >= 0) && (ks < nsub);
                const float v = ok ? acc[reg] : -1e30f; acc[reg] = v; mx = fmaxf(mx, v);
            }
            S[kt] = acc;
        }
    }
    mx = fmaxf(mx, shx(mx, 32, lane));
    float l = 0.f;
#pragma unroll
    for (int kt = 0; kt < 5; ++kt)
#pragma unroll
        for (int reg = 0; reg < 16; ++reg) { const float p = __expf(S[kt][reg] - mx); S[kt][reg] = p; l += p; }
    l += shx(l, 32, lane);
    f32x16 O0, O1;
#pragma unroll
    for (int reg = 0; reg < 16; ++reg) { O0[reg] = 0.f; O1[reg] = 0.f; }
    const int rowi = lane >> 3, chv = lane & 7, blk = (lane >> 4) & 1, qq = (lane & 15) >> 2, pp = lane & 3;
#pragma unroll
    for (int kt = 0; kt < 5; ++kt) {
        const int ks0 = q0 - 64 + 32 * kt;
        if (ks0 + 32 <= 0 || ks0 >= nsub) continue;
        v4u vv[4];
#pragma unroll
        for (int i = 0; i < 4; ++i) { const int kr = min(max(ks0 + 8 * i + rowi, 0), nsub - 1); vv[i] = *(const GAS v4u*)(base + (size_t)(rho + r * kr) * NPROJ + 1024 + 8 * chv); }
#pragma unroll
        for (int i = 0; i < 4; ++i) { const int row = 8 * i + rowi; *(LAS v4u*)(wl + 128 * row + 16 * (chv ^ (((row >> 1) & 1) << 2))) = vv[i]; }
#pragma unroll
        for (int s = 0; s < 2; ++s) {
            const bf16x8 A = pack8(S[kt], 8 * s);
            const int row0 = 16 * s + 4 * hh + qq, sw = ((row0 >> 1) & 1) << 2;
#pragma unroll
            for (int c = 0; c < 2; ++c) {
                const int ch = (4 * c + 2 * blk + (pp >> 1)) ^ sw;
                const LAS unsigned char* p0 = wl + 128 * row0 + 16 * ch + 8 * (pp & 1);
                const s16x4 lo = vtr(p0), hi = vtr(p0 + 8 * 128);
                const bf16x8 B = __builtin_shufflevector(lo, hi, 0, 1, 2, 3, 4, 5, 6, 7);
                if (c == 0) O0 = MFMA32(A, B, O0); else O1 = MFMA32(A, B, O1);
            }
        }
    }
    LAS float* lb = (LAS float*)(wl + 4096);
    if (lane < 32) lb[lane] = 1.f / l;
    f32x4 li4[4];
#pragma unroll
    for (int g = 0; g < 4; ++g) li4[g] = *(const LAS f32x4*)(lb + 4 * hh + 8 * g);
#pragma unroll
    for (int reg = 0; reg < 16; ++reg) {
        const float sc = li4[reg >> 2][reg & 3]; const int qs = q0 + (reg & 3) + 8 * (reg >> 2) + 4 * hh;
        bf16* orow = obase + (size_t)(rho + r * qs) * ostride;
        orow[r_l] = (bf16)f2bf(O0[reg] * sc); orow[32 + r_l] = (bf16)f2bf(O1[reg] * sc);
    }
    if (lane < 32) lsep[(size_t)(rho + r * (q0 + lane)) * 8] = mx + __logf(l);
}


constexpr int ML_Q = 0, ML_K = 32768, ML_V = 65536, ML_C = 98304, ML_VEC = 131584;
enum { MV_RT = 0, MV_A, MV_G, MV_EMT, MV_WEXP, MV_QN, MV_N, MV_HSC, MV_GSC, MV_SCAL, MV_COUNT };
static_assert(ML_VEC + 512 * MV_COUNT <= LDS_BYTES, "mLSTM LDS map");
__device__ __forceinline__ int xsw(int row) { return ((row & 3) << 2) | ((row >> 2) & 3); }
__device__ __forceinline__ bf16x8 ml_rowfrag(const LAS unsigned char* img, int rowbase, int ks, int r_l, int hh, int xr) {
    return *(const LAS bf16x8*)(img + 256 * (rowbase + r_l) + 16 * ((2 * ks + hh) ^ xr));
}
template <bool PERM> __device__ __forceinline__ bf16x8 ml_trfrag(const LAS unsigned char* img, int rowbase, int c, int hh, int blk, int qq, int pp) {
    const int chb = 4 * c + 2 * blk + (pp >> 1);
    const int r0 = rowbase + (PERM ? 4 * hh : 8 * hh) + qq, r1 = r0 + (PERM ? 8 : 4);
    const int x0 = (qq << 2) | ((PERM ? hh : 2 * hh) & 3), x1 = (qq << 2) | ((PERM ? 2 + hh : 2 * hh + 1) & 3);
    const s16x4 lo = vtr(img + 256 * r0 + 16 * (chb ^ x0) + 8 * (pp & 1)), hi = vtr(img + 256 * r1 + 16 * (chb ^ x1) + 8 * (pp & 1));
    return __builtin_shufflevector(lo, hi, 0, 1, 2, 3, 4, 5, 6, 7);
}

__device__ __forceinline__ void mlstm_scan(LAS unsigned char* lds, const bf16* QK  , const bf16* PROJ, const float* GATES, bf16* Hout  ,
                                           int b, int h, int dir, int tid) {
    const int lane = tid & 63, wave = __builtin_amdgcn_readfirstlane(tid >> 6), tt = wave >> 1, fh = wave & 1;
    const int r_l = lane & 31, hh = lane >> 5, blk = (lane >> 4) & 1, qq = (lane & 15) >> 2, pp = lane & 3, xr = xsw(r_l);
    const float scale = 0.08838834764831845f;
    LAS float* vec = (LAS float*)(lds + ML_VEC);
    for (int i = tid; i < 32768 / 16; i += NTHR) *(LAS v4u*)(lds + ML_C + 16 * i) = (v4u){0u, 0u, 0u, 0u};
    if (tid < 128) vec[MV_N * 128 + tid] = 0.f;
    f32x16 C0, C1;
#pragma unroll
    for (int i = 0; i < 16; ++i) { C0[i] = 0.f; C1[i] = 0.f; }
    float mst = 0.f;
    const int lrow = tid >> 4, lch = tid & 15;
#pragma unroll 1
    for (int cs = 0; cs < SEQ / 128; ++cs) {
        {
            v4u tq[4], tk[4], tv[4];
#pragma unroll
            for (int k4 = 0; k4 < 4; ++k4) {
                const int t = lrow + 32 * k4, sg = 128 * cs + t, pos = dir ? (SEQ - 1 - sg) : sg; const size_t m = (size_t)b * SEQ + pos;
                tq[k4] = *(const GAS v4u*)(QK + m * 1024 + h * 128 + 8 * lch);
                tk[k4] = *(const GAS v4u*)(QK + m * 1024 + 512 + h * 128 + 8 * lch);
                tv[k4] = *(const GAS v4u*)(PROJ + m * NPROJ + 2560 + h * 128 + 8 * lch);
            }
#pragma unroll
            for (int k4 = 0; k4 < 4; ++k4) {
                const int t = lrow + 32 * k4, o = 256 * t + 16 * (lch ^ xsw(t));
                *(LAS v4u*)(lds + ML_Q + o) = tq[k4]; *(LAS v4u*)(lds + ML_K + o) = tk[k4]; *(LAS v4u*)(lds + ML_V + o) = tv[k4];
            }
        }
        __syncthreads();
        if (wave == 0) {
            const int t0 = 2 * lane;
            float li0, li1, lf0, lf1;
            { const int sg = 128 * cs + t0, p0 = dir ? (SEQ - 1 - sg) : sg, p1 = dir ? (p0 - 1) : (p0 + 1);
              const float* g0 = GATES + ((size_t)b * SEQ + p0) * 16 + (2 * dir) * 4 + h; const float* g1 = GATES + ((size_t)b * SEQ + p1) * 16 + (2 * dir) * 4 + h;
              li0 = g0[0]; lf0 = log_sigmoid(g0[4]); li1 = g1[0]; lf1 = log_sigmoid(g1[4]); }
            const float ps = lf0 + lf1; float inc = ps;
#pragma unroll
            for (int d = 1; d < 64; d <<= 1) { const float o = shup(inc, d, lane); if (lane >= d) inc += o; }
            const float bc1 = inc, bc0 = inc - lf1;
            const float a0 = li0 - bc0, a1 = li1 - bc1;
            const float pm = fmaxf(a0, a1); float im = pm;
#pragma unroll
            for (int d = 1; d < 64; d <<= 1) { const float o = shup(im, d, lane); if (lane >= d) im = fmaxf(im, o); }
            float em = shup(im, 1, lane); if (lane == 0) em = -3.0e38f;
            const float cm0 = fmaxf(em, a0), cm1 = im;
            const float mt0 = fmaxf(bc0 + mst, bc0 + cm0), mt1 = fmaxf(bc1 + mst, bc1 + cm1);
            const float blast = rdlane(inc, 63), cref = rdlane(im, 63);
            const float mnew = fmaxf(blast + mst, blast + cref);
            vec[MV_RT * 128 + t0] = bc0 - mt0; vec[MV_RT * 128 + t0 + 1] = bc1 - mt1;
            vec[MV_A * 128 + t0] = a0; vec[MV_A * 128 + t0 + 1] = a1;
            vec[MV_G * 128 + t0] = __expf(bc0 + mst - mt0); vec[MV_G * 128 + t0 + 1] = __expf(bc1 + mst - mt1);
            vec[MV_EMT * 128 + t0] = __expf(-mt0); vec[MV_EMT * 128 + t0 + 1] = __expf(-mt1);
            vec[MV_WEXP * 128 + t0] = __expf(blast + a0 - mnew); vec[MV_WEXP * 128 + t0 + 1] = __expf(blast + a1 - mnew);
            if (lane == 0) vec[MV_SCAL * 128] = __expf(blast + mst - mnew);
            mst = mnew;
        } else if (wave == 2 || wave == 3) {
            const int t = tid - 128, xt = xsw(t);
            float s = 0.f;
#pragma unroll 4
            for (int ch = 0; ch < 16; ++ch) {
                const v4u qv = *(const LAS v4u*)(lds + ML_Q + 256 * t + 16 * (ch ^ xt));
                const f32x4 n0 = *(const LAS f32x4*)(vec + MV_N * 128 + 8 * ch), n1 = *(const LAS f32x4*)(vec + MV_N * 128 + 8 * ch + 4);
                s += bflo(qv.x) * n0.x + bfhi(qv.x) * n0.y + bflo(qv.y) * n0.z + bfhi(qv.y) * n0.w + bflo(qv.z) * n1.x + bfhi(qv.z) * n1.y + bflo(qv.w) * n1.z + bfhi(qv.w) * n1.w;
            }
            vec[MV_QN * 128 + t] = s;
        }
        __syncthreads();
        {
            bf16x8 qf[8];
            { const int ln_ = lndv(lane); const int r_l = ln_ & 31, hh = ln_ >> 5, blk = (ln_ >> 4) & 1, qq = (ln_ & 15) >> 2, pp = ln_ & 3, xr = xsw(r_l); (void)blk; (void)qq; (void)pp; (void)xr; (void)hh;
#pragma unroll
            for (int ks = 0; ks < 8; ++ks) qf[ks] = ml_rowfrag(lds + ML_Q, 32 * tt, ks, r_l, hh, xr); }
            f32x16 N0, N1;
#pragma unroll
            for (int i = 0; i < 16; ++i) { N0[i] = 0.f; N1[i] = 0.f; }
            float den = 0.f;
            const float rt = vec[MV_RT * 128 + 32 * tt + r_l];
#pragma unroll
            for (int st = 0; st < 4; ++st) {
                if (st <= tt) {
                    const int ln_ = lndv(lane); const int r_l = ln_ & 31, hh = ln_ >> 5, blk = (ln_ >> 4) & 1, qq = (ln_ & 15) >> 2, pp = ln_ & 3, xr = xsw(r_l); (void)blk; (void)qq; (void)pp; (void)xr; (void)hh;
                    f32x16 acc;
#pragma unroll
                    for (int i = 0; i < 16; ++i) acc[i] = 0.f;
#pragma unroll
                    for (int ks = 0; ks < 8; ++ks) acc = MFMA32(ml_rowfrag(lds + ML_K, 32 * st, ks, r_l, hh, xr), qf[ks], acc);
                    f32x4 av[4];
#pragma unroll
                    for (int g = 0; g < 4; ++g) av[g] = *(const LAS f32x4*)(vec + MV_A * 128 + 32 * st + 4 * hh + 8 * g);
#pragma unroll
                    for (int reg = 0; reg < 16; ++reg) {
                        const int cr = (reg & 3) + 8 * (reg >> 2) + 4 * hh;
                        const bool ok = (st < tt) || (cr <= r_l);
                        const float p = ok ? acc[reg] * scale * __expf(rt + av[reg >> 2][reg & 3]) : 0.f;
                        acc[reg] = p; den += p;
                    }
#pragma unroll
                    for (int s2 = 0; s2 < 2; ++s2) {
                        const bf16x8 A = pack8(acc, 8 * s2);
                        N0 = MFMA32(A, ml_trfrag<true>(lds + ML_V, 32 * st + 16 * s2, 2 * fh + 0, hh, blk, qq, pp), N0);
                        N1 = MFMA32(A, ml_trfrag<true>(lds + ML_V, 32 * st + 16 * s2, 2 * fh + 1, hh, blk, qq, pp), N1);
                    }
                }
            }
            den += shx(den, 32, lane);
            f32x16 Q0, Q1;
#pragma unroll
            for (int i = 0; i < 16; ++i) { Q0[i] = 0.f; Q1[i] = 0.f; }
            { LAS unsigned char* lq = lds + ML_Q; asm volatile("" : "+v"(lq)); const int ln_ = lndv(lane); const int r_l = ln_ & 31, hh = ln_ >> 5, blk = (ln_ >> 4) & 1, qq = (ln_ & 15) >> 2, pp = ln_ & 3, xr = xsw(r_l); (void)blk; (void)qq; (void)pp; (void)xr; (void)hh;
#pragma unroll
            for (int ks = 0; ks < 8; ++ks) {
                const bf16x8 qa = ml_rowfrag(lq, 32 * tt, ks, r_l, hh, xr);
                Q0 = MFMA32(qa, ml_rowfrag(lds + ML_C, 32 * (2 * fh + 0), ks, r_l, hh, xr), Q0);
                Q1 = MFMA32(qa, ml_rowfrag(lds + ML_C, 32 * (2 * fh + 1), ks, r_l, hh, xr), Q1);
            } }
            {
                const int t = 32 * tt + r_l;
                const float gs = vec[MV_G * 128 + t] * scale;
                const float dn = den + gs * vec[MV_QN * 128 + t];
                const float inv = 1.f / fmaxf(fabsf(dn), vec[MV_EMT * 128 + t]);
                vec[MV_HSC * 128 + t] = inv; vec[MV_GSC * 128 + t] = gs * inv;
            }
            f32x4 hs4[4], gs4[4];
#pragma unroll
            for (int g = 0; g < 4; ++g) { hs4[g] = *(const LAS f32x4*)(vec + MV_HSC * 128 + 32 * tt + 4 * hh + 8 * g); gs4[g] = *(const LAS f32x4*)(vec + MV_GSC * 128 + 32 * tt + 4 * hh + 8 * g); }
#pragma unroll
            for (int reg = 0; reg < 16; ++reg) {
                const int t = 32 * tt + (reg & 3) + 8 * (reg >> 2) + 4 * hh, sg = 128 * cs + t, pos = dir ? (SEQ - 1 - sg) : sg;
                bf16* orow = Hout + ((size_t)b * SEQ + pos) * MW + h * 128 + 64 * fh + r_l;
                const float hsv = hs4[reg >> 2][reg & 3], gsv = gs4[reg >> 2][reg & 3];
                orow[0] = (bf16)f2bf(N0[reg] * hsv + Q0[reg] * gsv); orow[32] = (bf16)f2bf(N1[reg] * hsv + Q1[reg] * gsv);
            }
        }
        float newn;
        {
            const float decay = vec[MV_SCAL * 128];
#pragma unroll
            for (int i = 0; i < 16; ++i) { C0[i] *= decay; C1[i] *= decay; }
            float nsum = 0.f;
#pragma unroll
            for (int ks = 0; ks < 8; ++ks) {
                const int ln_ = lndv(lane); const int r_l = ln_ & 31, hh = ln_ >> 5, blk = (ln_ >> 4) & 1, qq = (ln_ & 15) >> 2, pp = ln_ & 3, xr = xsw(r_l); (void)blk; (void)qq; (void)pp; (void)xr; (void)hh;
                const bf16x8 kr = ml_trfrag<false>(lds + ML_K, 16 * ks, tt, hh, blk, qq, pp);
                const f32x4 w0 = *(const LAS f32x4*)(vec + MV_WEXP * 128 + 16 * ks + 8 * hh), w1 = *(const LAS f32x4*)(vec + MV_WEXP * 128 + 16 * ks + 8 * hh + 4);
                const v4u ku = __builtin_bit_cast(v4u, kr);
                const float e0 = bflo(ku.x) * w0.x, e1 = bfhi(ku.x) * w0.y, e2 = bflo(ku.y) * w0.z, e3 = bfhi(ku.y) * w0.w, e4 = bflo(ku.z) * w1.x, e5 = bfhi(ku.z) * w1.y, e6 = bflo(ku.w) * w1.z, e7 = bfhi(ku.w) * w1.w;
                nsum += ((e0 + e1) + (e2 + e3)) + ((e4 + e5) + (e6 + e7));
                v4u au; au.x = cvtpk(e0, e1); au.y = cvtpk(e2, e3); au.z = cvtpk(e4, e5); au.w = cvtpk(e6, e7);
                const bf16x8 A = __builtin_bit_cast(bf16x8, au);
                C0 = MFMA32(A, ml_trfrag<false>(lds + ML_V, 16 * ks, 2 * fh + 0, hh, blk, qq, pp), C0);
                C1 = MFMA32(A, ml_trfrag<false>(lds + ML_V, 16 * ks, 2 * fh + 1, hh, blk, qq, pp), C1);
            }
            nsum += shx(nsum, 32, lane);
            newn = decay * vec[MV_N * 128 + 32 * tt + r_l] + nsum;
        }
        __syncthreads();
        {
            const int ln_ = lndv(lane); const int r_l = ln_ & 31, hh = ln_ >> 5, blk = (ln_ >> 4) & 1, qq = (ln_ & 15) >> 2, pp = ln_ & 3, xr = xsw(r_l); (void)blk; (void)qq; (void)pp; (void)xr; (void)hh;
            if (fh == 0 && lane < 32) vec[MV_N * 128 + 32 * tt + lane] = newn;
#pragma unroll
            for (int cl = 0; cl < 2; ++cl) {
                const int f = 32 * (2 * fh + cl) + r_l, xf = xsw(f);
#pragma unroll
                for (int g = 0; g < 4; ++g) {
                    const int e = 32 * tt + 8 * g + 4 * hh;
                    unsigned long long w;
                    if (cl == 0) w = (unsigned long long)cvtpk(C0[4 * g], C0[4 * g + 1]) | ((unsigned long long)cvtpk(C0[4 * g + 2], C0[4 * g + 3]) << 32);
                    else w = (unsigned long long)cvtpk(C1[4 * g], C1[4 * g + 1]) | ((unsigned long long)cvtpk(C1[4 * g + 2], C1[4 * g + 3]) << 32);
                    *(LAS unsigned long long*)(lds + ML_C + 256 * f + 16 * ((e >> 3) ^ xf) + 2 * (e & 7)) = w;
                }
            }
        }
    }
    __syncthreads();
}

#define PHASE_PTRS() const int tid = lndv((int)threadIdx.x), lane = tid & 63, wave = __builtin_amdgcn_readfirstlane(tid >> 6); const int gw = bid * NWAVES + wave, gt = bid * NTHR + tid; (void)lane; (void)gw; (void)gt; \
    Args a = a0; a.x = lnd(a.x); a.mix_pre_g = lnd(a.mix_pre_g); a.w_in = lnd(a.w_in); a.mconv_w = lnd(a.mconv_w); a.mconv_b = lnd(a.mconv_b); a.gate_b = lnd(a.gate_b); \
    a.head_g = lnd(a.head_g); a.w_out = lnd(a.w_out); a.mix_post_g = lnd(a.mix_post_g); a.ffn_pre_g = lnd(a.ffn_pre_g); a.w_up = lnd(a.w_up); a.fconv_w = lnd(a.fconv_w); a.fconv_b = lnd(a.fconv_b); \
    a.w_down = lnd(a.w_down); a.ffn_post_g = lnd(a.ffn_post_g); unsigned char* wsl = lnd(a.ws); \
    bf16* Win_t = (bf16*)(wsl + WS_WIN); bf16* Wout_t = (bf16*)(wsl + WS_WOUT); bf16* Wup_t = (bf16*)(wsl + WS_WUP); bf16* Wdn_t = (bf16*)(wsl + WS_WDN); \
    float* rope_c = (float*)(wsl + WS_ROPE); float* rope_s = rope_c + SEQ * 32; float* GATES = (float*)(wsl + WS_GATES); \
    bf16* HN = (bf16*)(wsl + WS_HN); bf16* PROJ = (bf16*)(wsl + WS_PROJ); bf16* HFB = (bf16*)(wsl + WS_HFB); bf16* HB16 = (bf16*)(wsl + WS_H); bf16* UB = (bf16*)(wsl + WS_U); \
    float* T = (float*)(wsl + WS_T); float* R = lnd(a.out); bf16* O1 = (bf16*)(wsl + WS_O1); float* LSE = (float*)(wsl + WS_LSE); (void)O1; (void)LSE; \
    (void)Win_t; (void)Wout_t; (void)Wup_t; (void)Wdn_t; (void)rope_c; (void)rope_s; (void)GATES; (void)HN; (void)PROJ; (void)HFB; (void)HB16; (void)UB; (void)T; (void)R;
__global__ void __launch_bounds__(NTHR, 2) hybrid_fwd(Args a0) {
    extern __shared__ __attribute__((aligned(16))) unsigned char lds_raw[];
    LAS unsigned char* lds = (LAS unsigned char*)lds_raw;
    volatile LAS unsigned* MISC = (volatile LAS unsigned*)(lds + MISC_OFF);
    const int tid = threadIdx.x, lane = tid & 63, wave = __builtin_amdgcn_readfirstlane(tid >> 6);
    const int G = gridDim.x, bid = blockIdx.x;
    unsigned char* ws = a0.ws;
    gu32* ctl = (gu32*)(ws + WS_CTL);
    for (int u = tid; u < (LDS_BYTES - LDSCTL_OFF) / 4; u += NTHR) ((LAS unsigned*)(lds + LDSCTL_OFF))[u] = 0u;
    __syncthreads();
    XcdBarrier bar = xcd_barrier_post((unsigned*)(ctl + CW_BAR), MISC + 8);
#define GRID_BAR() xcd_barrier(bar)
    const int gw = bid * NWAVES + wave, NGW = G * NWAVES;
    const int gt = bid * NTHR + tid, NGT = G * NTHR;


    {
            PHASE_PTRS();
        LAS float* scr = (LAS float*)(lds + wave * 16384);
        constexpr int I_IN = (DM / 64) * (NPROJ / 32), I_OUT = (DM / 64) * (DM / 32), I_UP = (DM / 64) * (NUP / 32), I_DN = (DFF / 64) * (DM / 32);
        constexpr int PER_L = I_IN + I_OUT + I_UP + I_DN;
        for (int it = gw; it < DEPTH * PER_L; it += NGW) {
            const int l = it / PER_L; int r = it % PER_L;
            if (r < I_IN) { transpose_item(a.w_in + (size_t)l * DM * PROJ_COLS, DM, PROJ_COLS, NPROJ, Win_t + (size_t)l * NPROJ * DM, scr, r, lane); continue; } r -= I_IN;
            if (r < I_OUT) { transpose_item(a.w_out + (size_t)l * DM * DM, DM, DM, DM, Wout_t + (size_t)l * DM * DM, scr, r, lane); continue; } r -= I_OUT;
            if (r < I_UP) { transpose_item(a.w_up + (size_t)l * DM * NUP, DM, NUP, NUP, Wup_t + (size_t)l * NUP * DM, scr, r, lane); continue; } r -= I_UP;
            transpose_item(a.w_down + (size_t)l * DFF * DM, DFF, DM, DM, Wdn_t + (size_t)l * DM * DFF, scr, r, lane);
        }
        for (int i = gt; i < SEQ * 32; i += NGT) {
            const int pos = i >> 5, fi = i & 31;
            const float inv = powf(10000.0f, -(float)(2 * fi) / 64.0f);
            const float ang = (float)pos * inv;
            const double ad = (double)ang; const double kk = rint(ad * 0.15915494309189535); const float rr = (float)(ad - kk * 6.283185307179586);
            rope_c[i] = cosf(rr); rope_s[i] = sinf(rr);
        }
    }
    __syncthreads();
    for (int l = 0; l < DEPTH; ++l) {
        if (l == 0) {
            PHASE_PTRS();
            const float* w_in_l = a.w_in + (size_t)l * DM * PROJ_COLS;
            LAS float* wg = (LAS float*)lds;
            for (int i = tid; i < DM * 16; i += NTHR) wg[i] = w_in_l[(size_t)(i >> 4) * PROJ_COLS + NPROJ + (i & 15)];
            __syncthreads();
            f32x4 g[4];
#pragma unroll
            for (int j = 0; j < 4; ++j) g[j] = ((const GAS f32x4*)(a.mix_pre_g + (size_t)l * DM))[lane + 64 * j];
            for (int m = gw; m < M; m += NGW) {
                f32x4 v[4];
#pragma unroll
                for (int j = 0; j < 4; ++j) v[j] = ((const GAS f32x4*)(a.x + (size_t)m * DM))[lane + 64 * j];
                rms_row(v, g, lane);
                store_row_bf16(HN + (size_t)m * DM, v, lane);
                gates_row(v, wg, a.gate_b + l * 16, GATES + (size_t)m * 16, lane);
            }
            __syncthreads();
        }
        if (l == 0) { cg::this_grid().sync(); } else { GRID_BAR(); }

        {
            PHASE_PTRS();
            pg8::Gemm g{HN, Win_t + (size_t)l * NPROJ * DM, M, NPROJ, DM}; pg8::StaticOrder S; S.init(M, NPROJ, G, bid);
            pg8::EpiBf16<0> E{PROJ, NPROJ, nullptr, 0, 0, 1.f};
            pg8::gemm_phase<pg8::EpiBf16<0>, pg8::StaticOrder, true, true>(lds, g, S, E);
        }
        GRID_BAR();
        {
            PHASE_PTRS();
            for (int i = gt; i < M * 64; i += NGT) {
                const int m = i >> 6, hs = (i >> 2) & 15, i8 = i & 3, pos = m & (SEQ - 1);
                bf16* p1 = PROJ + (size_t)m * NPROJ + hs * 64 + 8 * i8;
                const v4u a1 = *(const GAS v4u*)p1, a2 = *(const GAS v4u*)(p1 + 32);
                const f32x4 c0 = *(const GAS f32x4*)(rope_c + pos * 32 + 8 * i8), c1 = *(const GAS f32x4*)(rope_c + pos * 32 + 8 * i8 + 4);
                const f32x4 s0 = *(const GAS f32x4*)(rope_s + pos * 32 + 8 * i8), s1 = *(const GAS f32x4*)(rope_s + pos * 32 + 8 * i8 + 4);
                const float sc = hs < 8 ? 0.125f : 1.f;
                float t1[8] = {bflo(a1.x), bfhi(a1.x), bflo(a1.y), bfhi(a1.y), bflo(a1.z), bfhi(a1.z), bflo(a1.w), bfhi(a1.w)};
                float t2[8] = {bflo(a2.x), bfhi(a2.x), bflo(a2.y), bfhi(a2.y), bflo(a2.z), bfhi(a2.z), bflo(a2.w), bfhi(a2.w)};
                float cc[8] = {c0.x, c0.y, c0.z, c0.w, c1.x, c1.y, c1.z, c1.w}, ss[8] = {s0.x, s0.y, s0.z, s0.w, s1.x, s1.y, s1.z, s1.w};
                float o1[8], o2[8];
#pragma unroll
                for (int q = 0; q < 8; ++q) { o1[q] = (t1[q] * cc[q] - t2[q] * ss[q]) * sc; o2[q] = (t2[q] * cc[q] + t1[q] * ss[q]) * sc; }
                v4u w1, w2; w1.x = pk2(o1[0], o1[1]); w1.y = pk2(o1[2], o1[3]); w1.z = pk2(o1[4], o1[5]); w1.w = pk2(o1[6], o1[7]);
                w2.x = pk2(o2[0], o2[1]); w2.y = pk2(o2[2], o2[3]); w2.z = pk2(o2[4], o2[5]); w2.w = pk2(o2[6], o2[7]);
                *(GAS v4u*)p1 = w1; *(GAS v4u*)(p1 + 32) = w2;
            }
            const float* cw = a.mconv_w + (size_t)l * 5 * 1024; const float* cb = a.mconv_b + (size_t)l * 1024;
            for (int i = gt; i < M * 128; i += NGT) {
                const int m = i >> 7, c8 = (i & 127) * 8, pos = m & (SEQ - 1);
                float acc[8];
#pragma unroll
                for (int q = 0; q < 8; ++q) acc[q] = cb[c8 + q];
#pragma unroll
                for (int j = 0; j < 5; ++j) {
                    const int pp = pos + j - 2;
                    if (pp >= 0 && pp < SEQ) {
                        const v4u xv = *(const GAS v4u*)(PROJ + (size_t)(m + j - 2) * NPROJ + 1536 + c8);
                        const f32x4 w0 = *(const GAS f32x4*)(cw + j * 1024 + c8), w1 = *(const GAS f32x4*)(cw + j * 1024 + c8 + 4);
                        acc[0] += bflo(xv.x) * w0.x; acc[1] += bfhi(xv.x) * w0.y; acc[2] += bflo(xv.y) * w0.z; acc[3] += bfhi(xv.y) * w0.w;
                        acc[4] += bflo(xv.z) * w1.x; acc[5] += bfhi(xv.z) * w1.y; acc[6] += bflo(xv.w) * w1.z; acc[7] += bfhi(xv.w) * w1.w;
                    }
                }
#pragma unroll
                for (int q = 0; q < 8; ++q) acc[q] = acc[q] * sigmoidf_(acc[q]);
                v4u o; o.x = pk2(acc[0], acc[1]); o.y = pk2(acc[2], acc[3]); o.z = pk2(acc[4], acc[5]); o.w = pk2(acc[6], acc[7]);
                *(GAS v4u*)(HN + (size_t)m * 1024 + c8) = o;
            }
        }
        GRID_BAR();
        if (bid < 64) {
            PHASE_PTRS();
            const int b = bid >> 3, h = (bid >> 1) & 3, dir = bid & 1;
            mlstm_scan(lds, HN, PROJ, GATES, HFB + (size_t)dir * M * MW, b, h, dir, tid);
        } else {
            PHASE_PTRS();
            const int NWA = (G - 64) * NWAVES;
            LAS unsigned char* wl = lds + wave * 8192;
            for (int t = (bid - 64) * NWAVES + wave; t < BATCH * AH * 192; t += NWA) {
                const int bh = t / 192, rem = t % 192, br = rem >> 6, ti = rem & 63, b = bh >> 3, h = bh & 7;
                const bf16* base = PROJ + (size_t)b * SEQ * NPROJ + h * 64;
                bf16* obase; int ostride;
                if (br == 0) { obase = O1 + (size_t)b * SEQ * AW + h * 64; ostride = AW; }
                else { obase = PROJ + (size_t)b * SEQ * NPROJ + (br == 1 ? 1536 : 2048) + h * 64; ostride = NPROJ; }
                attn_task(base, obase, ostride, LSE + (size_t)br * M * 8 + (size_t)b * SEQ * 8 + h, br, ti, wl, lane);
            }
        }
        GRID_BAR();
        {
            PHASE_PTRS();
            const float* hg = a.head_g + (size_t)l * MW;
            for (int m = gw; m < M; m += NGW) {
                {
                    const v4u o1 = *(const GAS v4u*)(O1 + (size_t)m * AW + 8 * lane), o2 = *(const GAS v4u*)(PROJ + (size_t)m * NPROJ + 1536 + 8 * lane), o3 = *(const GAS v4u*)(PROJ + (size_t)m * NPROJ + 2048 + 8 * lane);
                    const float l1 = LSE[(size_t)m * 8 + (lane >> 3)], l2 = LSE[(size_t)M * 8 + (size_t)m * 8 + (lane >> 3)], l3 = LSE[(size_t)2 * M * 8 + (size_t)m * 8 + (lane >> 3)];
                    const float lm = fmaxf(l1, fmaxf(l2, l3));
                    float w1 = __expf(l1 - lm), w2 = __expf(l2 - lm), w3 = __expf(l3 - lm); const float wi = 1.f / (w1 + w2 + w3); w1 *= wi; w2 *= wi; w3 *= wi;
                    v4u w;
                    w.x = pk2(w1 * bflo(o1.x) + w2 * bflo(o2.x) + w3 * bflo(o3.x), w1 * bfhi(o1.x) + w2 * bfhi(o2.x) + w3 * bfhi(o3.x));
                    w.y = pk2(w1 * bflo(o1.y) + w2 * bflo(o2.y) + w3 * bflo(o3.y), w1 * bfhi(o1.y) + w2 * bfhi(o2.y) + w3 * bfhi(o3.y));
                    w.z = pk2(w1 * bflo(o1.z) + w2 * bflo(o2.z) + w3 * bflo(o3.z), w1 * bfhi(o1.z) + w2 * bfhi(o2.z) + w3 * bfhi(o3.z));
                    w.w = pk2(w1 * bflo(o1.w) + w2 * bflo(o2.w) + w3 * bflo(o3.w), w1 * bfhi(o1.w) + w2 * bfhi(o2.w) + w3 * bfhi(o3.w));
                    *(GAS v4u*)(HN + (size_t)m * 1024 + 8 * lane) = w;
                }
                const v4u hf = *(const GAS v4u*)(HFB + (size_t)m * MW + 8 * lane), hb = *(const GAS v4u*)(HFB + (size_t)M * MW + (size_t)m * MW + 8 * lane);
                const v4u mo = *(const GAS v4u*)(PROJ + (size_t)m * NPROJ + 3072 + 8 * lane);
                float hm[8] = {bflo(hf.x) + bflo(hb.x), bfhi(hf.x) + bfhi(hb.x), bflo(hf.y) + bflo(hb.y), bfhi(hf.y) + bfhi(hb.y),
                               bflo(hf.z) + bflo(hb.z), bfhi(hf.z) + bfhi(hb.z), bflo(hf.w) + bflo(hb.w), bfhi(hf.w) + bfhi(hb.w)};
                float ov[8] = {bflo(mo.x), bfhi(mo.x), bflo(mo.y), bfhi(mo.y), bflo(mo.z), bfhi(mo.z), bflo(mo.w), bfhi(mo.w)};
                float s = 0.f;
#pragma unroll
                for (int q = 0; q < 8; ++q) s += hm[q] * hm[q];
                s += shx(s, 1, lane); s += shx(s, 2, lane); s += shx(s, 4, lane); s += shx(s, 8, lane);
                const float rs = 1.0f / sqrtf(s * (1.f / 128.f) + EPS);
                const f32x4 g0 = *(const GAS f32x4*)(hg + 8 * lane), g1 = *(const GAS f32x4*)(hg + 8 * lane + 4);
                const float gg[8] = {g0.x, g0.y, g0.z, g0.w, g1.x, g1.y, g1.z, g1.w};
                float o[8];
#pragma unroll
                for (int q = 0; q < 8; ++q) o[q] = hm[q] * rs * gg[q] * sigmoidf_(ov[q]);
                v4u w; w.x = pk2(o[0], o[1]); w.y = pk2(o[2], o[3]); w.z = pk2(o[4], o[5]); w.w = pk2(o[6], o[7]);
                *(GAS v4u*)(HN + (size_t)m * 1024 + 512 + 8 * lane) = w;
            }
        }
        GRID_BAR();
        {
            PHASE_PTRS();
            pg8::Gemm g{HN, Wout_t + (size_t)l * DM * DM, M, DM, DM}; pg8::StaticOrder S; S.init(M, DM, G, bid);
            pg8::EpiF32 E{T, DM, nullptr};
            pg8::gemm_phase<pg8::EpiF32, pg8::StaticOrder, true, true>(lds, g, S, E);
        }
        GRID_BAR();
        {
            PHASE_PTRS();
            f32x4 g1[4], g2[4];
#pragma unroll
            for (int j = 0; j < 4; ++j) { g1[j] = ((const GAS f32x4*)(a.mix_post_g + (size_t)l * DM))[lane + 64 * j]; g2[j] = ((const GAS f32x4*)(a.ffn_pre_g + (size_t)l * DM))[lane + 64 * j]; }
            const float* xin = (l == 0) ? a.x : R;
            for (int m = gw; m < M; m += NGW) {
                f32x4 v[4], xb[4];
#pragma unroll
                for (int j = 0; j < 4; ++j) { v[j] = ((const GAS f32x4*)(T + (size_t)m * DM))[lane + 64 * j]; xb[j] = ((const GAS f32x4*)(xin + (size_t)m * DM))[lane + 64 * j]; }
                rms_row(v, g1, lane);
#pragma unroll
                for (int j = 0; j < 4; ++j) { v[j] = v[j] + xb[j]; ((GAS f32x4*)(R + (size_t)m * DM))[lane + 64 * j] = v[j]; }
                rms_row(v, g2, lane);
                store_row_bf16(HN + (size_t)m * DM, v, lane);
            }
        }
        GRID_BAR();
        for (int qd = 0; qd < 4; ++qd) {
            PHASE_PTRS();
            {
                pg8::Gemm g{HN + (size_t)qd * 4096 * DM, Wup_t + (size_t)l * NUP * DM, 4096, NUP, DM}; pg8::StaticOrder S; S.init(4096, NUP, G, bid);
                pg8::EpiBf16<0> E{UB, NUP, nullptr, 0, 0, 1.f};
                pg8::gemm_phase<pg8::EpiBf16<0>, pg8::StaticOrder, true, true>(lds, g, S, E);
            }
            GRID_BAR();
            {
                const float* cw = a.fconv_w + (size_t)l * 3 * NUP; const float* cb = a.fconv_b + (size_t)l * NUP;
                for (int i = gt; i < 4096 * (DFF / 8); i += NGT) {
                    const int t = i / (DFF / 8), c8 = (i % (DFF / 8)) * 8, pos = t & (SEQ - 1);
                    float ga[8], va[8];
                    { const f32x4 b0 = *(const GAS f32x4*)(cb + c8), b1 = *(const GAS f32x4*)(cb + c8 + 4), b2 = *(const GAS f32x4*)(cb + DFF + c8), b3 = *(const GAS f32x4*)(cb + DFF + c8 + 4);
                      ga[0] = b0.x; ga[1] = b0.y; ga[2] = b0.z; ga[3] = b0.w; ga[4] = b1.x; ga[5] = b1.y; ga[6] = b1.z; ga[7] = b1.w;
                      va[0] = b2.x; va[1] = b2.y; va[2] = b2.z; va[3] = b2.w; va[4] = b3.x; va[5] = b3.y; va[6] = b3.z; va[7] = b3.w; }
#pragma unroll
                    for (int j = 0; j < 3; ++j) {
                        const int pp = pos + j - 1;
                        if (pp >= 0 && pp < SEQ) {
                            const v4u xg = *(const GAS v4u*)(UB + (size_t)(t + j - 1) * NUP + c8), xv = *(const GAS v4u*)(UB + (size_t)(t + j - 1) * NUP + DFF + c8);
                            const f32x4 w0 = *(const GAS f32x4*)(cw + j * NUP + c8), w1 = *(const GAS f32x4*)(cw + j * NUP + c8 + 4);
                            const f32x4 w2 = *(const GAS f32x4*)(cw + j * NUP + DFF + c8), w3 = *(const GAS f32x4*)(cw + j * NUP + DFF + c8 + 4);
                            ga[0] += bflo(xg.x) * w0.x; ga[1] += bfhi(xg.x) * w0.y; ga[2] += bflo(xg.y) * w0.z; ga[3] += bfhi(xg.y) * w0.w;
                            ga[4] += bflo(xg.z) * w1.x; ga[5] += bfhi(xg.z) * w1.y; ga[6] += bflo(xg.w) * w1.z; ga[7] += bfhi(xg.w) * w1.w;
                            va[0] += bflo(xv.x) * w2.x; va[1] += bfhi(xv.x) * w2.y; va[2] += bflo(xv.y) * w2.z; va[3] += bfhi(xv.y) * w2.w;
                            va[4] += bflo(xv.z) * w3.x; va[5] += bfhi(xv.z) * w3.y; va[6] += bflo(xv.w) * w3.z; va[7] += bfhi(xv.w) * w3.w;
                        }
                    }
                    float o[8];
#pragma unroll
                    for (int q = 0; q < 8; ++q) o[q] = gelu_tanh(ga[q]) * va[q];
                    v4u w; w.x = pk2(o[0], o[1]); w.y = pk2(o[2], o[3]); w.z = pk2(o[4], o[5]); w.w = pk2(o[6], o[7]);
                    *(GAS v4u*)(HB16 + (size_t)(qd * 4096 + t) * DFF + c8) = w;
                }
            }
            GRID_BAR();
        }
        {
            PHASE_PTRS();
            pg8::Gemm g{HB16, Wdn_t + (size_t)l * DM * DFF, M, DM, DFF}; pg8::StaticOrder S; S.init(M, DM, G, bid);
            pg8::EpiF32 E{T, DM, nullptr};
            pg8::gemm_phase<pg8::EpiF32, pg8::StaticOrder, true, true>(lds, g, S, E);
        }
        GRID_BAR();
        {
            PHASE_PTRS();
            const bool more = (l + 1 < DEPTH);
            LAS float* wg = (LAS float*)lds;
            if (more) {
                const float* w_in_n = a.w_in + (size_t)(l + 1) * DM * PROJ_COLS;
                for (int i = tid; i < DM * 16; i += NTHR) wg[i] = w_in_n[(size_t)(i >> 4) * PROJ_COLS + NPROJ + (i & 15)];
                __syncthreads();
            }
            f32x4 g1[4], g2[4];
#pragma unroll
            for (int j = 0; j < 4; ++j) { g1[j] = ((const GAS f32x4*)(a.ffn_post_g + (size_t)l * DM))[lane + 64 * j];
                g2[j] = more ? ((const GAS f32x4*)(a.mix_pre_g + (size_t)(l + 1) * DM))[lane + 64 * j] : (f32x4){0.f, 0.f, 0.f, 0.f}; }
            for (int m = gw; m < M; m += NGW) {
                f32x4 v[4], xb[4];
#pragma unroll
                for (int j = 0; j < 4; ++j) { v[j] = ((const GAS f32x4*)(T + (size_t)m * DM))[lane + 64 * j]; xb[j] = ((const GAS f32x4*)(R + (size_t)m * DM))[lane + 64 * j]; }
                rms_row(v, g1, lane);
#pragma unroll
                for (int j = 0; j < 4; ++j) { v[j] = v[j] + xb[j]; ((GAS f32x4*)(R + (size_t)m * DM))[lane + 64 * j] = v[j]; }
                if (more) {
                    rms_row(v, g2, lane);
                    store_row_bf16(HN + (size_t)m * DM, v, lane);
                    gates_row(v, wg, a.gate_b + (l + 1) * 16, GATES + (size_t)m * 16, lane);
                }
            }
            __syncthreads();
        }
    }
}

extern "C" void kernel_launch(void* const* d_in, const int* in_sizes, int n_in, void* d_out, int out_size, void* d_ws, size_t ws_size, hipStream_t stream) {
    static int grid = 0;
    if (grid == 0) {
        if (n_in != 15 || in_sizes[0] != M * DM || out_size != M * DM || ws_size < WS_END) { fprintf(stderr, "kernel_launch: unexpected shapes n_in %d in0 %d out %d ws %zu\n", n_in, n_in > 0 ? in_sizes[0] : -1, out_size, ws_size); grid = -1; return; }
        int dev = 0, cus = 0, per_cu = 0;
        hipGetDevice(&dev); hipDeviceGetAttribute(&cus, hipDeviceAttributeMultiprocessorCount, dev);
        if (hipFuncSetAttribute((const void*)hybrid_fwd, hipFuncAttributeMaxDynamicSharedMemorySize, LDS_BYTES) != hipSuccess) { fprintf(stderr, "kernel_launch: hipFuncSetAttribute failed\n"); grid = -1; return; }
        if (hipOccupancyMaxActiveBlocksPerMultiprocessor(&per_cu, (const void*)hybrid_fwd, NTHR, LDS_BYTES) != hipSuccess || per_cu < 1) { fprintf(stderr, "kernel_launch: occupancy query says %d\n", per_cu); per_cu = 1; }
        (void)hipGetLastError();
        grid = cus;
        if (grid > 256) grid = 256;
    }
    if (grid < 0) return;
    if (hipMemsetAsync((char*)d_ws + WS_CTL, 0, CTL_ZERO_BYTES, stream) != hipSuccess) { fprintf(stderr, "kernel_launch: memset failed\n"); return; }
    Args a{};
    a.x = (const float*)d_in[0]; a.mix_pre_g = (const float*)d_in[1]; a.w_in = (const float*)d_in[2]; a.mconv_w = (const float*)d_in[3]; a.mconv_b = (const float*)d_in[4];
    a.gate_b = (const float*)d_in[5]; a.head_g = (const float*)d_in[6]; a.w_out = (const float*)d_in[7]; a.mix_post_g = (const float*)d_in[8]; a.ffn_pre_g = (const float*)d_in[9];
    a.w_up = (const float*)d_in[10]; a.fconv_w = (const float*)d_in[11]; a.fconv_b = (const float*)d_in[12]; a.w_down = (const float*)d_in[13]; a.ffn_post_g = (const float*)d_in[14];
    a.out = (float*)d_out; a.ws = (unsigned char*)d_ws;
    void* args[] = {&a};
    hipError_t e = hipLaunchCooperativeKernel((const void*)hybrid_fwd, dim3(grid), dim3(NTHR), args, LDS_BYTES, stream);
    if (e != hipSuccess) fprintf(stderr, "cooperative launch failed: %s (grid %d)\n", hipGetErrorString(e), grid);
}
```

```cpp
#include <hip/hip_runtime.h>
#include <hip/hip_cooperative_groups.h>
#include <cstdio>
#include <cstdint>
namespace cg = cooperative_groups;
namespace pg8 {
#define PG8_LAS __attribute__((address_space(3)))
typedef unsigned short bf16_t;
typedef short bf16x8 __attribute__((ext_vector_type(8)));
typedef float f32x4 __attribute__((ext_vector_type(4)));
typedef unsigned u32x4 __attribute__((ext_vector_type(4)));
constexpr int BM = 256, BK = 64, HALF = 128, HTB = HALF * BK * 2  , STAGE_BYTES = 8 * HTB, NXCD = 8, WGM = 8;

__host__ __device__ __forceinline__ int lds_byte(int r, int c) { const int st = (r >> 4) * 2 + (c >> 5), rr = r & 15, cc = c & 31, ob = rr * 64 + cc * 2; return st * 1024 + (ob ^ (((ob >> 9) & 1) << 5)); }
__host__ __device__ __forceinline__ void stage_rc(int b, int& R, int& C) { const int st = b / 1024, sb = b % 1024, swz = sb ^ (((sb >> 9) & 1) << 5); R = (st >> 1) * 16 + swz / 64; C = (st & 1) * 32 + (swz % 64) / 2; }
__host__ __device__ __forceinline__ int perm32(int rho) { const int n = rho >> 4, i = rho & 15; return 8 * (i >> 2) + 4 * n + (i & 3); }

struct Unit { int pm, pn; };
struct Gemm { const bf16_t* A; const bf16_t* Bt; int M, N, K; };

struct StaticOrder {
    int nM, nN, nwg, G, c;
    __host__ __device__ void init(int M, int N, int G_, int c_) { nM = M / BM; nN = N / BM; nwg = nM * nN; G = G_; c = c_; }
    __host__ __device__ bool next(int i, Unit& u) const {
        const long L = (long)i * G + c; if (L >= nwg) return false;
        int wgid = (int)L; { const int q = nwg / NXCD, r = nwg % NXCD, xcd = wgid % NXCD, off = wgid / NXCD; wgid = (xcd < r ? xcd * (q + 1) : r * (q + 1) + (xcd - r) * q) + off; }
        const int nig = WGM * nN, gid = wgid / nig, fm = gid * WGM, gsz = (nM - fm) < WGM ? (nM - fm) : WGM;
        u.pm = fm + ((wgid % nig) % gsz); u.pn = (wgid % nig) / gsz; return true;
    }
    __device__ __forceinline__ void a_ready(const Unit&) const {}
    __device__ __forceinline__ void done(const Unit&) const {}
};

__device__ __forceinline__ unsigned cvt_pk_bf16(float lo, float hi) { unsigned r; asm volatile("v_cvt_pk_bf16_f32 %0, %1, %2" : "=v"(r) : "v"(lo), "v"(hi)); return r; }
typedef float f32x2 __attribute__((ext_vector_type(2)));
__device__ __forceinline__ f32x2 gelu_pk(f32x2 v) {
    const f32x2 av = __builtin_elementwise_abs(v), d = av * 0.2316418882f + 1.0f;
    f32x2 t; t.x = __builtin_amdgcn_rcpf(d.x); t.y = __builtin_amdgcn_rcpf(d.y);
    f32x2 q = t * 0.5307027145f + (-0.7265760135f); q = q * t + 0.7107068705f; q = q * t + (-0.142248368f); q = q * t + 0.127414796f; q = q * t;
    const f32x2 s = (v * v) * (-0.72134752044f);
    f32x2 e; e.x = __builtin_amdgcn_exp2f(s.x); e.y = __builtin_amdgcn_exp2f(s.y);
    const f32x2 m = v * (q * e), r = v - m;
    f32x2 o; o.x = v.x < 0.f ? m.x : r.x; o.y = v.y < 0.f ? m.y : r.y; return o;
}

template <int ACT  > struct EpiBf16 {
    static constexpr bool PERM = true, AFTER_DRAIN = false; static_assert(ACT == 0 || ACT == 1, "EpiBf16: ACT is 0 (none) or 1 (gelu_pk)");
    bf16_t* O; int ldc; const float* bias; int split_cols; size_t split_stride; float scale0;
    __device__ __forceinline__ void operator()(const f32x4 (&acc)[2][2][4][2], const Unit& u, int wr, int wc, int fr, int fq) const {
        const int row0 = u.pm * BM + wr * 64 + fr; int colt = u.pn * BM; bf16_t* base = O;
        float sc = 1.f; if (split_cols) { const int t = colt / split_cols; base += (size_t)t * split_stride; colt -= t * split_cols; if (t == 0) sc = scale0; }
        const int col0 = colt + wc * 32 + 8 * fq, bcol0 = u.pn * BM + wc * 32 + 8 * fq;
        f32x4 bv[2][2];
#pragma unroll
        for (int bj = 0; bj < 2; ++bj)
#pragma unroll
            for (int n = 0; n < 2; ++n) bv[bj][n] = bias ? *(const f32x4*)(bias + bcol0 + bj * HALF + 4 * n) : (f32x4){0.f, 0.f, 0.f, 0.f};
#pragma unroll
        for (int ai = 0; ai < 2; ++ai)
#pragma unroll
            for (int m = 0; m < 4; ++m) { bf16_t* rowp = base + (size_t)(row0 + ai * HALF + m * 16) * ldc + col0;
#pragma unroll
                for (int bj = 0; bj < 2; ++bj) { f32x4 v0 = acc[ai][bj][m][0] + bv[bj][0], v1 = acc[ai][bj][m][1] + bv[bj][1];
                    if (ACT == 1) { f32x2 a = gelu_pk((f32x2){v0[0], v0[1]}), b = gelu_pk((f32x2){v0[2], v0[3]}), c = gelu_pk((f32x2){v1[0], v1[1]}), d = gelu_pk((f32x2){v1[2], v1[3]});
                        v0 = (f32x4){a.x, a.y, b.x, b.y}; v1 = (f32x4){c.x, c.y, d.x, d.y}; }
                    v0 = v0 * sc; v1 = v1 * sc; u32x4 w; w.x = cvt_pk_bf16(v0[0], v0[1]); w.y = cvt_pk_bf16(v0[2], v0[3]); w.z = cvt_pk_bf16(v1[0], v1[1]); w.w = cvt_pk_bf16(v1[2], v1[3]);
                    *(u32x4*)(rowp + bj * HALF) = w; } }
    }
};
struct EpiF32 {
    static constexpr bool PERM = false, AFTER_DRAIN = false;
    float* C; int ldc; const float* bias;
    __device__ __forceinline__ void operator()(const f32x4 (&acc)[2][2][4][2], const Unit& u, int wr, int wc, int fr, int fq) const {
        const int row0 = u.pm * BM + wr * 64 + fr, col0 = u.pn * BM + wc * 32 + 4 * fq;
        f32x4 bv[2][2];
#pragma unroll
        for (int bj = 0; bj < 2; ++bj)
#pragma unroll
            for (int n = 0; n < 2; ++n) bv[bj][n] = bias ? *(const f32x4*)(bias + col0 + bj * HALF + n * 16) : (f32x4){0.f, 0.f, 0.f, 0.f};
#pragma unroll
        for (int ai = 0; ai < 2; ++ai)
#pragma unroll
            for (int m = 0; m < 4; ++m) { float* rowp = C + (size_t)(row0 + ai * HALF + m * 16) * ldc + col0;
#pragma unroll
                for (int bj = 0; bj < 2; ++bj)
#pragma unroll
                    for (int n = 0; n < 2; ++n) *(f32x4*)(rowp + bj * HALF + n * 16) = acc[ai][bj][m][n] + bv[bj][n]; }
    }
};
__device__ __forceinline__ float gelu_tanh_f(float x) {
    const float u2 = 1.5957691216057308f * (x + 0.044715f * x * x * x);
    const float e = __expf(u2);
    return x - x / (1.f + e);
}
struct EpiFfn {
    static constexpr bool PERM = true, AFTER_DRAIN = false;
    bf16_t* H; const float* cw; const float* cb;
    __device__ __forceinline__ void operator()(const f32x4 (&acc)[2][2][4][2], const Unit& u, int wr, int wc, int fr, int fq) const {
        int lane = fq * 16 + fr; asm volatile("" : "+v"(lane));
        const int sg = 2 * u.pm + wr, b = sg / 17, j = sg - 17 * b;
        const int i0 = 8 * fr, tok0 = 126 * j - 1 + i0;
        const int colh = u.pn * 128 + wc * 32 + 8 * fq;
        int up = (lane - 1) << 2, dn = (lane + 1) << 2; asm volatile("" : "+v"(up), "+v"(dn));
        unsigned ow[8][2][2];
#pragma unroll
        for (int n = 0; n < 2; ++n) {
            const int c = colh + 4 * n;
            const f32x4 wg0 = *(const f32x4*)(cw + c), wg1 = *(const f32x4*)(cw + 5632 + c), wg2 = *(const f32x4*)(cw + 2 * 5632 + c), bg = *(const f32x4*)(cb + c);
            const f32x4 wv0 = *(const f32x4*)(cw + 2816 + c), wv1 = *(const f32x4*)(cw + 5632 + 2816 + c), wv2 = *(const f32x4*)(cw + 2 * 5632 + 2816 + c), bv = *(const f32x4*)(cb + 2816 + c);
            float hv[8][4];
#pragma unroll
            for (int k = 0; k < 4; ++k) {
                float ug[8], uv[8];
#pragma unroll
                for (int e = 0; e < 8; ++e) { ug[e] = acc[e >> 2][0][e & 3][n][k]; uv[e] = acc[e >> 2][1][e & 3][n][k]; }
                const float gp = __builtin_bit_cast(float, __builtin_amdgcn_ds_bpermute(up, __builtin_bit_cast(int, ug[7])));
                const float gn = __builtin_bit_cast(float, __builtin_amdgcn_ds_bpermute(dn, __builtin_bit_cast(int, ug[0])));
                const float vp = __builtin_bit_cast(float, __builtin_amdgcn_ds_bpermute(up, __builtin_bit_cast(int, uv[7])));
                const float vn = __builtin_bit_cast(float, __builtin_amdgcn_ds_bpermute(dn, __builtin_bit_cast(int, uv[0])));
#pragma unroll
                for (int e = 0; e < 8; ++e) {
                    const float gm = (e == 0) ? gp : ug[e > 0 ? e - 1 : 0], gq = (e == 7) ? gn : ug[e < 7 ? e + 1 : 7];
                    const float vm = (e == 0) ? vp : uv[e > 0 ? e - 1 : 0], vq = (e == 7) ? vn : uv[e < 7 ? e + 1 : 7];
                    const float gc = wg0[k] * gm + wg1[k] * ug[e] + wg2[k] * gq + bg[k], vc = wv0[k] * vm + wv1[k] * uv[e] + wv2[k] * vq + bv[k];
                    hv[e][k] = gelu_tanh_f(gc) * vc;
                }
            }
#pragma unroll
            for (int e = 0; e < 8; ++e) { ow[e][n][0] = cvt_pk_bf16(hv[e][0], hv[e][1]); ow[e][n][1] = cvt_pk_bf16(hv[e][2], hv[e][3]); }
        }
#pragma unroll
        for (int e = 0; e < 8; ++e) {
            const int i = i0 + e, tok = tok0 + e;
            if (i >= 1 && i <= 126 && tok < 2048) {
                u32x4 w; w.x = ow[e][0][0]; w.y = ow[e][0][1]; w.z = ow[e][1][0]; w.w = ow[e][1][1];
                *(u32x4*)(H + (size_t)(b * 2048 + tok) * 2816 + colh) = w;
            }
        }
    }
};
struct APlain { static constexpr bool GATHER = false; const char* base; __device__ __forceinline__ unsigned rowoff(int, int) const { return 0u; } };
struct AFfn { static constexpr bool GATHER = true; const char* base; unsigned hn_off;
    __device__ __forceinline__ unsigned rowoff(int pm, int R) const {
        const int ai = R >> 7, wr = (R >> 6) & 1, m = (R >> 4) & 3, fr = R & 15;
        const int sg = 2 * pm + wr, b = sg / 17, j = sg - 17 * b, tok = 126 * j - 1 + 8 * fr + 4 * ai + m;
        return (tok >= 0 && tok < 2048) ? hn_off + (unsigned)(b * 2048 + tok) * 2048u : 0u; } };
template <class Epi, class Sched, bool ALIGN_EPI = false, bool SP2 = false, class AMap = APlain>
__device__ __forceinline__ void gemm_phase(PG8_LAS unsigned char* lds, const Gemm g, const Sched& S, const Epi& E, const AMap AM = AMap{nullptr}) {
    static_assert(SP2 || !AMap::GATHER, "gathered A rows: SP2 path only");
    int tid_ = threadIdx.x; asm volatile("" : "+v"(tid_));
    const int tid = tid_, wid = __builtin_amdgcn_readfirstlane(tid >> 6), lane = tid & 63, wr = wid >> 2, wc = wid & 3, fr = lane & 15, fq = lane >> 4;
    const int K = g.K, nt = K / BK;
    unsigned voffA[2], voffB[2];
#pragma unroll
    for (int i = 0; i < 2; ++i) { int R, C; stage_rc(tid * 16 + i * 8192, R, C); const int Rb = Epi::PERM ? ((R & ~31) + perm32(R & 31)) : R;
        voffA[i] = (unsigned)(R * K + C) * 2u; voffB[i] = (unsigned)(Rb * K + C) * 2u; }
    const size_t kstep = (size_t)(BK * 2);
    const size_t hstep = (size_t)HALF * K * 2;
    const size_t tstep = 2 * hstep;
    const unsigned ldsw = (unsigned)wid * 1024u;
    const int aoff = lds_byte(wr * 64 + fr, fq * 8), boff = lds_byte(wc * 32 + fr, fq * 8);
#define PG8_SA(b, h) (((b) * 2 + (h)) * HTB)
#define PG8_SB(b, h) ((4 + (b) * 2 + (h)) * HTB)
#define PG8_STAGE(bufoff, gbase, voff) do { _Pragma("unroll") for (int _i = 0; _i < 2; ++_i) \
        __builtin_amdgcn_global_load_lds((const unsigned*)((const char*)(gbase) + (voff)[_i]), (PG8_LAS unsigned*)(lds + (bufoff) + ldsw + _i * 8192), 16, 0, 0); } while (0)
#define PG8_STAGE_A(bufoff, plainptr, kb, vg) do { if constexpr (AMap::GATHER) { PG8_STAGE(bufoff, AM.base + (kb), vg); } else { PG8_STAGE(bufoff, plainptr, voffA); } } while (0)
#define PG8_LDA(dst, b, h) do { _Pragma("unroll") for (int m = 0; m < 4; ++m) _Pragma("unroll") for (int k = 0; k < 2; ++k) dst[m][k] = *(const PG8_LAS bf16x8*)(lds + PG8_SA(b, h) + aoff + m * 2048 + k * 1024); } while (0)
#define PG8_LDB(dst, b, h) do { _Pragma("unroll") for (int n = 0; n < 2; ++n) _Pragma("unroll") for (int k = 0; k < 2; ++k) dst[n][k] = *(const PG8_LAS bf16x8*)(lds + PG8_SB(b, h) + boff + n * 2048 + k * 1024); } while (0)
#define PG8_MMA(ai, bj, At, Bt) do { __builtin_amdgcn_s_setprio(1); _Pragma("unroll") for (int m = 0; m < 4; ++m) _Pragma("unroll") for (int n = 0; n < 2; ++n) _Pragma("unroll") for (int k = 0; k < 2; ++k) \
        acc[ai][bj][m][n] = __builtin_amdgcn_mfma_f32_16x16x32_bf16(Bt[n][k], At[m][k], acc[ai][bj][m][n], 0, 0, 0); __builtin_amdgcn_s_setprio(0); } while (0)
#define PG8_WAIT_V(n) asm volatile("s_waitcnt vmcnt(" #n ")" ::: "memory")
#define PG8_WAIT_L(n) asm volatile("s_waitcnt lgkmcnt(" #n ")" ::: "memory")
#define PG8_BAR __builtin_amdgcn_s_barrier()
#define PG8_SCHED __builtin_amdgcn_sched_barrier(0)
    Unit cur, nxt; int ui = 0;
    if (!S.next(0, cur)) return;
    f32x4 acc[2][2][4][2];
#pragma unroll
    for (int a = 0; a < 2; ++a)
#pragma unroll
        for (int b = 0; b < 2; ++b)
#pragma unroll
            for (int m = 0; m < 4; ++m)
#pragma unroll
                for (int n = 0; n < 2; ++n) acc[a][b][m][n] = (f32x4){0.f, 0.f, 0.f, 0.f};
    bf16x8 At[4][2], B0[2][2], B1[2][2];
    const char* cA = (const char*)g.A + (size_t)cur.pm * tstep; const char* cB = (const char*)g.Bt + (size_t)cur.pn * tstep;
    S.a_ready(cur);
    unsigned vcur[2][2] = {{0u, 0u}, {0u, 0u}}, vnxt[2][2] = {{0u, 0u}, {0u, 0u}};
#define PG8_SETV(v, pm_) do { if constexpr (AMap::GATHER) { _Pragma("unroll") for (int h_ = 0; h_ < 2; ++h_) _Pragma("unroll") for (int i_ = 0; i_ < 2; ++i_) { int R_, C_; stage_rc(tid * 16 + i_ * 8192, R_, C_); v[h_][i_] = AM.rowoff(pm_, 128 * h_ + R_) + (unsigned)C_ * 2u; } } } while (0)
    PG8_SETV(vcur, cur.pm);
    if constexpr (SP2) {
        PG8_STAGE(PG8_SB(0, 0), cB, voffB); PG8_STAGE(PG8_SB(0, 1), cB + hstep, voffB); PG8_STAGE_A(PG8_SA(0, 0), cA, 0, vcur[0]); PG8_STAGE_A(PG8_SA(0, 1), cA + hstep, 0, vcur[1]);
        if (wr == 1) PG8_BAR;
        PG8_WAIT_V(2); PG8_BAR;
        PG8_STAGE(PG8_SB(1, 0), cB + kstep, voffB); PG8_STAGE_A(PG8_SA(1, 0), cA + kstep, kstep, vcur[0]); PG8_STAGE(PG8_SB(1, 1), cB + hstep + kstep, voffB);
        PG8_WAIT_V(6); PG8_BAR;
    } else {
        PG8_STAGE(PG8_SB(0, 0), cB, voffB); PG8_STAGE(PG8_SA(0, 0), cA, voffA); PG8_STAGE(PG8_SB(0, 1), cB + hstep, voffB); PG8_STAGE(PG8_SA(0, 1), cA + hstep, voffA);
        if (wr == 1) PG8_BAR;
        PG8_WAIT_V(4); PG8_BAR;
        PG8_STAGE(PG8_SB(1, 0), cB + kstep, voffB); PG8_STAGE(PG8_SA(1, 0), cA + kstep, voffA); PG8_STAGE(PG8_SB(1, 1), cB + hstep + kstep, voffB);
        PG8_WAIT_V(6); PG8_BAR;
    }
    for (;;) {
        const bool has_next = S.next(ui + 1, nxt);
        if (has_next) PG8_SETV(vnxt, nxt.pm);
        const char* nA = has_next ? (const char*)g.A + (size_t)nxt.pm * tstep : cA; const char* nB = has_next ? (const char*)g.Bt + (size_t)nxt.pn * tstep : cB;
        for (int t = 0; t < nt; t += 2) {
            const bool last = (t == nt - 2);
            const char* a1 = cA + (size_t)(t + 1) * kstep;
            const char* a2 = last ? nA : cA + (size_t)(t + 2) * kstep; const char* b2 = last ? nB : cB + (size_t)(t + 2) * kstep;
            const char* a3 = a2 + kstep; const char* b3 = b2 + kstep;
            if (last && has_next) S.a_ready(nxt);
            const size_t k1 = (size_t)(t + 1) * kstep, k2 = last ? (size_t)0 : (size_t)(t + 2) * kstep; const bool usen = last && has_next;
            unsigned vs[2][2];
#pragma unroll
            for (int h_ = 0; h_ < 2; ++h_)
#pragma unroll
                for (int i_ = 0; i_ < 2; ++i_) vs[h_][i_] = usen ? vnxt[h_][i_] : vcur[h_][i_];
            (void)k1; (void)k2;
            if constexpr (SP2) {
            PG8_LDB(B0, 0, 0); PG8_LDB(B1, 0, 1); PG8_SCHED; PG8_LDA(At, 0, 0); PG8_STAGE_A(PG8_SA(1, 1), a1 + hstep, k1, vcur[1]);
            PG8_WAIT_V(8); PG8_WAIT_L(0); PG8_BAR; PG8_MMA(0, 0, At, B0); PG8_MMA(0, 1, At, B1); PG8_BAR; PG8_SCHED;
            PG8_LDA(At, 0, 1); PG8_STAGE(PG8_SB(0, 0), b2, voffB); PG8_STAGE(PG8_SB(0, 1), b2 + hstep, voffB); PG8_STAGE_A(PG8_SA(0, 0), a2, k2, vs[0]);
            PG8_WAIT_V(8); PG8_WAIT_L(0); PG8_BAR; PG8_MMA(1, 0, At, B0); PG8_MMA(1, 1, At, B1); PG8_BAR; PG8_SCHED;
            PG8_LDB(B0, 1, 0); PG8_LDB(B1, 1, 1); PG8_SCHED; PG8_LDA(At, 1, 0); PG8_STAGE_A(PG8_SA(0, 1), a2 + hstep, k2, vs[1]);
            PG8_WAIT_V(8); PG8_WAIT_L(0); PG8_BAR; PG8_MMA(0, 0, At, B0); PG8_MMA(0, 1, At, B1); PG8_BAR; PG8_SCHED;
            PG8_LDA(At, 1, 1); PG8_STAGE(PG8_SB(1, 0), b3, voffB); PG8_STAGE(PG8_SB(1, 1), b3 + hstep, voffB); PG8_STAGE_A(PG8_SA(1, 0), a3, k2 + kstep, vs[0]);
            PG8_WAIT_V(8); PG8_WAIT_L(0); PG8_BAR; PG8_MMA(1, 0, At, B0); PG8_MMA(1, 1, At, B1); PG8_BAR; PG8_SCHED;
            } else {
            PG8_LDB(B0, 0, 0); PG8_SCHED; PG8_LDA(At, 0, 0); PG8_STAGE(PG8_SA(1, 1), a1 + hstep, voffA);
            PG8_WAIT_L(8); PG8_BAR; PG8_WAIT_L(0); PG8_MMA(0, 0, At, B0); PG8_BAR; PG8_SCHED;
            PG8_LDB(B1, 0, 1); PG8_STAGE(PG8_SB(0, 0), b2, voffB);
            PG8_BAR; PG8_WAIT_L(0); PG8_MMA(0, 1, At, B1); PG8_BAR;
            PG8_LDA(At, 0, 1); PG8_STAGE(PG8_SA(0, 0), a2, voffA);
            PG8_BAR; PG8_WAIT_L(0); PG8_MMA(1, 0, At, B0); PG8_BAR; PG8_SCHED;
            PG8_STAGE(PG8_SB(0, 1), b2 + hstep, voffB);
            PG8_WAIT_V(6); PG8_BAR; PG8_MMA(1, 1, At, B1); PG8_BAR;
            PG8_LDB(B0, 1, 0); PG8_SCHED; PG8_LDA(At, 1, 0); PG8_STAGE(PG8_SA(0, 1), a2 + hstep, voffA);
            PG8_WAIT_L(8); PG8_BAR; PG8_WAIT_L(0); PG8_MMA(0, 0, At, B0); PG8_BAR; PG8_SCHED;
            PG8_LDB(B1, 1, 1); PG8_STAGE(PG8_SB(1, 0), b3, voffB);
            PG8_BAR; PG8_WAIT_L(0); PG8_MMA(0, 1, At, B1); PG8_BAR;
            PG8_LDA(At, 1, 1); PG8_STAGE(PG8_SA(1, 0), a3, voffA);
            PG8_BAR; PG8_WAIT_L(0); PG8_MMA(1, 0, At, B0); PG8_BAR; PG8_SCHED;
            PG8_STAGE(PG8_SB(1, 1), b3 + hstep, voffB);
            PG8_WAIT_V(6); PG8_BAR; PG8_MMA(1, 1, At, B1); PG8_BAR;
            }
        }
        if constexpr (ALIGN_EPI) { if (wr == 0) PG8_BAR; }
        if constexpr (!Epi::AFTER_DRAIN) { E(acc, cur, wr, wc, fr, fq); S.done(cur); }
        if (!has_next) break;
#pragma unroll
        for (int a = 0; a < 2; ++a)
#pragma unroll
            for (int b = 0; b < 2; ++b)
#pragma unroll
                for (int m = 0; m < 4; ++m)
#pragma unroll
                    for (int n = 0; n < 2; ++n) acc[a][b][m][n] = (f32x4){0.f, 0.f, 0.f, 0.f};
        cur = nxt; cA = nA; cB = nB; ++ui;
#pragma unroll
        for (int h_ = 0; h_ < 2; ++h_)
#pragma unroll
            for (int i_ = 0; i_ < 2; ++i_) vcur[h_][i_] = vnxt[h_][i_];
        if constexpr (ALIGN_EPI) { if (wr == 1) PG8_BAR; }
    }
    PG8_WAIT_V(0);
    if constexpr (!ALIGN_EPI) { if (wr == 0) PG8_BAR; }
    PG8_BAR;
    if constexpr (Epi::AFTER_DRAIN) { E.fused(acc, cur, wr, wc, fr, fq, lds, wid, lane); S.done(cur); }
#undef PG8_SA
#undef PG8_SB
#undef PG8_STAGE
#undef PG8_STAGE_A
#undef PG8_SETV
#undef PG8_LDA
#undef PG8_LDB
#undef PG8_MMA
#undef PG8_WAIT_V
#undef PG8_WAIT_L
#undef PG8_BAR
#undef PG8_SCHED
}
}
#define GAS __attribute__((address_space(1)))
#define LAS __attribute__((address_space(3)))
typedef unsigned short bf16;
typedef unsigned v4u __attribute__((ext_vector_type(4)));
typedef float f32x4 __attribute__((ext_vector_type(4)));
typedef short bf16x8 __attribute__((ext_vector_type(8)));
typedef GAS unsigned gu32;
typedef GAS unsigned long long gu64;
#define RLX_AGENT __ATOMIC_RELAXED, __HIP_MEMORY_SCOPE_AGENT
#define LDS_WAIT() asm volatile("s_waitcnt lgkmcnt(0)" ::: "memory")
#define VM_WAIT() asm volatile("s_waitcnt vmcnt(0)" ::: "memory")
__device__ __forceinline__ unsigned long long rt() { return __builtin_amdgcn_s_memrealtime(); }
__device__ __forceinline__ unsigned f2bf(float f) { unsigned u = __builtin_bit_cast(unsigned, f); return (u + 0x7fffu + ((u >> 16) & 1u)) >> 16; }
__device__ __forceinline__ unsigned pk2(float lo, float hi) { return f2bf(lo) | (f2bf(hi) << 16); }

#define XB_TMO      128
#define XB_XCNT(j)  (256  + 64 * (j))
#define XB_XSUB(j)  (1280 + 64 * (j))
#define XB_XGEN(j)  (2304 + 64 * (j))
#define XB_TOP      3328
#define XB_TOPGEN   3392
#define XCD_BAR_WORDS 3456
#define XB_SPIN_CAP (1u << 18)

__device__ __forceinline__ unsigned xb_ld(unsigned* p)              { return __hip_atomic_load(p, __ATOMIC_RELAXED, __HIP_MEMORY_SCOPE_AGENT); }
__device__ __forceinline__ unsigned xb_add(unsigned* p, unsigned v) { return __hip_atomic_fetch_add(p, v, __ATOMIC_RELAXED, __HIP_MEMORY_SCOPE_AGENT); }
__device__ __forceinline__ unsigned xb_xcc_id() { return (unsigned)__builtin_amdgcn_s_getreg((3 << 11) | 20) & 0xFu; }
#define XB_SPIN(cond, bar) do { unsigned _sp = 0; while (cond) { __builtin_amdgcn_s_sleep(1); \
    if ((++_sp & 255u) == 0u) { if (xb_ld(&(bar)[XB_TMO])) break; if (_sp > XB_SPIN_CAP) { atomicAdd(&(bar)[XB_TMO], 1u); break; } } } } while (0)

struct XcdBarrier {
    unsigned* bar; unsigned x;
    volatile LAS unsigned* st;
};

__device__ __forceinline__ XcdBarrier xcd_barrier_post(unsigned* bar, volatile LAS unsigned* st) {
    XcdBarrier b; b.bar = bar; b.x = xb_xcc_id(); b.st = st;
    if (threadIdx.x == 0) (void)xb_add(&bar[XB_XCNT(b.x)], 1u);
    return b;
}
__device__ __forceinline__ void xcd_barrier_complete(unsigned* bar, unsigned x, unsigned& nloc, unsigned& nx) {
    const unsigned G = gridDim.x * gridDim.y * gridDim.z;
    unsigned sum, cnt, mine, sp = 0u;
    for (;;) {
        sum = 0u; cnt = 0u; mine = 0u;
#pragma unroll
        for (unsigned j = 0; j < 16; ++j) { const unsigned c = xb_ld(&bar[XB_XCNT(j)]); sum += c; cnt += (c > 0u) ? 1u : 0u; mine = (j == x) ? c : mine; }
        if (sum == G) break;
        __builtin_amdgcn_s_sleep(1);
        if ((++sp & 255u) == 0u) { if (xb_ld(&bar[XB_TMO])) break; if (sp > XB_SPIN_CAP) { atomicAdd(&bar[XB_TMO], 1u); break; } }
    }
    nloc = mine > 0u ? mine : 1u; nx = cnt > 0u ? cnt : 1u;
}

__device__ __forceinline__ void xcd_barrier(const XcdBarrier& b) {
    asm volatile("s_waitcnt vmcnt(0)" ::: "memory");
    __syncthreads();
    if (threadIdx.x == 0) {
        unsigned* bar = b.bar;
        __builtin_amdgcn_s_waitcnt(0);
        unsigned nloc = b.st[0], nx = b.st[1];
        if (nloc == 0u) { xcd_barrier_complete(bar, b.x, nloc, nx); b.st[0] = nloc; b.st[1] = nx; }
        const unsigned old = xb_add(&bar[XB_XSUB(b.x)], 1u);
        const unsigned gen = old / nloc;
        if (old + 1u == (gen + 1u) * nloc) {
            __builtin_amdgcn_fence(__ATOMIC_RELEASE, "agent");
            asm volatile("s_waitcnt vmcnt(0)" ::: "memory");
            const unsigned og = xb_add(&bar[XB_TOP], 1u);
            const unsigned tg = og / nx;
            if (og + 1u == (tg + 1u) * nx) xb_add(&bar[XB_TOPGEN], 1u);
            else XB_SPIN(xb_ld(&bar[XB_TOPGEN]) == tg, bar);
            __builtin_amdgcn_fence(__ATOMIC_ACQUIRE, "agent");
            xb_add(&bar[XB_XGEN(b.x)], 1u);
            asm volatile("s_waitcnt vmcnt(0)" ::: "memory");
        } else {
            XB_SPIN(xb_ld(&bar[XB_XGEN(b.x)]) == gen, bar);
            __builtin_amdgcn_fence(__ATOMIC_ACQUIRE, "agent");
            asm volatile("s_waitcnt vmcnt(0)" ::: "memory");
        }
    }
    __syncthreads();
}

constexpr int NWAVES = 8, NTHR = 512;
constexpr int BATCH = 8, SEQ = 2048, DM = 1024, M = BATCH * SEQ, DEPTH = 2;
constexpr int AW = 512, AH = 8, AD = 64;
constexpr int MW = 512, MH = 4, MD = 128;
constexpr int PROJ_COLS = 3600, NPROJ = 3584;
constexpr int DFF = 2816, NUP = 2 * DFF;
constexpr float EPS = 1e-6f;
constexpr size_t MiB = 1u << 20;
constexpr size_t WS_CTL = 0, CTL_ZERO_BYTES = 1 * MiB;
constexpr size_t WS_WIN = 1 * MiB;
constexpr size_t WS_WOUT = 15 * MiB;
constexpr size_t WS_WUP = 19 * MiB;
constexpr size_t WS_WDN = 41 * MiB;
constexpr size_t WS_ROPE = 52 * MiB;
constexpr size_t WS_GATES = 52 * MiB + 512 * 1024;
constexpr size_t WS_ZROW = 53 * MiB + 512 * 1024;
constexpr size_t WS_HN = 54 * MiB;
constexpr size_t WS_SCR = 86 * MiB;
constexpr size_t WS_PROJ = WS_SCR;
constexpr size_t WS_HFB = 198 * MiB;
constexpr size_t WS_H = WS_SCR;
constexpr size_t WS_U = 174 * MiB;
constexpr size_t WS_T = 174 * MiB;
constexpr size_t WS_O1 = 230 * MiB;
constexpr size_t WS_LSE = 246 * MiB;
constexpr size_t WS_END = 256 * MiB;
constexpr int CW_BAR = 4096;
constexpr int RING_BYTES = 131072, LDSCTL_OFF = RING_BYTES, MISC_OFF = LDSCTL_OFF + 320, LDS_BYTES = 147456;

struct Args {
    const float* x; const float* mix_pre_g; const float* w_in; const float* mconv_w; const float* mconv_b; const float* gate_b; const float* head_g;
    const float* w_out; const float* mix_post_g; const float* ffn_pre_g; const float* w_up; const float* fconv_w; const float* fconv_b; const float* w_down; const float* ffn_post_g;
    float* out; unsigned char* ws;
};

__device__ __forceinline__ float shx(float v, int mask, int lane) { return __builtin_bit_cast(float, __builtin_amdgcn_ds_bpermute((lane ^ mask) << 2, __builtin_bit_cast(int, v))); }
__device__ __forceinline__ float shup(float v, int d, int lane) { return __builtin_bit_cast(float, __builtin_amdgcn_ds_bpermute((lane - d) << 2, __builtin_bit_cast(int, v))); }
__device__ __forceinline__ float rdlane(float v, int l) { return __builtin_bit_cast(float, __builtin_amdgcn_readlane(__builtin_bit_cast(int, v), l)); }
__device__ __forceinline__ float wave_sum(float v, int lane) {
#pragma unroll
    for (int o = 1; o < 64; o <<= 1) v += shx(v, o, lane);
    return v;
}
__device__ __forceinline__ int lndv(int v) { asm volatile("" : "+v"(v)); return v; }
template <class T> __device__ __forceinline__ T* lnd(T* p) { asm volatile("" : "+s"(p)); return p; }
__device__ __forceinline__ float bf2f(unsigned short b) { return __builtin_bit_cast(float, (unsigned)b << 16); }
__device__ __forceinline__ float bflo(unsigned w) { return __builtin_bit_cast(float, w << 16); }
__device__ __forceinline__ float bfhi(unsigned w) { return __builtin_bit_cast(float, w & 0xffff0000u); }

template <bool UPMAP = false> __device__ __forceinline__ void transpose_item(const float* W, int K, int ldw, int ncols, bf16* WT, LAS float* scr, int item, int lane) {
    const int nblk = ncols / 32, kb = item / nblk, nb = item % nblk, k0 = 64 * kb, n0 = 32 * nb;
    const int d0 = UPMAP ? (n0 < DFF ? 256 * (n0 >> 7) + (n0 & 127) : 256 * ((n0 - DFF) >> 7) + 128 + ((n0 - DFF) & 127)) : n0;
#pragma unroll 8
    for (int i = 0; i < 32; ++i) { const int kk = 2 * i + (lane >> 5); scr[kk * 33 + (lane & 31)] = W[(size_t)(k0 + kk) * ldw + n0 + (lane & 31)]; }
    LDS_WAIT(); asm volatile("" ::: "memory");
    const int c = lane & 7;
#pragma unroll
    for (int j = 0; j < 4; ++j) { const int n = (lane >> 3) + 8 * j; const LAS float* s = scr + (8 * c) * 33 + n;
        v4u o; o.x = pk2(s[0 * 33], s[1 * 33]); o.y = pk2(s[2 * 33], s[3 * 33]); o.z = pk2(s[4 * 33], s[5 * 33]); o.w = pk2(s[6 * 33], s[7 * 33]);
        *(GAS v4u*)(WT + (size_t)(d0 + n) * K + k0 + 8 * c) = o; }
    LDS_WAIT(); asm volatile("" ::: "memory");
}

__device__ __forceinline__ void rms_row(f32x4 (&v)[4], const f32x4 (&g)[4], int lane) {
    float s = 0.f;
#pragma unroll
    for (int j = 0; j < 4; ++j) s += (v[j].x * v[j].x + v[j].y * v[j].y) + (v[j].z * v[j].z + v[j].w * v[j].w);
    const float rs = 1.0f / sqrtf(wave_sum(s, lane) * (1.f / DM) + EPS);
#pragma unroll
    for (int j = 0; j < 4; ++j) v[j] = v[j] * rs * g[j];
}
__device__ __forceinline__ void store_row_bf16(bf16* orow, const f32x4 (&v)[4], int lane) {
    GAS unsigned long long* o8 = (GAS unsigned long long*)orow + lane;
#pragma unroll
    for (int j = 0; j < 4; ++j) o8[64 * j] = (unsigned long long)pk2(v[j].x, v[j].y) | ((unsigned long long)pk2(v[j].z, v[j].w) << 32);
}
__device__ __forceinline__ void gates_row(const f32x4 (&y)[4], const LAS float* wg, const float* gb, float* grow, int lane) {
    float p[16];
#pragma unroll
    for (int q = 0; q < 16; ++q) p[q] = 0.f;
#pragma unroll
    for (int j = 0; j < 4; ++j)
#pragma unroll
        for (int c = 0; c < 4; ++c) {
            const int k = 256 * j + 4 * lane + c; const float yk = y[j][c];
            const LAS f32x4* w4 = (const LAS f32x4*)(wg + k * 16);
#pragma unroll
            for (int q = 0; q < 4; ++q) { const f32x4 w = w4[q]; p[4 * q + 0] += yk * w.x; p[4 * q + 1] += yk * w.y; p[4 * q + 2] += yk * w.z; p[4 * q + 3] += yk * w.w; }
        }
    float r = 0.f;
#pragma unroll
    for (int q = 0; q < 16; ++q) { const float t = wave_sum(p[q], lane); r = (lane == q) ? t : r; }
    if (lane < 16) grow[lane] = r + gb[lane];
}

__device__ __forceinline__ float gelu_tanh(float x) {
    const float u = 0.7978845608028654f * (x + 0.044715f * x * x * x);
    const float e = __expf(2.f * u);
    const float th = 1.f - 2.f / (1.f + e);
    return 0.5f * x * (1.f + th);
}
__device__ __forceinline__ float sigmoidf_(float x) { return 1.f / (1.f + __expf(-x)); }
__device__ __forceinline__ float log_sigmoid(float x) { return fminf(x, 0.f) - log1pf(__expf(-fabsf(x))); }


typedef short s16x4 __attribute__((ext_vector_type(4)));
typedef float f32x16 __attribute__((ext_vector_type(16)));
typedef float f32x2_t __attribute__((ext_vector_type(2))); typedef __bf16 bf16x2_t __attribute__((ext_vector_type(2)));
__device__ __forceinline__ unsigned cvtpk(float lo, float hi) { f32x2_t v = {lo, hi}; bf16x2_t b = __builtin_convertvector(v, bf16x2_t); return __builtin_bit_cast(unsigned, b); }
__device__ __forceinline__ s16x4 vtr(const LAS unsigned char* p) { return __builtin_bit_cast(s16x4, __builtin_amdgcn_ds_read_tr16_b64_v4i16((LAS s16x4*)p)); }
#define MFMA32(a, b, c) __builtin_amdgcn_mfma_f32_32x32x16_bf16((a), (b), (c), 0, 0, 0)
__device__ __forceinline__ bf16x8 pack8(const f32x16& x, int s8) {
    v4u p; p.x = cvtpk(x[s8 + 0], x[s8 + 1]); p.y = cvtpk(x[s8 + 2], x[s8 + 3]); p.z = cvtpk(x[s8 + 4], x[s8 + 5]); p.w = cvtpk(x[s8 + 6], x[s8 + 7]);
    return __builtin_bit_cast(bf16x8, p);
}
__device__ __forceinline__ void attn_task(const bf16* base, bf16* obase, int ostride, float* lsep, int br, int ti, LAS unsigned char* wl, int lane) {
    const int r_l = lane & 31, hh = lane >> 5;
    int r, rho, a, nsub;
    if (br == 0) { r = 1; rho = 0; a = ti; nsub = 2048; } else if (br == 1) { r = 4; rho = ti >> 4; a = ti & 15; nsub = 512; } else { r = 16; rho = ti >> 2; a = ti & 3; nsub = 128; }
    const int q0 = 32 * a;
    bf16x8 qf[4];
    { const bf16* qrow = base + (size_t)(rho + r * (q0 + r_l)) * NPROJ + 8 * hh;
#pragma unroll
      for (int s = 0; s < 4; ++s) qf[s] = *(const GAS bf16x8*)(qrow + 16 * s); }
    f32x16 S[5];
    float mx = -1e30f;
#pragma unroll
    for (int kt = 0; kt < 5; ++kt) {
        const int ks0 = q0 - 64 + 32 * kt;
        if (ks0 + 32 <= 0 || ks0 >= nsub) {
#pragma unroll
            for (int reg = 0; reg < 16; ++reg) S[kt][reg] = -1e30f;
        } else {
            const int kr = min(max(ks0 + r_l, 0), nsub - 1);
            const bf16* krow = base + (size_t)(rho + r * kr) * NPROJ + 512 + 8 * hh;
            bf16x8 kf[4];
#pragma unroll
            for (int s = 0; s < 4; ++s) kf[s] = *(const GAS bf16x8*)(krow + 16 * s);
            f32x16 acc;
#pragma unroll
            for (int reg = 0; reg < 16; ++reg) acc[reg] = 0.f;
#pragma unroll
            for (int s = 0; s < 4; ++s) acc = MFMA32(kf[s], qf[s], acc);
            const int kb = ks0 + 4 * hh, dq = kb - (q0 + r_l);
#pragma unroll
            for (int reg = 0; reg < 16; ++reg) {
                const int cr = (reg & 3) + 8 * (reg >> 2); const int d = dq + cr, ks = kb + cr;
                const bool ok = (d >= -64) && (d <= 64) && (ks >= 0) && (ks < nsub);
                const float v = ok ? acc[reg] : -1e30f; acc[reg] = v; mx = fmaxf(mx, v);
            }
            S[kt] = acc;
        }
    }
    mx = fmaxf(mx, shx(mx, 32, lane));
    float l = 0.f;
#pragma unroll
    for (int kt = 0; kt < 5; ++kt)
#pragma unroll
        for (int reg = 0; reg < 16; ++reg) { const float p = __expf(S[kt][reg] - mx); S[kt][reg] = p; l += p; }
    l += shx(l, 32, lane);
    f32x16 O0, O1;
#pragma unroll
    for (int reg = 0; reg < 16; ++reg) { O0[reg] = 0.f; O1[reg] = 0.f; }
    const int rowi = lane >> 3, chv = lane & 7, blk = (lane >> 4) & 1, qq = (lane & 15) >> 2, pp = lane & 3;
#pragma unroll
    for (int kt = 0; kt < 5; ++kt) {
        const int ks0 = q0 - 64 + 32 * kt;
        if (ks0 + 32 <= 0 || ks0 >= nsub) continue;
        v4u vv[4];
#pragma unroll
        for (int i = 0; i < 4; ++i) { const int kr = min(max(ks0 + 8 * i + rowi, 0), nsub - 1); vv[i] = *(const GAS v4u*)(base + (size_t)(rho + r * kr) * NPROJ + 1024 + 8 * chv); }
#pragma unroll
        for (int i = 0; i < 4; ++i) { const int row = 8 * i + rowi; *(LAS v4u*)(wl + 128 * row + 16 * (chv ^ (((row >> 1) & 1) << 2))) = vv[i]; }
#pragma unroll
        for (int s = 0; s < 2; ++s) {
            const bf16x8 A = pack8(S[kt], 8 * s);
            const int row0 = 16 * s + 4 * hh + qq, sw = ((row0 >> 1) & 1) << 2;
#pragma unroll
            for (int c = 0; c < 2; ++c) {
                const int ch = (4 * c + 2 * blk + (pp >> 1)) ^ sw;
                const LAS unsigned char* p0 = wl + 128 * row0 + 16 * ch + 8 * (pp & 1);
                const s16x4 lo = vtr(p0), hi = vtr(p0 + 8 * 128);
                const bf16x8 B = __builtin_shufflevector(lo, hi, 0, 1, 2, 3, 4, 5, 6, 7);
                if (c == 0) O0 = MFMA32(A, B, O0); else O1 = MFMA32(A, B, O1);
            }
        }
    }
    LAS float* lb = (LAS float*)(wl + 4096);
    if (lane < 32) lb[lane] = 1.f / l;
    f32x4 li4[4];
#pragma unroll
    for (int g = 0; g < 4; ++g) li4[g] = *(const LAS f32x4*)(lb + 4 * hh + 8 * g);
#pragma unroll
    for (int reg = 0; reg < 16; ++reg) {
        const float sc = li4[reg >> 2][reg & 3]; const int qs = q0 + (reg & 3) + 8 * (reg >> 2) + 4 * hh;
        bf16* orow = obase + (size_t)(rho + r * qs) * ostride;
        orow[r_l] = (bf16)f2bf(O0[reg] * sc); orow[32 + r_l] = (bf16)f2bf(O1[reg] * sc);
    }
    if (lane < 32) lsep[(size_t)(rho + r * (q0 + lane)) * 8] = mx + __logf(l);
}


constexpr int ML_Q = 0, ML_K = 32768, ML_V = 65536, ML_C = 98304, ML_VEC = 131584;
enum { MV_RT = 0, MV_A, MV_G, MV_EMT, MV_WEXP, MV_QN, MV_N, MV_HSC, MV_GSC, MV_SCAL, MV_COUNT };
static_assert(ML_VEC + 512 * MV_COUNT <= LDS_BYTES, "mLSTM LDS map");
__device__ __forceinline__ int xsw(int row) { return ((row & 3) << 2) | ((row >> 2) & 3); }
__device__ __forceinline__ bf16x8 ml_rowfrag(const LAS unsigned char* img, int rowbase, int ks, int r_l, int hh, int xr) {
    return *(const LAS bf16x8*)(img + 256 * (rowbase + r_l) + 16 * ((2 * ks + hh) ^ xr));
}
template <bool PERM> __device__ __forceinline__ bf16x8 ml_trfrag(const LAS unsigned char* img, int rowbase, int c, int hh, int blk, int qq, int pp) {
    const int chb = 4 * c + 2 * blk + (pp >> 1);
    const int r0 = rowbase + (PERM ? 4 * hh : 8 * hh) + qq, r1 = r0 + (PERM ? 8 : 4);
    const int x0 = (qq << 2) | ((PERM ? hh : 2 * hh) & 3), x1 = (qq << 2) | ((PERM ? 2 + hh : 2 * hh + 1) & 3);
    const s16x4 lo = vtr(img + 256 * r0 + 16 * (chb ^ x0) + 8 * (pp & 1)), hi = vtr(img + 256 * r1 + 16 * (chb ^ x1) + 8 * (pp & 1));
    return __builtin_shufflevector(lo, hi, 0, 1, 2, 3, 4, 5, 6, 7);
}

__device__ __forceinline__ void mlstm_scan(LAS unsigned char* lds, const bf16* QK  , const bf16* PROJ, const float* GATES, bf16* Hout  ,
                                           int b, int h, int dir, int tid) {
    const int lane = tid & 63, wave = __builtin_amdgcn_readfirstlane(tid >> 6), tt = wave >> 1, fh = wave & 1;
    const int r_l = lane & 31, hh = lane >> 5, blk = (lane >> 4) & 1, qq = (lane & 15) >> 2, pp = lane & 3, xr = xsw(r_l);
    const float scale = 0.08838834764831845f;
    LAS float* vec = (LAS float*)(lds + ML_VEC);
    for (int i = tid; i < 32768 / 16; i += NTHR) *(LAS v4u*)(lds + ML_C + 16 * i) = (v4u){0u, 0u, 0u, 0u};
    if (tid < 128) vec[MV_N * 128 + tid] = 0.f;
    f32x16 C0, C1;
#pragma unroll
    for (int i = 0; i < 16; ++i) { C0[i] = 0.f; C1[i] = 0.f; }
    float mst = 0.f;
    const int lrow = tid >> 4, lch = tid & 15;
#pragma unroll 1
    for (int cs = 0; cs < SEQ / 128; ++cs) {
        {
            v4u tq[4], tk[4], tv[4];
#pragma unroll
            for (int k4 = 0; k4 < 4; ++k4) {
                const int t = lrow + 32 * k4, sg = 128 * cs + t, pos = dir ? (SEQ - 1 - sg) : sg; const size_t m = (size_t)b * SEQ + pos;
                tq[k4] = *(const GAS v4u*)(QK + m * 1024 + h * 128 + 8 * lch);
                tk[k4] = *(const GAS v4u*)(QK + m * 1024 + 512 + h * 128 + 8 * lch);
                tv[k4] = *(const GAS v4u*)(PROJ + m * NPROJ + 2560 + h * 128 + 8 * lch);
            }
#pragma unroll
            for (int k4 = 0; k4 < 4; ++k4) {
                const int t = lrow + 32 * k4, o = 256 * t + 16 * (lch ^ xsw(t));
                *(LAS v4u*)(lds + ML_Q + o) = tq[k4]; *(LAS v4u*)(lds + ML_K + o) = tk[k4]; *(LAS v4u*)(lds + ML_V + o) = tv[k4];
            }
        }
        __syncthreads();
        if (wave == 0) {
            const int t0 = 2 * lane;
            float li0, li1, lf0, lf1;
            { const int sg = 128 * cs + t0, p0 = dir ? (SEQ - 1 - sg) : sg, p1 = dir ? (p0 - 1) : (p0 + 1);
              const float* g0 = GATES + ((size_t)b * SEQ + p0) * 16 + (2 * dir) * 4 + h; const float* g1 = GATES + ((size_t)b * SEQ + p1) * 16 + (2 * dir) * 4 + h;
              li0 = g0[0]; lf0 = log_sigmoid(g0[4]); li1 = g1[0]; lf1 = log_sigmoid(g1[4]); }
            const float ps = lf0 + lf1; float inc = ps;
#pragma unroll
            for (int d = 1; d < 64; d <<= 1) { const float o = shup(inc, d, lane); if (lane >= d) inc += o; }
            const float bc1 = inc, bc0 = inc - lf1;
            const float a0 = li0 - bc0, a1 = li1 - bc1;
            const float pm = fmaxf(a0, a1); float im = pm;
#pragma unroll
            for (int d = 1; d < 64; d <<= 1) { const float o = shup(im, d, lane); if (lane >= d) im = fmaxf(im, o); }
            float em = shup(im, 1, lane); if (lane == 0) em = -3.0e38f;
            const float cm0 = fmaxf(em, a0), cm1 = im;
            const float mt0 = fmaxf(bc0 + mst, bc0 + cm0), mt1 = fmaxf(bc1 + mst, bc1 + cm1);
            const float blast = rdlane(inc, 63), cref = rdlane(im, 63);
            const float mnew = fmaxf(blast + mst, blast + cref);
            vec[MV_RT * 128 + t0] = bc0 - mt0; vec[MV_RT * 128 + t0 + 1] = bc1 - mt1;
            vec[MV_A * 128 + t0] = a0; vec[MV_A * 128 + t0 + 1] = a1;
            vec[MV_G * 128 + t0] = __expf(bc0 + mst - mt0); vec[MV_G * 128 + t0 + 1] = __expf(bc1 + mst - mt1);
            vec[MV_EMT * 128 + t0] = __expf(-mt0); vec[MV_EMT * 128 + t0 + 1] = __expf(-mt1);
            vec[MV_WEXP * 128 + t0] = __expf(blast + a0 - mnew); vec[MV_WEXP * 128 + t0 + 1] = __expf(blast + a1 - mnew);
            if (lane == 0) vec[MV_SCAL * 128] = __expf(blast + mst - mnew);
            mst = mnew;
        } else if (wave == 2 || wave == 3) {
            const int t = tid - 128, xt = xsw(t);
            float s = 0.f;
#pragma unroll 4
            for (int ch = 0; ch < 16; ++ch) {
                const v4u qv = *(const LAS v4u*)(lds + ML_Q + 256 * t + 16 * (ch ^ xt));
                const f32x4 n0 = *(const LAS f32x4*)(vec + MV_N * 128 + 8 * ch), n1 = *(const LAS f32x4*)(vec + MV_N * 128 + 8 * ch + 4);
                s += bflo(qv.x) * n0.x + bfhi(qv.x) * n0.y + bflo(qv.y) * n0.z + bfhi(qv.y) * n0.w + bflo(qv.z) * n1.x + bfhi(qv.z) * n1.y + bflo(qv.w) * n1.z + bfhi(qv.w) * n1.w;
            }
            vec[MV_QN * 128 + t] = s;
        }
        __syncthreads();
        {
            bf16x8 qf[8];
            { const int ln_ = lndv(lane); const int r_l = ln_ & 31, hh = ln_ >> 5, blk = (ln_ >> 4) & 1, qq = (ln_ & 15) >> 2, pp = ln_ & 3, xr = xsw(r_l); (void)blk; (void)qq; (void)pp; (void)xr; (void)hh;
#pragma unroll
            for (int ks = 0; ks < 8; ++ks) qf[ks] = ml_rowfrag(lds + ML_Q, 32 * tt, ks, r_l, hh, xr); }
            f32x16 N0, N1;
#pragma unroll
            for (int i = 0; i < 16; ++i) { N0[i] = 0.f; N1[i] = 0.f; }
            float den = 0.f;
            const float rt = vec[MV_RT * 128 + 32 * tt + r_l];
#pragma unroll
            for (int st = 0; st < 4; ++st) {
                if (st <= tt) {
                    const int ln_ = lndv(lane); const int r_l = ln_ & 31, hh = ln_ >> 5, blk = (ln_ >> 4) & 1, qq = (ln_ & 15) >> 2, pp = ln_ & 3, xr = xsw(r_l); (void)blk; (void)qq; (void)pp; (void)xr; (void)hh;
                    f32x16 acc;
#pragma unroll
                    for (int i = 0; i < 16; ++i) acc[i] = 0.f;
#pragma unroll
                    for (int ks = 0; ks < 8; ++ks) acc = MFMA32(ml_rowfrag(lds + ML_K, 32 * st, ks, r_l, hh, xr), qf[ks], acc);
                    f32x4 av[4];
#pragma unroll
                    for (int g = 0; g < 4; ++g) av[g] = *(const LAS f32x4*)(vec + MV_A * 128 + 32 * st + 4 * hh + 8 * g);
#pragma unroll
                    for (int reg = 0; reg < 16; ++reg) {
                        const int cr = (reg & 3) + 8 * (reg >> 2) + 4 * hh;
                        const bool ok = (st < tt) || (cr <= r_l);
                        const float p = ok ? acc[reg] * scale * __expf(rt + av[reg >> 2][reg & 3]) : 0.f;
                        acc[reg] = p; den += p;
                    }
#pragma unroll
                    for (int s2 = 0; s2 < 2; ++s2) {
                        const bf16x8 A = pack8(acc, 8 * s2);
                        N0 = MFMA32(A, ml_trfrag<true>(lds + ML_V, 32 * st + 16 * s2, 2 * fh + 0, hh, blk, qq, pp), N0);
                        N1 = MFMA32(A, ml_trfrag<true>(lds + ML_V, 32 * st + 16 * s2, 2 * fh + 1, hh, blk, qq, pp), N1);
                    }
                }
            }
            den += shx(den, 32, lane);
            f32x16 Q0, Q1;
#pragma unroll
            for (int i = 0; i < 16; ++i) { Q0[i] = 0.f; Q1[i] = 0.f; }
            { LAS unsigned char* lq = lds + ML_Q; asm volatile("" : "+v"(lq)); const int ln_ = lndv(lane); const int r_l = ln_ & 31, hh = ln_ >> 5, blk = (ln_ >> 4) & 1, qq = (ln_ & 15) >> 2, pp = ln_ & 3, xr = xsw(r_l); (void)blk; (void)qq; (void)pp; (void)xr; (void)hh;
#pragma unroll
            for (int ks = 0; ks < 8; ++ks) {
                const bf16x8 qa = ml_rowfrag(lq, 32 * tt, ks, r_l, hh, xr);
                Q0 = MFMA32(qa, ml_rowfrag(lds + ML_C, 32 * (2 * fh + 0), ks, r_l, hh, xr), Q0);
                Q1 = MFMA32(qa, ml_rowfrag(lds + ML_C, 32 * (2 * fh + 1), ks, r_l, hh, xr), Q1);
            } }
            {
                const int t = 32 * tt + r_l;
                const float gs = vec[MV_G * 128 + t] * scale;
                const float dn = den + gs * vec[MV_QN * 128 + t];
                const float inv = 1.f / fmaxf(fabsf(dn), vec[MV_EMT * 128 + t]);
                vec[MV_HSC * 128 + t] = inv; vec[MV_GSC * 128 + t] = gs * inv;
            }
            f32x4 hs4[4], gs4[4];
#pragma unroll
            for (int g = 0; g < 4; ++g) { hs4[g] = *(const LAS f32x4*)(vec + MV_HSC * 128 + 32 * tt + 4 * hh + 8 * g); gs4[g] = *(const LAS f32x4*)(vec + MV_GSC * 128 + 32 * tt + 4 * hh + 8 * g); }
#pragma unroll
            for (int reg = 0; reg < 16; ++reg) {
                const int t = 32 * tt + (reg & 3) + 8 * (reg >> 2) + 4 * hh, sg = 128 * cs + t, pos = dir ? (SEQ - 1 - sg) : sg;
                bf16* orow = Hout + ((size_t)b * SEQ + pos) * MW + h * 128 + 64 * fh + r_l;
                const float hsv = hs4[reg >> 2][reg & 3], gsv = gs4[reg >> 2][reg & 3];
                orow[0] = (bf16)f2bf(N0[reg] * hsv + Q0[reg] * gsv); orow[32] = (bf16)f2bf(N1[reg] * hsv + Q1[reg] * gsv);
            }
        }
        float newn;
        {
            const float decay = vec[MV_SCAL * 128];
#pragma unroll
            for (int i = 0; i < 16; ++i) { C0[i] *= decay; C1[i] *= decay; }
            float nsum = 0.f;
#pragma unroll
            for (int ks = 0; ks < 8; ++ks) {
                const int ln_ = lndv(lane); const int r_l = ln_ & 31, hh = ln_ >> 5, blk = (ln_ >> 4) & 1, qq = (ln_ & 15) >> 2, pp = ln_ & 3, xr = xsw(r_l); (void)blk; (void)qq; (void)pp; (void)xr; (void)hh;
                const bf16x8 kr = ml_trfrag<false>(lds + ML_K, 16 * ks, tt, hh, blk, qq, pp);
                const f32x4 w0 = *(const LAS f32x4*)(vec + MV_WEXP * 128 + 16 * ks + 8 * hh), w1 = *(const LAS f32x4*)(vec + MV_WEXP * 128 + 16 * ks + 8 * hh + 4);
                const v4u ku = __builtin_bit_cast(v4u, kr);
                const float e0 = bflo(ku.x) * w0.x, e1 = bfhi(ku.x) * w0.y, e2 = bflo(ku.y) * w0.z, e3 = bfhi(ku.y) * w0.w, e4 = bflo(ku.z) * w1.x, e5 = bfhi(ku.z) * w1.y, e6 = bflo(ku.w) * w1.z, e7 = bfhi(ku.w) * w1.w;
                nsum += ((e0 + e1) + (e2 + e3)) + ((e4 + e5) + (e6 + e7));
                v4u au; au.x = cvtpk(e0, e1); au.y = cvtpk(e2, e3); au.z = cvtpk(e4, e5); au.w = cvtpk(e6, e7);
                const bf16x8 A = __builtin_bit_cast(bf16x8, au);
                C0 = MFMA32(A, ml_trfrag<false>(lds + ML_V, 16 * ks, 2 * fh + 0, hh, blk, qq, pp), C0);
                C1 = MFMA32(A, ml_trfrag<false>(lds + ML_V, 16 * ks, 2 * fh + 1, hh, blk, qq, pp), C1);
            }
            nsum += shx(nsum, 32, lane);
            newn = decay * vec[MV_N * 128 + 32 * tt + r_l] + nsum;
        }
        __syncthreads();
        {
            const int ln_ = lndv(lane); const int r_l = ln_ & 31, hh = ln_ >> 5, blk = (ln_ >> 4) & 1, qq = (ln_ & 15) >> 2, pp = ln_ & 3, xr = xsw(r_l); (void)blk; (void)qq; (void)pp; (void)xr; (void)hh;
            if (fh == 0 && lane < 32) vec[MV_N * 128 + 32 * tt + lane] = newn;
#pragma unroll
            for (int cl = 0; cl < 2; ++cl) {
                const int f = 32 * (2 * fh + cl) + r_l, xf = xsw(f);
#pragma unroll
                for (int g = 0; g < 4; ++g) {
                    const int e = 32 * tt + 8 * g + 4 * hh;
                    unsigned long long w;
                    if (cl == 0) w = (unsigned long long)cvtpk(C0[4 * g], C0[4 * g + 1]) | ((unsigned long long)cvtpk(C0[4 * g + 2], C0[4 * g + 3]) << 32);
                    else w = (unsigned long long)cvtpk(C1[4 * g], C1[4 * g + 1]) | ((unsigned long long)cvtpk(C1[4 * g + 2], C1[4 * g + 3]) << 32);
                    *(LAS unsigned long long*)(lds + ML_C + 256 * f + 16 * ((e >> 3) ^ xf) + 2 * (e & 7)) = w;
                }
            }
        }
    }
    __syncthreads();
}

#define PHASE_PTRS() const int tid = lndv((int)threadIdx.x), lane = tid & 63, wave = __builtin_amdgcn_readfirstlane(tid >> 6); const int gw = bid * NWAVES + wave, gt = bid * NTHR + tid; (void)lane; (void)gw; (void)gt; \
    Args a = a0; a.x = lnd(a.x); a.mix_pre_g = lnd(a.mix_pre_g); a.w_in = lnd(a.w_in); a.mconv_w = lnd(a.mconv_w); a.mconv_b = lnd(a.mconv_b); a.gate_b = lnd(a.gate_b); \
    a.head_g = lnd(a.head_g); a.w_out = lnd(a.w_out); a.mix_post_g = lnd(a.mix_post_g); a.ffn_pre_g = lnd(a.ffn_pre_g); a.w_up = lnd(a.w_up); a.fconv_w = lnd(a.fconv_w); a.fconv_b = lnd(a.fconv_b); \
    a.w_down = lnd(a.w_down); a.ffn_post_g = lnd(a.ffn_post_g); unsigned char* wsl = lnd(a.ws); \
    bf16* Win_t = (bf16*)(wsl + WS_WIN); bf16* Wout_t = (bf16*)(wsl + WS_WOUT); bf16* Wup_t = (bf16*)(wsl + WS_WUP); bf16* Wdn_t = (bf16*)(wsl + WS_WDN); \
    float* rope_c = (float*)(wsl + WS_ROPE); float* rope_s = rope_c + SEQ * 32; float* GATES = (float*)(wsl + WS_GATES); \
    bf16* HN = (bf16*)(wsl + WS_HN); bf16* PROJ = (bf16*)(wsl + WS_PROJ); bf16* HFB = (bf16*)(wsl + WS_HFB); bf16* HB16 = (bf16*)(wsl + WS_H); bf16* UB = (bf16*)(wsl + WS_U); \
    float* T = (float*)(wsl + WS_T); float* R = lnd(a.out); bf16* O1 = (bf16*)(wsl + WS_O1); float* LSE = (float*)(wsl + WS_LSE); (void)O1; (void)LSE; \
    (void)Win_t; (void)Wout_t; (void)Wup_t; (void)Wdn_t; (void)rope_c; (void)rope_s; (void)GATES; (void)HN; (void)PROJ; (void)HFB; (void)HB16; (void)UB; (void)T; (void)R;
__global__ void __launch_bounds__(NTHR, 2) hybrid_fwd(Args a0) {
    extern __shared__ __attribute__((aligned(16))) unsigned char lds_raw[];
    LAS unsigned char* lds = (LAS unsigned char*)lds_raw;
    volatile LAS unsigned* MISC = (volatile LAS unsigned*)(lds + MISC_OFF);
    const int tid = threadIdx.x, lane = tid & 63, wave = __builtin_amdgcn_readfirstlane(tid >> 6);
    const int G = gridDim.x, bid = blockIdx.x;
    unsigned char* ws = a0.ws;
    gu32* ctl = (gu32*)(ws + WS_CTL);
    for (int u = tid; u < (LDS_BYTES - LDSCTL_OFF) / 4; u += NTHR) ((LAS unsigned*)(lds + LDSCTL_OFF))[u] = 0u;
    __syncthreads();
    XcdBarrier bar = xcd_barrier_post((unsigned*)(ctl + CW_BAR), MISC + 8);
#define GRID_BAR() xcd_barrier(bar)
    const int gw = bid * NWAVES + wave, NGW = G * NWAVES;
    const int gt = bid * NTHR + tid, NGT = G * NTHR;


    {
            PHASE_PTRS();
        LAS float* scr = (LAS float*)(lds + wave * 16384);
        constexpr int I_IN = (DM / 64) * (NPROJ / 32), I_OUT = (DM / 64) * (DM / 32), I_UP = (DM / 64) * (NUP / 32), I_DN = (DFF / 64) * (DM / 32);
        constexpr int PER_L = I_IN + I_OUT + I_UP + I_DN;
        for (int it = gw; it < DEPTH * PER_L; it += NGW) {
            const int l = it / PER_L; int r = it % PER_L;
            if (r < I_IN) { transpose_item(a.w_in + (size_t)l * DM * PROJ_COLS, DM, PROJ_COLS, NPROJ, Win_t + (size_t)l * NPROJ * DM, scr, r, lane); continue; } r -= I_IN;
            if (r < I_OUT) { transpose_item(a.w_out + (size_t)l * DM * DM, DM, DM, DM, Wout_t + (size_t)l * DM * DM, scr, r, lane); continue; } r -= I_OUT;
            if (r < I_UP) { transpose_item<true>(a.w_up + (size_t)l * DM * NUP, DM, NUP, NUP, Wup_t + (size_t)l * NUP * DM, scr, r, lane); continue; } r -= I_UP;
            transpose_item(a.w_down + (size_t)l * DFF * DM, DFF, DM, DM, Wdn_t + (size_t)l * DM * DFF, scr, r, lane);
        }
        for (int i = gt; i < SEQ * 32; i += NGT) {
            const int pos = i >> 5, fi = i & 31;
            const float inv = powf(10000.0f, -(float)(2 * fi) / 64.0f);
            const float ang = (float)pos * inv;
            const double ad = (double)ang; const double kk = rint(ad * 0.15915494309189535); const float rr = (float)(ad - kk * 6.283185307179586);
            rope_c[i] = cosf(rr); rope_s[i] = sinf(rr);
        }
        if (gt < 512) ((GAS unsigned*)(wsl + WS_ZROW))[gt] = 0u;
    }
    __syncthreads();
    for (int l = 0; l < DEPTH; ++l) {
        if (l == 0) {
            PHASE_PTRS();
            const float* w_in_l = a.w_in + (size_t)l * DM * PROJ_COLS;
            LAS float* wg = (LAS float*)lds;
            for (int i = tid; i < DM * 16; i += NTHR) wg[i] = w_in_l[(size_t)(i >> 4) * PROJ_COLS + NPROJ + (i & 15)];
            __syncthreads();
            f32x4 g[4];
#pragma unroll
            for (int j = 0; j < 4; ++j) g[j] = ((const GAS f32x4*)(a.mix_pre_g + (size_t)l * DM))[lane + 64 * j];
            for (int m = gw; m < M; m += NGW) {
                f32x4 v[4];
#pragma unroll
                for (int j = 0; j < 4; ++j) v[j] = ((const GAS f32x4*)(a.x + (size_t)m * DM))[lane + 64 * j];
                rms_row(v, g, lane);
                store_row_bf16(HN + (size_t)m * DM, v, lane);
                gates_row(v, wg, a.gate_b + l * 16, GATES + (size_t)m * 16, lane);
            }
            __syncthreads();
        }
        if (l == 0) { cg::this_grid().sync(); } else { GRID_BAR(); }

        {
            PHASE_PTRS();
            pg8::Gemm g{HN, Win_t + (size_t)l * NPROJ * DM, M, NPROJ, DM}; pg8::StaticOrder S; S.init(M, NPROJ, G, bid);
            pg8::EpiBf16<0> E{PROJ, NPROJ, nullptr, 0, 0, 1.f};
            pg8::gemm_phase<pg8::EpiBf16<0>, pg8::StaticOrder, true, true>(lds, g, S, E);
        }
        GRID_BAR();
        {
            PHASE_PTRS();
            for (int i = gt; i < M * 64; i += NGT) {
                const int m = i >> 6, hs = (i >> 2) & 15, i8 = i & 3, pos = m & (SEQ - 1);
                bf16* p1 = PROJ + (size_t)m * NPROJ + hs * 64 + 8 * i8;
                const v4u a1 = *(const GAS v4u*)p1, a2 = *(const GAS v4u*)(p1 + 32);
                const f32x4 c0 = *(const GAS f32x4*)(rope_c + pos * 32 + 8 * i8), c1 = *(const GAS f32x4*)(rope_c + pos * 32 + 8 * i8 + 4);
                const f32x4 s0 = *(const GAS f32x4*)(rope_s + pos * 32 + 8 * i8), s1 = *(const GAS f32x4*)(rope_s + pos * 32 + 8 * i8 + 4);
                const float sc = hs < 8 ? 0.125f : 1.f;
                float t1[8] = {bflo(a1.x), bfhi(a1.x), bflo(a1.y), bfhi(a1.y), bflo(a1.z), bfhi(a1.z), bflo(a1.w), bfhi(a1.w)};
                float t2[8] = {bflo(a2.x), bfhi(a2.x), bflo(a2.y), bfhi(a2.y), bflo(a2.z), bfhi(a2.z), bflo(a2.w), bfhi(a2.w)};
                float cc[8] = {c0.x, c0.y, c0.z, c0.w, c1.x, c1.y, c1.z, c1.w}, ss[8] = {s0.x, s0.y, s0.z, s0.w, s1.x, s1.y, s1.z, s1.w};
                float o1[8], o2[8];
#pragma unroll
                for (int q = 0; q < 8; ++q) { o1[q] = (t1[q] * cc[q] - t2[q] * ss[q]) * sc; o2[q] = (t2[q] * cc[q] + t1[q] * ss[q]) * sc; }
                v4u w1, w2; w1.x = pk2(o1[0], o1[1]); w1.y = pk2(o1[2], o1[3]); w1.z = pk2(o1[4], o1[5]); w1.w = pk2(o1[6], o1[7]);
                w2.x = pk2(o2[0], o2[1]); w2.y = pk2(o2[2], o2[3]); w2.z = pk2(o2[4], o2[5]); w2.w = pk2(o2[6], o2[7]);
                *(GAS v4u*)p1 = w1; *(GAS v4u*)(p1 + 32) = w2;
            }
            const float* cw = a.mconv_w + (size_t)l * 5 * 1024; const float* cb = a.mconv_b + (size_t)l * 1024;
            for (int i = gt; i < M * 128; i += NGT) {
                const int m = i >> 7, c8 = (i & 127) * 8, pos = m & (SEQ - 1);
                float acc[8];
#pragma unroll
                for (int q = 0; q < 8; ++q) acc[q] = cb[c8 + q];
#pragma unroll
                for (int j = 0; j < 5; ++j) {
                    const int pp = pos + j - 2;
                    if (pp >= 0 && pp < SEQ) {
                        const v4u xv = *(const GAS v4u*)(PROJ + (size_t)(m + j - 2) * NPROJ + 1536 + c8);
                        const f32x4 w0 = *(const GAS f32x4*)(cw + j * 1024 + c8), w1 = *(const GAS f32x4*)(cw + j * 1024 + c8 + 4);
                        acc[0] += bflo(xv.x) * w0.x; acc[1] += bfhi(xv.x) * w0.y; acc[2] += bflo(xv.y) * w0.z; acc[3] += bfhi(xv.y) * w0.w;
                        acc[4] += bflo(xv.z) * w1.x; acc[5] += bfhi(xv.z) * w1.y; acc[6] += bflo(xv.w) * w1.z; acc[7] += bfhi(xv.w) * w1.w;
                    }
                }
#pragma unroll
                for (int q = 0; q < 8; ++q) acc[q] = acc[q] * sigmoidf_(acc[q]);
                v4u o; o.x = pk2(acc[0], acc[1]); o.y = pk2(acc[2], acc[3]); o.z = pk2(acc[4], acc[5]); o.w = pk2(acc[6], acc[7]);
                *(GAS v4u*)(HN + (size_t)m * 1024 + c8) = o;
            }
        }
        GRID_BAR();
        if (bid < 64) {
            PHASE_PTRS();
            const int b = bid >> 3, h = (bid >> 1) & 3, dir = bid & 1;
            mlstm_scan(lds, HN, PROJ, GATES, HFB + (size_t)dir * M * MW, b, h, dir, tid);
        } else {
            PHASE_PTRS();
            const int NWA = (G - 64) * NWAVES;
            LAS unsigned char* wl = lds + wave * 8192;
            for (int t = (bid - 64) * NWAVES + wave; t < BATCH * AH * 192; t += NWA) {
                const int bh = t / 192, rem = t % 192, br = rem >> 6, ti = rem & 63, b = bh >> 3, h = bh & 7;
                const bf16* base = PROJ + (size_t)b * SEQ * NPROJ + h * 64;
                bf16* obase; int ostride;
                if (br == 0) { obase = O1 + (size_t)b * SEQ * AW + h * 64; ostride = AW; }
                else { obase = PROJ + (size_t)b * SEQ * NPROJ + (br == 1 ? 1536 : 2048) + h * 64; ostride = NPROJ; }
                attn_task(base, obase, ostride, LSE + (size_t)br * M * 8 + (size_t)b * SEQ * 8 + h, br, ti, wl, lane);
            }
        }
        GRID_BAR();
        {
            PHASE_PTRS();
            const float* hg = a.head_g + (size_t)l * MW;
            for (int m = gw; m < M; m += NGW) {
                {
                    const v4u o1 = *(const GAS v4u*)(O1 + (size_t)m * AW + 8 * lane), o2 = *(const GAS v4u*)(PROJ + (size_t)m * NPROJ + 1536 + 8 * lane), o3 = *(const GAS v4u*)(PROJ + (size_t)m * NPROJ + 2048 + 8 * lane);
                    const float l1 = LSE[(size_t)m * 8 + (lane >> 3)], l2 = LSE[(size_t)M * 8 + (size_t)m * 8 + (lane >> 3)], l3 = LSE[(size_t)2 * M * 8 + (size_t)m * 8 + (lane >> 3)];
                    const float lm = fmaxf(l1, fmaxf(l2, l3));
                    float w1 = __expf(l1 - lm), w2 = __expf(l2 - lm), w3 = __expf(l3 - lm); const float wi = 1.f / (w1 + w2 + w3); w1 *= wi; w2 *= wi; w3 *= wi;
                    v4u w;
                    w.x = pk2(w1 * bflo(o1.x) + w2 * bflo(o2.x) + w3 * bflo(o3.x), w1 * bfhi(o1.x) + w2 * bfhi(o2.x) + w3 * bfhi(o3.x));
                    w.y = pk2(w1 * bflo(o1.y) + w2 * bflo(o2.y) + w3 * bflo(o3.y), w1 * bfhi(o1.y) + w2 * bfhi(o2.y) + w3 * bfhi(o3.y));
                    w.z = pk2(w1 * bflo(o1.z) + w2 * bflo(o2.z) + w3 * bflo(o3.z), w1 * bfhi(o1.z) + w2 * bfhi(o2.z) + w3 * bfhi(o3.z));
                    w.w = pk2(w1 * bflo(o1.w) + w2 * bflo(o2.w) + w3 * bflo(o3.w), w1 * bfhi(o1.w) + w2 * bfhi(o2.w) + w3 * bfhi(o3.w));
                    *(GAS v4u*)(HN + (size_t)m * 1024 + 8 * lane) = w;
                }
                const v4u hf = *(const GAS v4u*)(HFB + (size_t)m * MW + 8 * lane), hb = *(const GAS v4u*)(HFB + (size_t)M * MW + (size_t)m * MW + 8 * lane);
                const v4u mo = *(const GAS v4u*)(PROJ + (size_t)m * NPROJ + 3072 + 8 * lane);
                float hm[8] = {bflo(hf.x) + bflo(hb.x), bfhi(hf.x) + bfhi(hb.x), bflo(hf.y) + bflo(hb.y), bfhi(hf.y) + bfhi(hb.y),
                               bflo(hf.z) + bflo(hb.z), bfhi(hf.z) + bfhi(hb.z), bflo(hf.w) + bflo(hb.w), bfhi(hf.w) + bfhi(hb.w)};
                float ov[8] = {bflo(mo.x), bfhi(mo.x), bflo(mo.y), bfhi(mo.y), bflo(mo.z), bfhi(mo.z), bflo(mo.w), bfhi(mo.w)};
                float s = 0.f;
#pragma unroll
                for (int q = 0; q < 8; ++q) s += hm[q] * hm[q];
                s += shx(s, 1, lane); s += shx(s, 2, lane); s += shx(s, 4, lane); s += shx(s, 8, lane);
                const float rs = 1.0f / sqrtf(s * (1.f / 128.f) + EPS);
                const f32x4 g0 = *(const GAS f32x4*)(hg + 8 * lane), g1 = *(const GAS f32x4*)(hg + 8 * lane + 4);
                const float gg[8] = {g0.x, g0.y, g0.z, g0.w, g1.x, g1.y, g1.z, g1.w};
                float o[8];
#pragma unroll
                for (int q = 0; q < 8; ++q) o[q] = hm[q] * rs * gg[q] * sigmoidf_(ov[q]);
                v4u w; w.x = pk2(o[0], o[1]); w.y = pk2(o[2], o[3]); w.z = pk2(o[4], o[5]); w.w = pk2(o[6], o[7]);
                *(GAS v4u*)(HN + (size_t)m * 1024 + 512 + 8 * lane) = w;
            }
        }
        GRID_BAR();
        {
            PHASE_PTRS();
            pg8::Gemm g{HN, Wout_t + (size_t)l * DM * DM, M, DM, DM}; pg8::StaticOrder S; S.init(M, DM, G, bid);
            pg8::EpiF32 E{T, DM, nullptr};
            pg8::gemm_phase<pg8::EpiF32, pg8::StaticOrder, true, true>(lds, g, S, E);
        }
        GRID_BAR();
        {
            PHASE_PTRS();
            f32x4 g1[4], g2[4];
#pragma unroll
            for (int j = 0; j < 4; ++j) { g1[j] = ((const GAS f32x4*)(a.mix_post_g + (size_t)l * DM))[lane + 64 * j]; g2[j] = ((const GAS f32x4*)(a.ffn_pre_g + (size_t)l * DM))[lane + 64 * j]; }
            const float* xin = (l == 0) ? a.x : R;
            for (int m = gw; m < M; m += NGW) {
                f32x4 v[4], xb[4];
#pragma unroll
                for (int j = 0; j < 4; ++j) { v[j] = ((const GAS f32x4*)(T + (size_t)m * DM))[lane + 64 * j]; xb[j] = ((const GAS f32x4*)(xin + (size_t)m * DM))[lane + 64 * j]; }
                rms_row(v, g1, lane);
#pragma unroll
                for (int j = 0; j < 4; ++j) { v[j] = v[j] + xb[j]; ((GAS f32x4*)(R + (size_t)m * DM))[lane + 64 * j] = v[j]; }
                rms_row(v, g2, lane);
                store_row_bf16(HN + (size_t)m * DM, v, lane);
            }
        }
        GRID_BAR();
        {
            PHASE_PTRS();
            pg8::Gemm g{nullptr, Wup_t + (size_t)l * NUP * DM, 68 * 256, NUP, DM}; pg8::StaticOrder S; S.init(68 * 256, NUP, G, bid);
            pg8::EpiFfn E{HB16, a.fconv_w + (size_t)l * 3 * NUP, a.fconv_b + (size_t)l * NUP};
            pg8::AFfn AM{(const char*)(wsl + WS_ZROW), (unsigned)(WS_HN - WS_ZROW)};
            pg8::gemm_phase<pg8::EpiFfn, pg8::StaticOrder, true, true, pg8::AFfn>(lds, g, S, E, AM);
        }
        GRID_BAR();
        {
            PHASE_PTRS();
            pg8::Gemm g{HB16, Wdn_t + (size_t)l * DM * DFF, M, DM, DFF}; pg8::StaticOrder S; S.init(M, DM, G, bid);
            pg8::EpiF32 E{T, DM, nullptr};
            pg8::gemm_phase<pg8::EpiF32, pg8::StaticOrder, true, true>(lds, g, S, E);
        }
        GRID_BAR();
        {
            PHASE_PTRS();
            const bool more = (l + 1 < DEPTH);
            LAS float* wg = (LAS float*)lds;
            if (more) {
                const float* w_in_n = a.w_in + (size_t)(l + 1) * DM * PROJ_COLS;
                for (int i = tid; i < DM * 16; i += NTHR) wg[i] = w_in_n[(size_t)(i >> 4) * PROJ_COLS + NPROJ + (i & 15)];
                __syncthreads();
            }
            f32x4 g1[4], g2[4];
#pragma unroll
            for (int j = 0; j < 4; ++j) { g1[j] = ((const GAS f32x4*)(a.ffn_post_g + (size_t)l * DM))[lane + 64 * j];
                g2[j] = more ? ((const GAS f32x4*)(a.mix_pre_g + (size_t)(l + 1) * DM))[lane + 64 * j] : (f32x4){0.f, 0.f, 0.f, 0.f}; }
            for (int m = gw; m < M; m += NGW) {
                f32x4 v[4], xb[4];
#pragma unroll
                for (int j = 0; j < 4; ++j) { v[j] = ((const GAS f32x4*)(T + (size_t)m * DM))[lane + 64 * j]; xb[j] = ((const GAS f32x4*)(R + (size_t)m * DM))[lane + 64 * j]; }
                rms_row(v, g1, lane);
#pragma unroll
                for (int j = 0; j < 4; ++j) { v[j] = v[j] + xb[j]; ((GAS f32x4*)(R + (size_t)m * DM))[lane + 64 * j] = v[j]; }
                if (more) {
                    rms_row(v, g2, lane);
                    store_row_bf16(HN + (size_t)m * DM, v, lane);
                    gates_row(v, wg, a.gate_b + (l + 1) * 16, GATES + (size_t)m * 16, lane);
                }
            }
            __syncthreads();
        }
    }
}

extern "C" void kernel_launch(void* const* d_in, const int* in_sizes, int n_in, void* d_out, int out_size, void* d_ws, size_t ws_size, hipStream_t stream) {
    static int grid = 0;
    if (grid == 0) {
        if (n_in != 15 || in_sizes[0] != M * DM || out_size != M * DM || ws_size < WS_END) { fprintf(stderr, "kernel_launch: unexpected shapes n_in %d in0 %d out %d ws %zu\n", n_in, n_in > 0 ? in_sizes[0] : -1, out_size, ws_size); grid = -1; return; }
        int dev = 0, cus = 0, per_cu = 0;
        hipGetDevice(&dev); hipDeviceGetAttribute(&cus, hipDeviceAttributeMultiprocessorCount, dev);
        if (hipFuncSetAttribute((const void*)hybrid_fwd, hipFuncAttributeMaxDynamicSharedMemorySize, LDS_BYTES) != hipSuccess) { fprintf(stderr, "kernel_launch: hipFuncSetAttribute failed\n"); grid = -1; return; }
        if (hipOccupancyMaxActiveBlocksPerMultiprocessor(&per_cu, (const void*)hybrid_fwd, NTHR, LDS_BYTES) != hipSuccess || per_cu < 1) { fprintf(stderr, "kernel_launch: occupancy query says %d\n", per_cu); per_cu = 1; }
        (void)hipGetLastError();
        grid = cus;
        if (grid > 256) grid = 256;
    }
    if (grid < 0) return;
    if (hipMemsetAsync((char*)d_ws + WS_CTL, 0, CTL_ZERO_BYTES, stream) != hipSuccess) { fprintf(stderr, "kernel_launch: memset failed\n"); return; }
    Args a{};
    a.x = (const float*)d_in[0]; a.mix_pre_g = (const float*)d_in[1]; a.w_in = (const float*)d_in[2]; a.mconv_w = (const float*)d_in[3]; a.mconv_b = (const float*)d_in[4];
    a.gate_b = (const float*)d_in[5]; a.head_g = (const float*)d_in[6]; a.w_out = (const float*)d_in[7]; a.mix_post_g = (const float*)d_in[8]; a.ffn_pre_g = (const float*)d_in[9];
    a.w_up = (const float*)d_in[10]; a.fconv_w = (const float*)d_in[11]; a.fconv_b = (const float*)d_in[12]; a.w_down = (const float*)d_in[13]; a.ffn_post_g = (const float*)d_in[14];
    a.out = (float*)d_out; a.ws = (unsigned char*)d_ws;
    void* args[] = {&a};
    hipError_t e = hipLaunchCooperativeKernel((const void*)hybrid_fwd, dim3(grid), dim3(NTHR), args, LDS_BYTES, stream);
    if (e != hipSuccess) fprintf(stderr, "cooperative launch failed: %s (grid %d)\n", hipGetErrorString(e), grid);
}
```

```cpp
#include <hip/hip_runtime.h>
#include <hip/hip_cooperative_groups.h>
#include <cstdio>
#include <cstdint>
namespace cg = cooperative_groups;
namespace pg8 {
#define PG8_LAS __attribute__((address_space(3)))
typedef unsigned short bf16_t;
typedef short bf16x8 __attribute__((ext_vector_type(8)));
typedef float f32x4 __attribute__((ext_vector_type(4)));
typedef unsigned u32x4 __attribute__((ext_vector_type(4)));
constexpr int BM = 256, BK = 64, HALF = 128, HTB = HALF * BK * 2  , STAGE_BYTES = 8 * HTB, NXCD = 8, WGM = 8;

__host__ __device__ __forceinline__ int lds_byte(int r, int c) { const int st = (r >> 4) * 2 + (c >> 5), rr = r & 15, cc = c & 31, ob = rr * 64 + cc * 2; return st * 1024 + (ob ^ (((ob >> 9) & 1) << 5)); }
__host__ __device__ __forceinline__ void stage_rc(int b, int& R, int& C) { const int st = b / 1024, sb = b % 1024, swz = sb ^ (((sb >> 9) & 1) << 5); R = (st >> 1) * 16 + swz / 64; C = (st & 1) * 32 + (swz % 64) / 2; }
__host__ __device__ __forceinline__ int perm32(int rho) { const int n = rho >> 4, i = rho & 15; return 8 * (i >> 2) + 4 * n + (i & 3); }

struct Unit { int pm, pn; };
struct Gemm { const bf16_t* A; const bf16_t* Bt; int M, N, K; };

struct StaticOrder {
    int nM, nN, nwg, G, c;
    __host__ __device__ void init(int M, int N, int G_, int c_) { nM = M / BM; nN = N / BM; nwg = nM * nN; G = G_; c = c_; }
    __host__ __device__ bool next(int i, Unit& u) const {
        const long L = (long)i * G + c; if (L >= nwg) return false;
        int wgid = (int)L; { const int q = nwg / NXCD, r = nwg % NXCD, xcd = wgid % NXCD, off = wgid / NXCD; wgid = (xcd < r ? xcd * (q + 1) : r * (q + 1) + (xcd - r) * q) + off; }
        const int nig = WGM * nN, gid = wgid / nig, fm = gid * WGM, gsz = (nM - fm) < WGM ? (nM - fm) : WGM;
        u.pm = fm + ((wgid % nig) % gsz); u.pn = (wgid % nig) / gsz; return true;
    }
    __device__ __forceinline__ void a_ready(const Unit&) const {}
    __device__ __forceinline__ void done(const Unit&) const {}
};

__device__ __forceinline__ unsigned cvt_pk_bf16(float lo, float hi) { unsigned r; asm volatile("v_cvt_pk_bf16_f32 %0, %1, %2" : "=v"(r) : "v"(lo), "v"(hi)); return r; }
typedef float f32x2 __attribute__((ext_vector_type(2)));
__device__ __forceinline__ f32x2 gelu_pk(f32x2 v) {
    const f32x2 av = __builtin_elementwise_abs(v), d = av * 0.2316418882f + 1.0f;
    f32x2 t; t.x = __builtin_amdgcn_rcpf(d.x); t.y = __builtin_amdgcn_rcpf(d.y);
    f32x2 q = t * 0.5307027145f + (-0.7265760135f); q = q * t + 0.7107068705f; q = q * t + (-0.142248368f); q = q * t + 0.127414796f; q = q * t;
    const f32x2 s = (v * v) * (-0.72134752044f);
    f32x2 e; e.x = __builtin_amdgcn_exp2f(s.x); e.y = __builtin_amdgcn_exp2f(s.y);
    const f32x2 m = v * (q * e), r = v - m;
    f32x2 o; o.x = v.x < 0.f ? m.x : r.x; o.y = v.y < 0.f ? m.y : r.y; return o;
}

template <int ACT  > struct EpiBf16 {
    static constexpr bool PERM = true, AFTER_DRAIN = false; static_assert(ACT == 0 || ACT == 1, "EpiBf16: ACT is 0 (none) or 1 (gelu_pk)");
    bf16_t* O; int ldc; const float* bias; int split_cols; size_t split_stride; float scale0;
    __device__ __forceinline__ void operator()(const f32x4 (&acc)[2][2][4][2], const Unit& u, int wr, int wc, int fr, int fq) const {
        const int row0 = u.pm * BM + wr * 64 + fr; int colt = u.pn * BM; bf16_t* base = O;
        float sc = 1.f; if (split_cols) { const int t = colt / split_cols; base += (size_t)t * split_stride; colt -= t * split_cols; if (t == 0) sc = scale0; }
        const int col0 = colt + wc * 32 + 8 * fq, bcol0 = u.pn * BM + wc * 32 + 8 * fq;
        f32x4 bv[2][2];
#pragma unroll
        for (int bj = 0; bj < 2; ++bj)
#pragma unroll
            for (int n = 0; n < 2; ++n) bv[bj][n] = bias ? *(const f32x4*)(bias + bcol0 + bj * HALF + 4 * n) : (f32x4){0.f, 0.f, 0.f, 0.f};
#pragma unroll
        for (int ai = 0; ai < 2; ++ai)
#pragma unroll
            for (int m = 0; m < 4; ++m) { bf16_t* rowp = base + (size_t)(row0 + ai * HALF + m * 16) * ldc + col0;
#pragma unroll
                for (int bj = 0; bj < 2; ++bj) { f32x4 v0 = acc[ai][bj][m][0] + bv[bj][0], v1 = acc[ai][bj][m][1] + bv[bj][1];
                    if (ACT == 1) { f32x2 a = gelu_pk((f32x2){v0[0], v0[1]}), b = gelu_pk((f32x2){v0[2], v0[3]}), c = gelu_pk((f32x2){v1[0], v1[1]}), d = gelu_pk((f32x2){v1[2], v1[3]});
                        v0 = (f32x4){a.x, a.y, b.x, b.y}; v1 = (f32x4){c.x, c.y, d.x, d.y}; }
                    v0 = v0 * sc; v1 = v1 * sc; u32x4 w; w.x = cvt_pk_bf16(v0[0], v0[1]); w.y = cvt_pk_bf16(v0[2], v0[3]); w.z = cvt_pk_bf16(v1[0], v1[1]); w.w = cvt_pk_bf16(v1[2], v1[3]);
                    *(u32x4*)(rowp + bj * HALF) = w; } }
    }
};
struct EpiF32 {
    static constexpr bool PERM = false, AFTER_DRAIN = false;
    float* C; int ldc; const float* bias;
    __device__ __forceinline__ void operator()(const f32x4 (&acc)[2][2][4][2], const Unit& u, int wr, int wc, int fr, int fq) const {
        const int row0 = u.pm * BM + wr * 64 + fr, col0 = u.pn * BM + wc * 32 + 4 * fq;
        f32x4 bv[2][2];
#pragma unroll
        for (int bj = 0; bj < 2; ++bj)
#pragma unroll
            for (int n = 0; n < 2; ++n) bv[bj][n] = bias ? *(const f32x4*)(bias + col0 + bj * HALF + n * 16) : (f32x4){0.f, 0.f, 0.f, 0.f};
#pragma unroll
        for (int ai = 0; ai < 2; ++ai)
#pragma unroll
            for (int m = 0; m < 4; ++m) { float* rowp = C + (size_t)(row0 + ai * HALF + m * 16) * ldc + col0;
#pragma unroll
                for (int bj = 0; bj < 2; ++bj)
#pragma unroll
                    for (int n = 0; n < 2; ++n) *(f32x4*)(rowp + bj * HALF + n * 16) = acc[ai][bj][m][n] + bv[bj][n]; }
    }
};
__device__ __forceinline__ float gelu_tanh_f(float x) {
    const float u2 = 1.5957691216057308f * (x + 0.044715f * x * x * x);
    const float e = __expf(u2);
    return x - x / (1.f + e);
}
struct EpiFfn {
    static constexpr bool PERM = true, AFTER_DRAIN = false;
    bf16_t* H; const float* cw; const float* cb;
    __device__ __forceinline__ void operator()(const f32x4 (&acc)[2][2][4][2], const Unit& u, int wr, int wc, int fr, int fq) const {
        int lane = fq * 16 + fr; asm volatile("" : "+v"(lane));
        const int sg = 2 * u.pm + wr, b = sg / 17, j = sg - 17 * b;
        const int i0 = 8 * fr, tok0 = 126 * j - 1 + i0;
        const int colh = u.pn * 128 + wc * 32 + 8 * fq;
        int up = (lane - 1) << 2, dn = (lane + 1) << 2; asm volatile("" : "+v"(up), "+v"(dn));
        unsigned ow[8][2][2];
#pragma unroll
        for (int n = 0; n < 2; ++n) {
            const int c = colh + 4 * n;
            const f32x4 wg0 = *(const f32x4*)(cw + c), wg1 = *(const f32x4*)(cw + 5632 + c), wg2 = *(const f32x4*)(cw + 2 * 5632 + c), bg = *(const f32x4*)(cb + c);
            const f32x4 wv0 = *(const f32x4*)(cw + 2816 + c), wv1 = *(const f32x4*)(cw + 5632 + 2816 + c), wv2 = *(const f32x4*)(cw + 2 * 5632 + 2816 + c), bv = *(const f32x4*)(cb + 2816 + c);
            float hv[8][4];
#pragma unroll
            for (int k = 0; k < 4; ++k) {
                float ug[8], uv[8];
#pragma unroll
                for (int e = 0; e < 8; ++e) { ug[e] = acc[e >> 2][0][e & 3][n][k]; uv[e] = acc[e >> 2][1][e & 3][n][k]; }
                const float gp = __builtin_bit_cast(float, __builtin_amdgcn_ds_bpermute(up, __builtin_bit_cast(int, ug[7])));
                const float gn = __builtin_bit_cast(float, __builtin_amdgcn_ds_bpermute(dn, __builtin_bit_cast(int, ug[0])));
                const float vp = __builtin_bit_cast(float, __builtin_amdgcn_ds_bpermute(up, __builtin_bit_cast(int, uv[7])));
                const float vn = __builtin_bit_cast(float, __builtin_amdgcn_ds_bpermute(dn, __builtin_bit_cast(int, uv[0])));
#pragma unroll
                for (int e = 0; e < 8; ++e) {
                    const float gm = (e == 0) ? gp : ug[e > 0 ? e - 1 : 0], gq = (e == 7) ? gn : ug[e < 7 ? e + 1 : 7];
                    const float vm = (e == 0) ? vp : uv[e > 0 ? e - 1 : 0], vq = (e == 7) ? vn : uv[e < 7 ? e + 1 : 7];
                    const float gc = wg0[k] * gm + wg1[k] * ug[e] + wg2[k] * gq + bg[k], vc = wv0[k] * vm + wv1[k] * uv[e] + wv2[k] * vq + bv[k];
                    hv[e][k] = gelu_tanh_f(gc) * vc;
                }
            }
#pragma unroll
            for (int e = 0; e < 8; ++e) { ow[e][n][0] = cvt_pk_bf16(hv[e][0], hv[e][1]); ow[e][n][1] = cvt_pk_bf16(hv[e][2], hv[e][3]); }
        }
#pragma unroll
        for (int e = 0; e < 8; ++e) {
            const int i = i0 + e, tok = tok0 + e;
            if (i >= 1 && i <= 126 && tok < 2048) {
                u32x4 w; w.x = ow[e][0][0]; w.y = ow[e][0][1]; w.z = ow[e][1][0]; w.w = ow[e][1][1];
                *(u32x4*)(H + (size_t)(b * 2048 + tok) * 2816 + colh) = w;
            }
        }
    }
};
struct APlain { static constexpr bool GATHER = false; const char* base; __device__ __forceinline__ unsigned rowoff(int, int) const { return 0u; } };
struct AFfn { static constexpr bool GATHER = true; const char* base; unsigned hn_off;
    __device__ __forceinline__ unsigned rowoff(int pm, int R) const {
        const int ai = R >> 7, wr = (R >> 6) & 1, m = (R >> 4) & 3, fr = R & 15;
        const int sg = 2 * pm + wr, b = sg / 17, j = sg - 17 * b, tok = 126 * j - 1 + 8 * fr + 4 * ai + m;
        return (tok >= 0 && tok < 2048) ? hn_off + (unsigned)(b * 2048 + tok) * 2048u : 0u; } };
template <class Epi, class Sched, bool ALIGN_EPI = false, bool SP2 = false, class AMap = APlain>
__device__ __forceinline__ void gemm_phase(PG8_LAS unsigned char* lds, const Gemm g, const Sched& S, const Epi& E, const AMap AM = AMap{nullptr}) {
    static_assert(SP2 || !AMap::GATHER, "gathered A rows: SP2 path only");
    int tid_ = threadIdx.x; asm volatile("" : "+v"(tid_));
    const int tid = tid_, wid = __builtin_amdgcn_readfirstlane(tid >> 6), lane = tid & 63, wr = wid >> 2, wc = wid & 3, fr = lane & 15, fq = lane >> 4;
    const int K = g.K, nt = K / BK;
    unsigned voffA[2], voffB[2];
#pragma unroll
    for (int i = 0; i < 2; ++i) { int R, C; stage_rc(tid * 16 + i * 8192, R, C); const int Rb = Epi::PERM ? ((R & ~31) + perm32(R & 31)) : R;
        voffA[i] = (unsigned)(R * K + C) * 2u; voffB[i] = (unsigned)(Rb * K + C) * 2u; }
    const size_t kstep = (size_t)(BK * 2);
    const size_t hstep = (size_t)HALF * K * 2;
    const size_t tstep = 2 * hstep;
    const unsigned ldsw = (unsigned)wid * 1024u;
    const int aoff = lds_byte(wr * 64 + fr, fq * 8), boff = lds_byte(wc * 32 + fr, fq * 8);
#define PG8_SA(b, h) (((b) * 2 + (h)) * HTB)
#define PG8_SB(b, h) ((4 + (b) * 2 + (h)) * HTB)
#define PG8_STAGE(bufoff, gbase, voff) do { _Pragma("unroll") for (int _i = 0; _i < 2; ++_i) \
        __builtin_amdgcn_global_load_lds((const unsigned*)((const char*)(gbase) + (voff)[_i]), (PG8_LAS unsigned*)(lds + (bufoff) + ldsw + _i * 8192), 16, 0, 0); } while (0)
#define PG8_STAGE_A(bufoff, plainptr, kb, vg) do { if constexpr (AMap::GATHER) { PG8_STAGE(bufoff, AM.base + (kb), vg); } else { PG8_STAGE(bufoff, plainptr, voffA); } } while (0)
#define PG8_LDA(dst, b, h) do { _Pragma("unroll") for (int m = 0; m < 4; ++m) _Pragma("unroll") for (int k = 0; k < 2; ++k) dst[m][k] = *(const PG8_LAS bf16x8*)(lds + PG8_SA(b, h) + aoff + m * 2048 + k * 1024); } while (0)
#define PG8_LDB(dst, b, h) do { _Pragma("unroll") for (int n = 0; n < 2; ++n) _Pragma("unroll") for (int k = 0; k < 2; ++k) dst[n][k] = *(const PG8_LAS bf16x8*)(lds + PG8_SB(b, h) + boff + n * 2048 + k * 1024); } while (0)
#define PG8_MMA(ai, bj, At, Bt) do { __builtin_amdgcn_s_setprio(1); _Pragma("unroll") for (int m = 0; m < 4; ++m) _Pragma("unroll") for (int n = 0; n < 2; ++n) _Pragma("unroll") for (int k = 0; k < 2; ++k) \
        acc[ai][bj][m][n] = __builtin_amdgcn_mfma_f32_16x16x32_bf16(Bt[n][k], At[m][k], acc[ai][bj][m][n], 0, 0, 0); __builtin_amdgcn_s_setprio(0); } while (0)
#define PG8_WAIT_V(n) asm volatile("s_waitcnt vmcnt(" #n ")" ::: "memory")
#define PG8_WAIT_L(n) asm volatile("s_waitcnt lgkmcnt(" #n ")" ::: "memory")
#define PG8_BAR __builtin_amdgcn_s_barrier()
#define PG8_SCHED __builtin_amdgcn_sched_barrier(0)
    Unit cur, nxt; int ui = 0;
    if (!S.next(0, cur)) return;
    f32x4 acc[2][2][4][2];
#pragma unroll
    for (int a = 0; a < 2; ++a)
#pragma unroll
        for (int b = 0; b < 2; ++b)
#pragma unroll
            for (int m = 0; m < 4; ++m)
#pragma unroll
                for (int n = 0; n < 2; ++n) acc[a][b][m][n] = (f32x4){0.f, 0.f, 0.f, 0.f};
    bf16x8 At[4][2], B0[2][2], B1[2][2];
    const char* cA = (const char*)g.A + (size_t)cur.pm * tstep; const char* cB = (const char*)g.Bt + (size_t)cur.pn * tstep;
    S.a_ready(cur);
    unsigned vcur[2][2] = {{0u, 0u}, {0u, 0u}}, vnxt[2][2] = {{0u, 0u}, {0u, 0u}};
#define PG8_SETV(v, pm_) do { if constexpr (AMap::GATHER) { _Pragma("unroll") for (int h_ = 0; h_ < 2; ++h_) _Pragma("unroll") for (int i_ = 0; i_ < 2; ++i_) { int R_, C_; stage_rc(tid * 16 + i_ * 8192, R_, C_); v[h_][i_] = AM.rowoff(pm_, 128 * h_ + R_) + (unsigned)C_ * 2u; } } } while (0)
    PG8_SETV(vcur, cur.pm);
    if constexpr (SP2) {
        PG8_STAGE(PG8_SB(0, 0), cB, voffB); PG8_STAGE(PG8_SB(0, 1), cB + hstep, voffB); PG8_STAGE_A(PG8_SA(0, 0), cA, 0, vcur[0]); PG8_STAGE_A(PG8_SA(0, 1), cA + hstep, 0, vcur[1]);
        if (wr == 1) PG8_BAR;
        PG8_WAIT_V(2); PG8_BAR;
        PG8_STAGE(PG8_SB(1, 0), cB + kstep, voffB); PG8_STAGE_A(PG8_SA(1, 0), cA + kstep, kstep, vcur[0]); PG8_STAGE(PG8_SB(1, 1), cB + hstep + kstep, voffB);
        PG8_WAIT_V(6); PG8_BAR;
    } else {
        PG8_STAGE(PG8_SB(0, 0), cB, voffB); PG8_STAGE(PG8_SA(0, 0), cA, voffA); PG8_STAGE(PG8_SB(0, 1), cB + hstep, voffB); PG8_STAGE(PG8_SA(0, 1), cA + hstep, voffA);
        if (wr == 1) PG8_BAR;
        PG8_WAIT_V(4); PG8_BAR;
        PG8_STAGE(PG8_SB(1, 0), cB + kstep, voffB); PG8_STAGE(PG8_SA(1, 0), cA + kstep, voffA); PG8_STAGE(PG8_SB(1, 1), cB + hstep + kstep, voffB);
        PG8_WAIT_V(6); PG8_BAR;
    }
    for (;;) {
        const bool has_next = S.next(ui + 1, nxt);
        if (has_next) PG8_SETV(vnxt, nxt.pm);
        const char* nA = has_next ? (const char*)g.A + (size_t)nxt.pm * tstep : cA; const char* nB = has_next ? (const char*)g.Bt + (size_t)nxt.pn * tstep : cB;
        for (int t = 0; t < nt; t += 2) {
            const bool last = (t == nt - 2);
            const char* a1 = cA + (size_t)(t + 1) * kstep;
            const char* a2 = last ? nA : cA + (size_t)(t + 2) * kstep; const char* b2 = last ? nB : cB + (size_t)(t + 2) * kstep;
            const char* a3 = a2 + kstep; const char* b3 = b2 + kstep;
            if (last && has_next) S.a_ready(nxt);
            const size_t k1 = (size_t)(t + 1) * kstep, k2 = last ? (size_t)0 : (size_t)(t + 2) * kstep; const bool usen = last && has_next;
            unsigned vs[2][2];
#pragma unroll
            for (int h_ = 0; h_ < 2; ++h_)
#pragma unroll
                for (int i_ = 0; i_ < 2; ++i_) vs[h_][i_] = usen ? vnxt[h_][i_] : vcur[h_][i_];
            (void)k1; (void)k2;
            if constexpr (SP2) {
            PG8_LDB(B0, 0, 0); PG8_LDB(B1, 0, 1); PG8_SCHED; PG8_LDA(At, 0, 0); PG8_STAGE_A(PG8_SA(1, 1), a1 + hstep, k1, vcur[1]);
            PG8_WAIT_V(8); PG8_WAIT_L(0); PG8_BAR; PG8_MMA(0, 0, At, B0); PG8_MMA(0, 1, At, B1); PG8_BAR; PG8_SCHED;
            PG8_LDA(At, 0, 1); PG8_STAGE(PG8_SB(0, 0), b2, voffB); PG8_STAGE(PG8_SB(0, 1), b2 + hstep, voffB); PG8_STAGE_A(PG8_SA(0, 0), a2, k2, vs[0]);
            PG8_WAIT_V(8); PG8_WAIT_L(0); PG8_BAR; PG8_MMA(1, 0, At, B0); PG8_MMA(1, 1, At, B1); PG8_BAR; PG8_SCHED;
            PG8_LDB(B0, 1, 0); PG8_LDB(B1, 1, 1); PG8_SCHED; PG8_LDA(At, 1, 0); PG8_STAGE_A(PG8_SA(0, 1), a2 + hstep, k2, vs[1]);
            PG8_WAIT_V(8); PG8_WAIT_L(0); PG8_BAR; PG8_MMA(0, 0, At, B0); PG8_MMA(0, 1, At, B1); PG8_BAR; PG8_SCHED;
            PG8_LDA(At, 1, 1); PG8_STAGE(PG8_SB(1, 0), b3, voffB); PG8_STAGE(PG8_SB(1, 1), b3 + hstep, voffB); PG8_STAGE_A(PG8_SA(1, 0), a3, k2 + kstep, vs[0]);
            PG8_WAIT_V(8); PG8_WAIT_L(0); PG8_BAR; PG8_MMA(1, 0, At, B0); PG8_MMA(1, 1, At, B1); PG8_BAR; PG8_SCHED;
            } else {
            PG8_LDB(B0, 0, 0); PG8_SCHED; PG8_LDA(At, 0, 0); PG8_STAGE(PG8_SA(1, 1), a1 + hstep, voffA);
            PG8_WAIT_L(8); PG8_BAR; PG8_WAIT_L(0); PG8_MMA(0, 0, At, B0); PG8_BAR; PG8_SCHED;
            PG8_LDB(B1, 0, 1); PG8_STAGE(PG8_SB(0, 0), b2, voffB);
            PG8_BAR; PG8_WAIT_L(0); PG8_MMA(0, 1, At, B1); PG8_BAR;
            PG8_LDA(At, 0, 1); PG8_STAGE(PG8_SA(0, 0), a2, voffA);
            PG8_BAR; PG8_WAIT_L(0); PG8_MMA(1, 0, At, B0); PG8_BAR; PG8_SCHED;
            PG8_STAGE(PG8_SB(0, 1), b2 + hstep, voffB);
            PG8_WAIT_V(6); PG8_BAR; PG8_MMA(1, 1, At, B1); PG8_BAR;
            PG8_LDB(B0, 1, 0); PG8_SCHED; PG8_LDA(At, 1, 0); PG8_STAGE(PG8_SA(0, 1), a2 + hstep, voffA);
            PG8_WAIT_L(8); PG8_BAR; PG8_WAIT_L(0); PG8_MMA(0, 0, At, B0); PG8_BAR; PG8_SCHED;
            PG8_LDB(B1, 1, 1); PG8_STAGE(PG8_SB(1, 0), b3, voffB);
            PG8_BAR; PG8_WAIT_L(0); PG8_MMA(0, 1, At, B1); PG8_BAR;
            PG8_LDA(At, 1, 1); PG8_STAGE(PG8_SA(1, 0), a3, voffA);
            PG8_BAR; PG8_WAIT_L(0); PG8_MMA(1, 0, At, B0); PG8_BAR; PG8_SCHED;
            PG8_STAGE(PG8_SB(1, 1), b3 + hstep, voffB);
            PG8_WAIT_V(6); PG8_BAR; PG8_MMA(1, 1, At, B1); PG8_BAR;
            }
        }
        if constexpr (ALIGN_EPI) { if (wr == 0) PG8_BAR; }
        if constexpr (!Epi::AFTER_DRAIN) { E(acc, cur, wr, wc, fr, fq); S.done(cur); }
        if (!has_next) break;
#pragma unroll
        for (int a = 0; a < 2; ++a)
#pragma unroll
            for (int b = 0; b < 2; ++b)
#pragma unroll
                for (int m = 0; m < 4; ++m)
#pragma unroll
                    for (int n = 0; n < 2; ++n) acc[a][b][m][n] = (f32x4){0.f, 0.f, 0.f, 0.f};
        cur = nxt; cA = nA; cB = nB; ++ui;
#pragma unroll
        for (int h_ = 0; h_ < 2; ++h_)
#pragma unroll
            for (int i_ = 0; i_ < 2; ++i_) vcur[h_][i_] = vnxt[h_][i_];
        if constexpr (ALIGN_EPI) { if (wr == 1) PG8_BAR; }
    }
    PG8_WAIT_V(0);
    if constexpr (!ALIGN_EPI) { if (wr == 0) PG8_BAR; }
    PG8_BAR;
    if constexpr (Epi::AFTER_DRAIN) { E.fused(acc, cur, wr, wc, fr, fq, lds, wid, lane); S.done(cur); }
#undef PG8_SA
#undef PG8_SB
#undef PG8_STAGE
#undef PG8_STAGE_A
#undef PG8_SETV
#undef PG8_LDA
#undef PG8_LDB
#undef PG8_MMA
#undef PG8_WAIT_V
#undef PG8_WAIT_L
#undef PG8_BAR
#undef PG8_SCHED
}
}
#define GAS __attribute__((address_space(1)))
#define LAS __attribute__((address_space(3)))
typedef unsigned short bf16;
typedef unsigned v4u __attribute__((ext_vector_type(4)));
typedef float f32x4 __attribute__((ext_vector_type(4)));
typedef short bf16x8 __attribute__((ext_vector_type(8)));
typedef GAS unsigned gu32;
typedef GAS unsigned long long gu64;
#define RLX_AGENT __ATOMIC_RELAXED, __HIP_MEMORY_SCOPE_AGENT
#define LDS_WAIT() asm volatile("s_waitcnt lgkmcnt(0)" ::: "memory")
#define VM_WAIT() asm volatile("s_waitcnt vmcnt(0)" ::: "memory")
__device__ __forceinline__ unsigned long long rt() { return __builtin_amdgcn_s_memrealtime(); }
__device__ __forceinline__ unsigned f2bf(float f) { unsigned u = __builtin_bit_cast(unsigned, f); return (u + 0x7fffu + ((u >> 16) & 1u)) >> 16; }
__device__ __forceinline__ unsigned pk2(float lo, float hi) { return f2bf(lo) | (f2bf(hi) << 16); }

#define XB_TMO      128
#define XB_XCNT(j)  (256  + 64 * (j))
#define XB_XSUB(j)  (1280 + 64 * (j))
#define XB_XGEN(j)  (2304 + 64 * (j))
#define XB_TOP      3328
#define XB_TOPGEN   3392
#define XCD_BAR_WORDS 3456
#define XB_SPIN_CAP (1u << 18)

__device__ __forceinline__ unsigned xb_ld(unsigned* p)              { return __hip_atomic_load(p, __ATOMIC_RELAXED, __HIP_MEMORY_SCOPE_AGENT); }
__device__ __forceinline__ unsigned xb_add(unsigned* p, unsigned v) { return __hip_atomic_fetch_add(p, v, __ATOMIC_RELAXED, __HIP_MEMORY_SCOPE_AGENT); }
__device__ __forceinline__ unsigned xb_xcc_id() { return (unsigned)__builtin_amdgcn_s_getreg((3 << 11) | 20) & 0xFu; }
#define XB_SPIN(cond, bar) do { unsigned _sp = 0; while (cond) { __builtin_amdgcn_s_sleep(1); \
    if ((++_sp & 255u) == 0u) { if (xb_ld(&(bar)[XB_TMO])) break; if (_sp > XB_SPIN_CAP) { atomicAdd(&(bar)[XB_TMO], 1u); break; } } } } while (0)

struct XcdBarrier {
    unsigned* bar; unsigned x;
    volatile LAS unsigned* st;
};

__device__ __forceinline__ XcdBarrier xcd_barrier_post(unsigned* bar, volatile LAS unsigned* st) {
    XcdBarrier b; b.bar = bar; b.x = xb_xcc_id(); b.st = st;
    if (threadIdx.x == 0) (void)xb_add(&bar[XB_XCNT(b.x)], 1u);
    return b;
}
__device__ __forceinline__ void xcd_barrier_complete(unsigned* bar, unsigned x, unsigned& nloc, unsigned& nx) {
    const unsigned G = gridDim.x * gridDim.y * gridDim.z;
    unsigned sum, cnt, mine, sp = 0u;
    for (;;) {
        sum = 0u; cnt = 0u; mine = 0u;
#pragma unroll
        for (unsigned j = 0; j < 16; ++j) { const unsigned c = xb_ld(&bar[XB_XCNT(j)]); sum += c; cnt += (c > 0u) ? 1u : 0u; mine = (j == x) ? c : mine; }
        if (sum == G) break;
        __builtin_amdgcn_s_sleep(1);
        if ((++sp & 255u) == 0u) { if (xb_ld(&bar[XB_TMO])) break; if (sp > XB_SPIN_CAP) { atomicAdd(&bar[XB_TMO], 1u); break; } }
    }
    nloc = mine > 0u ? mine : 1u; nx = cnt > 0u ? cnt : 1u;
}

__device__ __forceinline__ void xcd_barrier(const XcdBarrier& b) {
    asm volatile("s_waitcnt vmcnt(0)" ::: "memory");
    __syncthreads();
    if (threadIdx.x == 0) {
        unsigned* bar = b.bar;
        __builtin_amdgcn_s_waitcnt(0);
        unsigned nloc = b.st[0], nx = b.st[1];
        if (nloc == 0u) { xcd_barrier_complete(bar, b.x, nloc, nx); b.st[0] = nloc; b.st[1] = nx; }
        const unsigned old = xb_add(&bar[XB_XSUB(b.x)], 1u);
        const unsigned gen = old / nloc;
        if (old + 1u == (gen + 1u) * nloc) {
            __builtin_amdgcn_fence(__ATOMIC_RELEASE, "agent");
            asm volatile("s_waitcnt vmcnt(0)" ::: "memory");
            const unsigned og = xb_add(&bar[XB_TOP], 1u);
            const unsigned tg = og / nx;
            if (og + 1u == (tg + 1u) * nx) xb_add(&bar[XB_TOPGEN], 1u);
            else XB_SPIN(xb_ld(&bar[XB_TOPGEN]) == tg, bar);
            __builtin_amdgcn_fence(__ATOMIC_ACQUIRE, "agent");
            xb_add(&bar[XB_XGEN(b.x)], 1u);
            asm volatile("s_waitcnt vmcnt(0)" ::: "memory");
        } else {
            XB_SPIN(xb_ld(&bar[XB_XGEN(b.x)]) == gen, bar);
            __builtin_amdgcn_fence(__ATOMIC_ACQUIRE, "agent");
            asm volatile("s_waitcnt vmcnt(0)" ::: "memory");
        }
    }
    __syncthreads();
}

constexpr int NWAVES = 8, NTHR = 512;
constexpr int BATCH = 8, SEQ = 2048, DM = 1024, M = BATCH * SEQ, DEPTH = 2;
constexpr int AW = 512, AH = 8, AD = 64;
constexpr int MW = 512, MH = 4, MD = 128;
constexpr int PROJ_COLS = 3600, NPROJ = 3584;
constexpr int DFF = 2816, NUP = 2 * DFF;
constexpr float EPS = 1e-6f;
constexpr size_t MiB = 1u << 20;
constexpr size_t WS_CTL = 0, CTL_ZERO_BYTES = 1 * MiB;
constexpr size_t WS_WIN = 1 * MiB;
constexpr size_t WS_WOUT = 15 * MiB;
constexpr size_t WS_WUP = 19 * MiB;
constexpr size_t WS_WDN = 41 * MiB;
constexpr size_t WS_ROPE = 52 * MiB;
constexpr size_t WS_GATES = 52 * MiB + 512 * 1024;
constexpr size_t WS_ZROW = 53 * MiB + 512 * 1024;
constexpr size_t WS_HN = 54 * MiB;
constexpr size_t WS_SCR = 86 * MiB;
constexpr size_t WS_PROJ = WS_SCR;
constexpr size_t WS_HFB = 198 * MiB;
constexpr size_t WS_H = WS_SCR;
constexpr size_t WS_U = 174 * MiB;
constexpr size_t WS_T = 174 * MiB;
constexpr size_t WS_O1 = 230 * MiB;
constexpr size_t WS_LSE = 246 * MiB;
constexpr size_t WS_END = 256 * MiB;
constexpr int CW_BAR = 4096;
constexpr int RING_BYTES = 131072, LDSCTL_OFF = RING_BYTES, MISC_OFF = LDSCTL_OFF + 320, LDS_BYTES = 147456;

struct Args {
    const float* x; const float* mix_pre_g; const float* w_in; const float* mconv_w; const float* mconv_b; const float* gate_b; const float* head_g;
    const float* w_out; const float* mix_post_g; const float* ffn_pre_g; const float* w_up; const float* fconv_w; const float* fconv_b; const float* w_down; const float* ffn_post_g;
    float* out; unsigned char* ws;
};

__device__ __forceinline__ float shx(float v, int mask, int lane) { return __builtin_bit_cast(float, __builtin_amdgcn_ds_bpermute((lane ^ mask) << 2, __builtin_bit_cast(int, v))); }
__device__ __forceinline__ float shup(float v, int d, int lane) { return __builtin_bit_cast(float, __builtin_amdgcn_ds_bpermute((lane - d) << 2, __builtin_bit_cast(int, v))); }
__device__ __forceinline__ float rdlane(float v, int l) { return __builtin_bit_cast(float, __builtin_amdgcn_readlane(__builtin_bit_cast(int, v), l)); }
__device__ __forceinline__ float wave_sum(float v, int lane) {
#pragma unroll
    for (int o = 1; o < 64; o <<= 1) v += shx(v, o, lane);
    return v;
}
__device__ __forceinline__ int lndv(int v) { asm volatile("" : "+v"(v)); return v; }
template <class T> __device__ __forceinline__ T* lnd(T* p) { asm volatile("" : "+s"(p)); return p; }
__device__ __forceinline__ float bf2f(unsigned short b) { return __builtin_bit_cast(float, (unsigned)b << 16); }
__device__ __forceinline__ float bflo(unsigned w) { return __builtin_bit_cast(float, w << 16); }
__device__ __forceinline__ float bfhi(unsigned w) { return __builtin_bit_cast(float, w & 0xffff0000u); }

template <bool UPMAP = false> __device__ __forceinline__ void transpose_item(const float* W, int K, int ldw, int ncols, bf16* WT, LAS float* scr, int item, int lane) {
    const int nblk = ncols / 64, kb = item / nblk, nb = item % nblk, k0 = 64 * kb, n0 = 64 * nb;
    const int d0 = UPMAP ? (n0 < DFF ? 256 * (n0 >> 7) + (n0 & 127) : 256 * ((n0 - DFF) >> 7) + 128 + ((n0 - DFF) & 127)) : n0;
    f32x4 v[16];
    const int kr = lane >> 4, n4 = lane & 15;
#pragma unroll
    for (int i = 0; i < 16; ++i) v[i] = *(const GAS f32x4*)(W + (size_t)(k0 + 4 * i + kr) * ldw + n0 + 4 * n4);
#pragma unroll
    for (int i = 0; i < 16; ++i) { const int k = 4 * i + kr; *(LAS f32x4*)(scr + k * 64 + 4 * (n4 ^ ((k >> 3) & 7))) = v[i]; }
    LDS_WAIT(); asm volatile("" ::: "memory");
    const int nlo = lane & 3, kc = (lane >> 2) & 7, hf = lane >> 5;
#pragma unroll
    for (int j = 0; j < 8; ++j) {
        const int nhi = 2 * j + hf, n = 4 * nhi + nlo;
        const LAS float* s = scr + (8 * kc) * 64 + 4 * (nhi ^ kc) + nlo;
        v4u o; o.x = pk2(s[0 * 64], s[1 * 64]); o.y = pk2(s[2 * 64], s[3 * 64]); o.z = pk2(s[4 * 64], s[5 * 64]); o.w = pk2(s[6 * 64], s[7 * 64]);
        *(GAS v4u*)(WT + (size_t)(d0 + n) * K + k0 + 8 * kc) = o;
    }
    LDS_WAIT(); asm volatile("" ::: "memory");
}

__device__ __forceinline__ void rms_row(f32x4 (&v)[4], const f32x4 (&g)[4], int lane) {
    float s = 0.f;
#pragma unroll
    for (int j = 0; j < 4; ++j) s += (v[j].x * v[j].x + v[j].y * v[j].y) + (v[j].z * v[j].z + v[j].w * v[j].w);
    const float rs = 1.0f / sqrtf(wave_sum(s, lane) * (1.f / DM) + EPS);
#pragma unroll
    for (int j = 0; j < 4; ++j) v[j] = v[j] * rs * g[j];
}
__device__ __forceinline__ void store_row_bf16(bf16* orow, const f32x4 (&v)[4], int lane) {
    GAS unsigned long long* o8 = (GAS unsigned long long*)orow + lane;
#pragma unroll
    for (int j = 0; j < 4; ++j) o8[64 * j] = (unsigned long long)pk2(v[j].x, v[j].y) | ((unsigned long long)pk2(v[j].z, v[j].w) << 32);
}
__device__ __forceinline__ void gates_fill(LAS float* wg, const float* w_in_l, int tid) {
    for (int i = tid; i < DM * 16; i += NTHR) { const int k = i >> 4, q = i & 15, j = k >> 8, ln = (k >> 2) & 63, c = k & 3;
        wg[((4 * j + c) * 64 + ln) * 20 + q] = w_in_l[(size_t)k * PROJ_COLS + NPROJ + q]; }
}
__device__ __forceinline__ void gates_row(const f32x4 (&y)[4], const LAS float* wg, const float* gb, float* grow, int lane) {
    float p[16];
#pragma unroll
    for (int q = 0; q < 16; ++q) p[q] = 0.f;
#pragma unroll
    for (int j = 0; j < 4; ++j)
#pragma unroll
        for (int c = 0; c < 4; ++c) {
            const float yk = y[j][c];
            const LAS f32x4* w4 = (const LAS f32x4*)(wg + ((4 * j + c) * 64 + lane) * 20);
#pragma unroll
            for (int q = 0; q < 4; ++q) { const f32x4 w = w4[q]; p[4 * q + 0] += yk * w.x; p[4 * q + 1] += yk * w.y; p[4 * q + 2] += yk * w.z; p[4 * q + 3] += yk * w.w; }
        }
    float a8[8], a4[4], a2[2], a1;
    { const bool hi = (lane & 32) != 0;
#pragma unroll
      for (int i = 0; i < 8; ++i) { const float snd = hi ? p[i] : p[i + 8], kp = hi ? p[i + 8] : p[i]; a8[i] = kp + shx(snd, 32, lane); } }
    { const bool hi = (lane & 16) != 0;
#pragma unroll
      for (int i = 0; i < 4; ++i) { const float snd = hi ? a8[i] : a8[i + 4], kp = hi ? a8[i + 4] : a8[i]; a4[i] = kp + shx(snd, 16, lane); } }
    { const bool hi = (lane & 8) != 0;
#pragma unroll
      for (int i = 0; i < 2; ++i) { const float snd = hi ? a4[i] : a4[i + 2], kp = hi ? a4[i + 2] : a4[i]; a2[i] = kp + shx(snd, 8, lane); } }
    { const bool hi = (lane & 4) != 0; const float snd = hi ? a2[0] : a2[1], kp = hi ? a2[1] : a2[0]; a1 = kp + shx(snd, 4, lane); }
    a1 += shx(a1, 1, lane); a1 += shx(a1, 2, lane);
    const int gi = ((lane >> 5) & 1) * 8 + ((lane >> 4) & 1) * 4 + ((lane >> 3) & 1) * 2 + ((lane >> 2) & 1);
    if ((lane & 3) == 0) grow[gi] = a1 + gb[gi];
}

__device__ __forceinline__ float gelu_tanh(float x) {
    const float u = 0.7978845608028654f * (x + 0.044715f * x * x * x);
    const float e = __expf(2.f * u);
    const float th = 1.f - 2.f / (1.f + e);
    return 0.5f * x * (1.f + th);
}
__device__ __forceinline__ float sigmoidf_(float x) { return 1.f / (1.f + __expf(-x)); }
__device__ __forceinline__ float log_sigmoid(float x) { return fminf(x, 0.f) - log1pf(__expf(-fabsf(x))); }


typedef short s16x4 __attribute__((ext_vector_type(4)));
typedef float f32x16 __attribute__((ext_vector_type(16)));
typedef float f32x2_t __attribute__((ext_vector_type(2))); typedef __bf16 bf16x2_t __attribute__((ext_vector_type(2)));
__device__ __forceinline__ unsigned cvtpk(float lo, float hi) { f32x2_t v = {lo, hi}; bf16x2_t b = __builtin_convertvector(v, bf16x2_t); return __builtin_bit_cast(unsigned, b); }
__device__ __forceinline__ s16x4 vtr(const LAS unsigned char* p) { return __builtin_bit_cast(s16x4, __builtin_amdgcn_ds_read_tr16_b64_v4i16((LAS s16x4*)p)); }
#define MFMA32(a, b, c) __builtin_amdgcn_mfma_f32_32x32x16_bf16((a), (b), (c), 0, 0, 0)
__device__ __forceinline__ bf16x8 pack8(const f32x16& x, int s8) {
    v4u p; p.x = cvtpk(x[s8 + 0], x[s8 + 1]); p.y = cvtpk(x[s8 + 2], x[s8 + 3]); p.z = cvtpk(x[s8 + 4], x[s8 + 5]); p.w = cvtpk(x[s8 + 6], x[s8 + 7]);
    return __builtin_bit_cast(bf16x8, p);
}
__device__ __forceinline__ void attn_task(const bf16* base, bf16* obase, int ostride, float* lsep, int br, int ti, LAS unsigned char* wl, int lane) {
    const int r_l = lane & 31, hh = lane >> 5;
    int r, rho, a, nsub;
    if (br == 0) { r = 1; rho = 0; a = ti; nsub = 2048; } else if (br == 1) { r = 4; rho = ti >> 4; a = ti & 15; nsub = 512; } else { r = 16; rho = ti >> 2; a = ti & 3; nsub = 128; }
    const int q0 = 32 * a;
    bf16x8 qf[4];
    { const bf16* qrow = base + (size_t)(rho + r * (q0 + r_l)) * NPROJ + 8 * hh;
#pragma unroll
      for (int s = 0; s < 4; ++s) qf[s] = *(const GAS bf16x8*)(qrow + 16 * s); }
    f32x16 S[5];
    float mx = -1e30f;
#pragma unroll
    for (int kt = 0; kt < 5; ++kt) {
        const int ks0 = q0 - 64 + 32 * kt;
        if (ks0 + 32 <= 0 || ks0 >= nsub) {
#pragma unroll
            for (int reg = 0; reg < 16; ++reg) S[kt][reg] = -1e30f;
        } else {
            const int kr = min(max(ks0 + r_l, 0), nsub - 1);
            const bf16* krow = base + (size_t)(rho + r * kr) * NPROJ + 512 + 8 * hh;
            bf16x8 kf[4];
#pragma unroll
            for (int s = 0; s < 4; ++s) kf[s] = *(const GAS bf16x8*)(krow + 16 * s);
            f32x16 acc;
#pragma unroll
            for (int reg = 0; reg < 16; ++reg) acc[reg] = 0.f;
#pragma unroll
            for (int s = 0; s < 4; ++s) acc = MFMA32(kf[s], qf[s], acc);
            const int kb = ks0 + 4 * hh, dq = kb - (q0 + r_l);
#pragma unroll
            for (int reg = 0; reg < 16; ++reg) {
                const int cr = (reg & 3) + 8 * (reg >> 2); const int d = dq + cr, ks = kb + cr;
                const bool ok = (d >= -64) && (d <= 64) && (ks >= 0) && (ks < nsub);
                const float v = ok ? acc[reg] : -1e30f; acc[reg] = v; mx = fmaxf(mx, v);
            }
            S[kt] = acc;
        }
    }
    mx = fmaxf(mx, shx(mx, 32, lane));
    float l = 0.f;
#pragma unroll
    for (int kt = 0; kt < 5; ++kt)
#pragma unroll
        for (int reg = 0; reg < 16; ++reg) { const float p = __expf(S[kt][reg] - mx); S[kt][reg] = p; l += p; }
    l += shx(l, 32, lane);
    f32x16 O0, O1;
#pragma unroll
    for (int reg = 0; reg < 16; ++reg) { O0[reg] = 0.f; O1[reg] = 0.f; }
    const int rowi = lane >> 3, chv = lane & 7, blk = (lane >> 4) & 1, qq = (lane & 15) >> 2, pp = lane & 3;
#pragma unroll
    for (int kt = 0; kt < 5; ++kt) {
        const int ks0 = q0 - 64 + 32 * kt;
        if (ks0 + 32 <= 0 || ks0 >= nsub) continue;
        v4u vv[4];
#pragma unroll
        for (int i = 0; i < 4; ++i) { const int kr = min(max(ks0 + 8 * i + rowi, 0), nsub - 1); vv[i] = *(const GAS v4u*)(base + (size_t)(rho + r * kr) * NPROJ + 1024 + 8 * chv); }
#pragma unroll
        for (int i = 0; i < 4; ++i) { const int row = 8 * i + rowi; *(LAS v4u*)(wl + 128 * row + 16 * (chv ^ (((row >> 1) & 1) << 2))) = vv[i]; }
#pragma unroll
        for (int s = 0; s < 2; ++s) {
            const bf16x8 A = pack8(S[kt], 8 * s);
            const int row0 = 16 * s + 4 * hh + qq, sw = ((row0 >> 1) & 1) << 2;
#pragma unroll
            for (int c = 0; c < 2; ++c) {
                const int ch = (4 * c + 2 * blk + (pp >> 1)) ^ sw;
                const LAS unsigned char* p0 = wl + 128 * row0 + 16 * ch + 8 * (pp & 1);
                const s16x4 lo = vtr(p0), hi = vtr(p0 + 8 * 128);
                const bf16x8 B = __builtin_shufflevector(lo, hi, 0, 1, 2, 3, 4, 5, 6, 7);
                if (c == 0) O0 = MFMA32(A, B, O0); else O1 = MFMA32(A, B, O1);
            }
        }
    }
    LAS float* lb = (LAS float*)(wl + 4096);
    if (lane < 32) lb[lane] = 1.f / l;
    f32x4 li4[4];
#pragma unroll
    for (int g = 0; g < 4; ++g) li4[g] = *(const LAS f32x4*)(lb + 4 * hh + 8 * g);
#pragma unroll
    for (int reg = 0; reg < 16; ++reg) {
        const float sc = li4[reg >> 2][reg & 3]; const int qs = q0 + (reg & 3) + 8 * (reg >> 2) + 4 * hh;
        bf16* orow = obase + (size_t)(rho + r * qs) * ostride;
        orow[r_l] = (bf16)f2bf(O0[reg] * sc); orow[32 + r_l] = (bf16)f2bf(O1[reg] * sc);
    }
    if (lane < 32) lsep[(size_t)(rho + r * (q0 + lane)) * 8] = mx + __logf(l);
}


constexpr int ML_Q = 0, ML_K = 32768, ML_V = 65536, ML_C = 98304, ML_VEC = 131584;
enum { MV_RT = 0, MV_A, MV_G, MV_EMT, MV_WEXP, MV_QN, MV_N, MV_HSC, MV_GSC, MV_SCAL, MV_COUNT };
static_assert(ML_VEC + 512 * MV_COUNT <= LDS_BYTES, "mLSTM LDS map");
__device__ __forceinline__ int xsw(int row) { return ((row & 3) << 2) | ((row >> 2) & 3); }
__device__ __forceinline__ bf16x8 ml_rowfrag(const LAS unsigned char* img, int rowbase, int ks, int r_l, int hh, int xr) {
    return *(const LAS bf16x8*)(img + 256 * (rowbase + r_l) + 16 * ((2 * ks + hh) ^ xr));
}
template <bool PERM> __device__ __forceinline__ bf16x8 ml_trfrag(const LAS unsigned char* img, int rowbase, int c, int hh, int blk, int qq, int pp) {
    const int chb = 4 * c + 2 * blk + (pp >> 1);
    const int r0 = rowbase + (PERM ? 4 * hh : 8 * hh) + qq, r1 = r0 + (PERM ? 8 : 4);
    const int x0 = (qq << 2) | ((PERM ? hh : 2 * hh) & 3), x1 = (qq << 2) | ((PERM ? 2 + hh : 2 * hh + 1) & 3);
    const s16x4 lo = vtr(img + 256 * r0 + 16 * (chb ^ x0) + 8 * (pp & 1)), hi = vtr(img + 256 * r1 + 16 * (chb ^ x1) + 8 * (pp & 1));
    return __builtin_shufflevector(lo, hi, 0, 1, 2, 3, 4, 5, 6, 7);
}

__device__ __forceinline__ void mlstm_scan(LAS unsigned char* lds, const bf16* QK  , const bf16* PROJ, const float* GATES, bf16* Hout  ,
                                           int b, int h, int dir, int tid) {
    const int lane = tid & 63, wave = __builtin_amdgcn_readfirstlane(tid >> 6), tt = wave >> 1, fh = wave & 1;
    const int r_l = lane & 31, hh = lane >> 5, blk = (lane >> 4) & 1, qq = (lane & 15) >> 2, pp = lane & 3, xr = xsw(r_l);
    const float scale = 0.08838834764831845f;
    LAS float* vec = (LAS float*)(lds + ML_VEC);
    for (int i = tid; i < 32768 / 16; i += NTHR) *(LAS v4u*)(lds + ML_C + 16 * i) = (v4u){0u, 0u, 0u, 0u};
    if (tid < 128) vec[MV_N * 128 + tid] = 0.f;
    f32x16 C0, C1;
#pragma unroll
    for (int i = 0; i < 16; ++i) { C0[i] = 0.f; C1[i] = 0.f; }
    float mst = 0.f;
    const int lrow = tid >> 4, lch = tid & 15;
#pragma unroll 1
    for (int cs = 0; cs < SEQ / 128; ++cs) {
        {
            v4u tq[4], tk[4], tv[4];
#pragma unroll
            for (int k4 = 0; k4 < 4; ++k4) {
                const int t = lrow + 32 * k4, sg = 128 * cs + t, pos = dir ? (SEQ - 1 - sg) : sg; const size_t m = (size_t)b * SEQ + pos;
                tq[k4] = *(const GAS v4u*)(QK + m * 1024 + h * 128 + 8 * lch);
                tk[k4] = *(const GAS v4u*)(QK + m * 1024 + 512 + h * 128 + 8 * lch);
                tv[k4] = *(const GAS v4u*)(PROJ + m * NPROJ + 2560 + h * 128 + 8 * lch);
            }
#pragma unroll
            for (int k4 = 0; k4 < 4; ++k4) {
                const int t = lrow + 32 * k4, o = 256 * t + 16 * (lch ^ xsw(t));
                *(LAS v4u*)(lds + ML_Q + o) = tq[k4]; *(LAS v4u*)(lds + ML_K + o) = tk[k4]; *(LAS v4u*)(lds + ML_V + o) = tv[k4];
            }
        }
        __syncthreads();
        if (wave == 0) {
            const int t0 = 2 * lane;
            float li0, li1, lf0, lf1;
            { const int sg = 128 * cs + t0, p0 = dir ? (SEQ - 1 - sg) : sg, p1 = dir ? (p0 - 1) : (p0 + 1);
              const float* g0 = GATES + ((size_t)b * SEQ + p0) * 16 + (2 * dir) * 4 + h; const float* g1 = GATES + ((size_t)b * SEQ + p1) * 16 + (2 * dir) * 4 + h;
              li0 = g0[0]; lf0 = log_sigmoid(g0[4]); li1 = g1[0]; lf1 = log_sigmoid(g1[4]); }
            const float ps = lf0 + lf1; float inc = ps;
#pragma unroll
            for (int d = 1; d < 64; d <<= 1) { const float o = shup(inc, d, lane); if (lane >= d) inc += o; }
            const float bc1 = inc, bc0 = inc - lf1;
            const float a0 = li0 - bc0, a1 = li1 - bc1;
            const float pm = fmaxf(a0, a1); float im = pm;
#pragma unroll
            for (int d = 1; d < 64; d <<= 1) { const float o = shup(im, d, lane); if (lane >= d) im = fmaxf(im, o); }
            float em = shup(im, 1, lane); if (lane == 0) em = -3.0e38f;
            const float cm0 = fmaxf(em, a0), cm1 = im;
            const float mt0 = fmaxf(bc0 + mst, bc0 + cm0), mt1 = fmaxf(bc1 + mst, bc1 + cm1);
            const float blast = rdlane(inc, 63), cref = rdlane(im, 63);
            const float mnew = fmaxf(blast + mst, blast + cref);
            vec[MV_RT * 128 + t0] = bc0 - mt0; vec[MV_RT * 128 + t0 + 1] = bc1 - mt1;
            vec[MV_A * 128 + t0] = a0; vec[MV_A * 128 + t0 + 1] = a1;
            vec[MV_G * 128 + t0] = __expf(bc0 + mst - mt0); vec[MV_G * 128 + t0 + 1] = __expf(bc1 + mst - mt1);
            vec[MV_EMT * 128 + t0] = __expf(-mt0); vec[MV_EMT * 128 + t0 + 1] = __expf(-mt1);
            vec[MV_WEXP * 128 + t0] = __expf(blast + a0 - mnew); vec[MV_WEXP * 128 + t0 + 1] = __expf(blast + a1 - mnew);
            if (lane == 0) vec[MV_SCAL * 128] = __expf(blast + mst - mnew);
            mst = mnew;
        } else if (wave == 2 || wave == 3) {
            const int t = tid - 128, xt = xsw(t);
            float s = 0.f;
#pragma unroll 4
            for (int ch = 0; ch < 16; ++ch) {
                const v4u qv = *(const LAS v4u*)(lds + ML_Q + 256 * t + 16 * (ch ^ xt));
                const f32x4 n0 = *(const LAS f32x4*)(vec + MV_N * 128 + 8 * ch), n1 = *(const LAS f32x4*)(vec + MV_N * 128 + 8 * ch + 4);
                s += bflo(qv.x) * n0.x + bfhi(qv.x) * n0.y + bflo(qv.y) * n0.z + bfhi(qv.y) * n0.w + bflo(qv.z) * n1.x + bfhi(qv.z) * n1.y + bflo(qv.w) * n1.z + bfhi(qv.w) * n1.w;
            }
            vec[MV_QN * 128 + t] = s;
        }
        __syncthreads();
        {
            bf16x8 qf[8];
            { const int ln_ = lndv(lane); const int r_l = ln_ & 31, hh = ln_ >> 5, blk = (ln_ >> 4) & 1, qq = (ln_ & 15) >> 2, pp = ln_ & 3, xr = xsw(r_l); (void)blk; (void)qq; (void)pp; (void)xr; (void)hh;
#pragma unroll
            for (int ks = 0; ks < 8; ++ks) qf[ks] = ml_rowfrag(lds + ML_Q, 32 * tt, ks, r_l, hh, xr); }
            f32x16 N0, N1;
#pragma unroll
            for (int i = 0; i < 16; ++i) { N0[i] = 0.f; N1[i] = 0.f; }
            float den = 0.f;
            const float rt = vec[MV_RT * 128 + 32 * tt + r_l];
#pragma unroll
            for (int st = 0; st < 4; ++st) {
                if (st <= tt) {
                    const int ln_ = lndv(lane); const int r_l = ln_ & 31, hh = ln_ >> 5, blk = (ln_ >> 4) & 1, qq = (ln_ & 15) >> 2, pp = ln_ & 3, xr = xsw(r_l); (void)blk; (void)qq; (void)pp; (void)xr; (void)hh;
                    f32x16 acc;
#pragma unroll
                    for (int i = 0; i < 16; ++i) acc[i] = 0.f;
#pragma unroll
                    for (int ks = 0; ks < 8; ++ks) acc = MFMA32(ml_rowfrag(lds + ML_K, 32 * st, ks, r_l, hh, xr), qf[ks], acc);
                    f32x4 av[4];
#pragma unroll
                    for (int g = 0; g < 4; ++g) av[g] = *(const LAS f32x4*)(vec + MV_A * 128 + 32 * st + 4 * hh + 8 * g);
#pragma unroll
                    for (int reg = 0; reg < 16; ++reg) {
                        const int cr = (reg & 3) + 8 * (reg >> 2) + 4 * hh;
                        const bool ok = (st < tt) || (cr <= r_l);
                        const float p = ok ? acc[reg] * scale * __expf(rt + av[reg >> 2][reg & 3]) : 0.f;
                        acc[reg] = p; den += p;
                    }
#pragma unroll
                    for (int s2 = 0; s2 < 2; ++s2) {
                        const bf16x8 A = pack8(acc, 8 * s2);
                        N0 = MFMA32(A, ml_trfrag<true>(lds + ML_V, 32 * st + 16 * s2, 2 * fh + 0, hh, blk, qq, pp), N0);
                        N1 = MFMA32(A, ml_trfrag<true>(lds + ML_V, 32 * st + 16 * s2, 2 * fh + 1, hh, blk, qq, pp), N1);
                    }
                }
            }
            den += shx(den, 32, lane);
            f32x16 Q0, Q1;
#pragma unroll
            for (int i = 0; i < 16; ++i) { Q0[i] = 0.f; Q1[i] = 0.f; }
            { LAS unsigned char* lq = lds + ML_Q; asm volatile("" : "+v"(lq)); const int ln_ = lndv(lane); const int r_l = ln_ & 31, hh = ln_ >> 5, blk = (ln_ >> 4) & 1, qq = (ln_ & 15) >> 2, pp = ln_ & 3, xr = xsw(r_l); (void)blk; (void)qq; (void)pp; (void)xr; (void)hh;
#pragma unroll
            for (int ks = 0; ks < 8; ++ks) {
                const bf16x8 qa = ml_rowfrag(lq, 32 * tt, ks, r_l, hh, xr);
                Q0 = MFMA32(qa, ml_rowfrag(lds + ML_C, 32 * (2 * fh + 0), ks, r_l, hh, xr), Q0);
                Q1 = MFMA32(qa, ml_rowfrag(lds + ML_C, 32 * (2 * fh + 1), ks, r_l, hh, xr), Q1);
            } }
            {
                const int t = 32 * tt + r_l;
                const float gs = vec[MV_G * 128 + t] * scale;
                const float dn = den + gs * vec[MV_QN * 128 + t];
                const float inv = 1.f / fmaxf(fabsf(dn), vec[MV_EMT * 128 + t]);
                vec[MV_HSC * 128 + t] = inv; vec[MV_GSC * 128 + t] = gs * inv;
            }
            f32x4 hs4[4], gs4[4];
#pragma unroll
            for (int g = 0; g < 4; ++g) { hs4[g] = *(const LAS f32x4*)(vec + MV_HSC * 128 + 32 * tt + 4 * hh + 8 * g); gs4[g] = *(const LAS f32x4*)(vec + MV_GSC * 128 + 32 * tt + 4 * hh + 8 * g); }
#pragma unroll
            for (int reg = 0; reg < 16; ++reg) {
                const int t = 32 * tt + (reg & 3) + 8 * (reg >> 2) + 4 * hh, sg = 128 * cs + t, pos = dir ? (SEQ - 1 - sg) : sg;
                bf16* orow = Hout + ((size_t)b * SEQ + pos) * MW + h * 128 + 64 * fh + r_l;
                const float hsv = hs4[reg >> 2][reg & 3], gsv = gs4[reg >> 2][reg & 3];
                orow[0] = (bf16)f2bf(N0[reg] * hsv + Q0[reg] * gsv); orow[32] = (bf16)f2bf(N1[reg] * hsv + Q1[reg] * gsv);
            }
        }
        float newn;
        {
            const float decay = vec[MV_SCAL * 128];
#pragma unroll
            for (int i = 0; i < 16; ++i) { C0[i] *= decay; C1[i] *= decay; }
            float nsum = 0.f;
#pragma unroll
            for (int ks = 0; ks < 8; ++ks) {
                const int ln_ = lndv(lane); const int r_l = ln_ & 31, hh = ln_ >> 5, blk = (ln_ >> 4) & 1, qq = (ln_ & 15) >> 2, pp = ln_ & 3, xr = xsw(r_l); (void)blk; (void)qq; (void)pp; (void)xr; (void)hh;
                const bf16x8 kr = ml_trfrag<false>(lds + ML_K, 16 * ks, tt, hh, blk, qq, pp);
                const f32x4 w0 = *(const LAS f32x4*)(vec + MV_WEXP * 128 + 16 * ks + 8 * hh), w1 = *(const LAS f32x4*)(vec + MV_WEXP * 128 + 16 * ks + 8 * hh + 4);
                const v4u ku = __builtin_bit_cast(v4u, kr);
                const float e0 = bflo(ku.x) * w0.x, e1 = bfhi(ku.x) * w0.y, e2 = bflo(ku.y) * w0.z, e3 = bfhi(ku.y) * w0.w, e4 = bflo(ku.z) * w1.x, e5 = bfhi(ku.z) * w1.y, e6 = bflo(ku.w) * w1.z, e7 = bfhi(ku.w) * w1.w;
                nsum += ((e0 + e1) + (e2 + e3)) + ((e4 + e5) + (e6 + e7));
                v4u au; au.x = cvtpk(e0, e1); au.y = cvtpk(e2, e3); au.z = cvtpk(e4, e5); au.w = cvtpk(e6, e7);
                const bf16x8 A = __builtin_bit_cast(bf16x8, au);
                C0 = MFMA32(A, ml_trfrag<false>(lds + ML_V, 16 * ks, 2 * fh + 0, hh, blk, qq, pp), C0);
                C1 = MFMA32(A, ml_trfrag<false>(lds + ML_V, 16 * ks, 2 * fh + 1, hh, blk, qq, pp), C1);
            }
            nsum += shx(nsum, 32, lane);
            newn = decay * vec[MV_N * 128 + 32 * tt + r_l] + nsum;
        }
        __syncthreads();
        {
            const int ln_ = lndv(lane); const int r_l = ln_ & 31, hh = ln_ >> 5, blk = (ln_ >> 4) & 1, qq = (ln_ & 15) >> 2, pp = ln_ & 3, xr = xsw(r_l); (void)blk; (void)qq; (void)pp; (void)xr; (void)hh;
            if (fh == 0 && lane < 32) vec[MV_N * 128 + 32 * tt + lane] = newn;
#pragma unroll
            for (int cl = 0; cl < 2; ++cl) {
                const int f = 32 * (2 * fh + cl) + r_l, xf = xsw(f);
#pragma unroll
                for (int g = 0; g < 4; ++g) {
                    const int e = 32 * tt + 8 * g + 4 * hh;
                    unsigned long long w;
                    if (cl == 0) w = (unsigned long long)cvtpk(C0[4 * g], C0[4 * g + 1]) | ((unsigned long long)cvtpk(C0[4 * g + 2], C0[4 * g + 3]) << 32);
                    else w = (unsigned long long)cvtpk(C1[4 * g], C1[4 * g + 1]) | ((unsigned long long)cvtpk(C1[4 * g + 2], C1[4 * g + 3]) << 32);
                    *(LAS unsigned long long*)(lds + ML_C + 256 * f + 16 * ((e >> 3) ^ xf) + 2 * (e & 7)) = w;
                }
            }
        }
    }
    __syncthreads();
}

#define PHASE_PTRS() const int tid = lndv((int)threadIdx.x), lane = tid & 63, wave = __builtin_amdgcn_readfirstlane(tid >> 6); const int gw = bid * NWAVES + wave, gt = bid * NTHR + tid; (void)lane; (void)gw; (void)gt; \
    Args a = a0; a.x = lnd(a.x); a.mix_pre_g = lnd(a.mix_pre_g); a.w_in = lnd(a.w_in); a.mconv_w = lnd(a.mconv_w); a.mconv_b = lnd(a.mconv_b); a.gate_b = lnd(a.gate_b); \
    a.head_g = lnd(a.head_g); a.w_out = lnd(a.w_out); a.mix_post_g = lnd(a.mix_post_g); a.ffn_pre_g = lnd(a.ffn_pre_g); a.w_up = lnd(a.w_up); a.fconv_w = lnd(a.fconv_w); a.fconv_b = lnd(a.fconv_b); \
    a.w_down = lnd(a.w_down); a.ffn_post_g = lnd(a.ffn_post_g); unsigned char* wsl = lnd(a.ws); \
    bf16* Win_t = (bf16*)(wsl + WS_WIN); bf16* Wout_t = (bf16*)(wsl + WS_WOUT); bf16* Wup_t = (bf16*)(wsl + WS_WUP); bf16* Wdn_t = (bf16*)(wsl + WS_WDN); \
    float* rope_c = (float*)(wsl + WS_ROPE); float* rope_s = rope_c + SEQ * 32; float* GATES = (float*)(wsl + WS_GATES); \
    bf16* HN = (bf16*)(wsl + WS_HN); bf16* PROJ = (bf16*)(wsl + WS_PROJ); bf16* HFB = (bf16*)(wsl + WS_HFB); bf16* HB16 = (bf16*)(wsl + WS_H); bf16* UB = (bf16*)(wsl + WS_U); \
    float* T = (float*)(wsl + WS_T); float* R = lnd(a.out); bf16* O1 = (bf16*)(wsl + WS_O1); float* LSE = (float*)(wsl + WS_LSE); (void)O1; (void)LSE; \
    (void)Win_t; (void)Wout_t; (void)Wup_t; (void)Wdn_t; (void)rope_c; (void)rope_s; (void)GATES; (void)HN; (void)PROJ; (void)HFB; (void)HB16; (void)UB; (void)T; (void)R;
__global__ void __launch_bounds__(NTHR, 2) hybrid_fwd(Args a0) {
    extern __shared__ __attribute__((aligned(16))) unsigned char lds_raw[];
    LAS unsigned char* lds = (LAS unsigned char*)lds_raw;
    volatile LAS unsigned* MISC = (volatile LAS unsigned*)(lds + MISC_OFF);
    const int tid = threadIdx.x, lane = tid & 63, wave = __builtin_amdgcn_readfirstlane(tid >> 6);
    const int G = gridDim.x, bid = blockIdx.x;
    unsigned char* ws = a0.ws;
    gu32* ctl = (gu32*)(ws + WS_CTL);
    for (int u = tid; u < (LDS_BYTES - LDSCTL_OFF) / 4; u += NTHR) ((LAS unsigned*)(lds + LDSCTL_OFF))[u] = 0u;
    __syncthreads();
    XcdBarrier bar = xcd_barrier_post((unsigned*)(ctl + CW_BAR), MISC + 8);
#define GRID_BAR() xcd_barrier(bar)
    const int gw = bid * NWAVES + wave, NGW = G * NWAVES;
    const int gt = bid * NTHR + tid, NGT = G * NTHR;


    {
            PHASE_PTRS();
        LAS float* scr = (LAS float*)(lds + wave * 16384);
        constexpr int I_IN = (DM / 64) * (NPROJ / 64), I_OUT = (DM / 64) * (DM / 64), I_UP = (DM / 64) * (NUP / 64), I_DN = (DFF / 64) * (DM / 64);
        constexpr int PER_L = I_IN + I_OUT + I_UP + I_DN;
        for (int it = gw; it < DEPTH * PER_L; it += NGW) {
            const int l = it / PER_L; int r = it % PER_L;
            if (r < I_IN) { transpose_item(a.w_in + (size_t)l * DM * PROJ_COLS, DM, PROJ_COLS, NPROJ, Win_t + (size_t)l * NPROJ * DM, scr, r, lane); continue; } r -= I_IN;
            if (r < I_OUT) { transpose_item(a.w_out + (size_t)l * DM * DM, DM, DM, DM, Wout_t + (size_t)l * DM * DM, scr, r, lane); continue; } r -= I_OUT;
            if (r < I_UP) { transpose_item<true>(a.w_up + (size_t)l * DM * NUP, DM, NUP, NUP, Wup_t + (size_t)l * NUP * DM, scr, r, lane); continue; } r -= I_UP;
            transpose_item(a.w_down + (size_t)l * DFF * DM, DFF, DM, DM, Wdn_t + (size_t)l * DM * DFF, scr, r, lane);
        }
        for (int i = gt; i < SEQ * 32; i += NGT) {
            const int pos = i >> 5, fi = i & 31;
            const float inv = powf(10000.0f, -(float)(2 * fi) / 64.0f);
            const float ang = (float)pos * inv;
            const double ad = (double)ang; const double kk = rint(ad * 0.15915494309189535); const float rr = (float)(ad - kk * 6.283185307179586);
            rope_c[i] = cosf(rr); rope_s[i] = sinf(rr);
        }
        if (gt < 512) ((GAS unsigned*)(wsl + WS_ZROW))[gt] = 0u;
    }
    __syncthreads();
    for (int l = 0; l < DEPTH; ++l) {
        if (l == 0) {
            PHASE_PTRS();
            const float* w_in_l = a.w_in + (size_t)l * DM * PROJ_COLS;
            LAS float* wg = (LAS float*)lds;
            gates_fill(wg, w_in_l, tid);
            __syncthreads();
            f32x4 g[4];
#pragma unroll
            for (int j = 0; j < 4; ++j) g[j] = ((const GAS f32x4*)(a.mix_pre_g + (size_t)l * DM))[lane + 64 * j];
            for (int m = gw; m < M; m += NGW) {
                f32x4 v[4];
#pragma unroll
                for (int j = 0; j < 4; ++j) v[j] = ((const GAS f32x4*)(a.x + (size_t)m * DM))[lane + 64 * j];
                rms_row(v, g, lane);
                store_row_bf16(HN + (size_t)m * DM, v, lane);
                gates_row(v, wg, a.gate_b + l * 16, GATES + (size_t)m * 16, lane);
            }
            __syncthreads();
        }
        if (l == 0) { cg::this_grid().sync(); } else { GRID_BAR(); }

        {
            PHASE_PTRS();
            pg8::Gemm g{HN, Win_t + (size_t)l * NPROJ * DM, M, NPROJ, DM}; pg8::StaticOrder S; S.init(M, NPROJ, G, bid);
            pg8::EpiBf16<0> E{PROJ, NPROJ, nullptr, 0, 0, 1.f};
            pg8::gemm_phase<pg8::EpiBf16<0>, pg8::StaticOrder, true, true>(lds, g, S, E);
        }
        GRID_BAR();
        {
            PHASE_PTRS();
            for (int i = gt; i < M * 64; i += NGT) {
                const int m = i >> 6, hs = (i >> 2) & 15, i8 = i & 3, pos = m & (SEQ - 1);
                bf16* p1 = PROJ + (size_t)m * NPROJ + hs * 64 + 8 * i8;
                const v4u a1 = *(const GAS v4u*)p1, a2 = *(const GAS v4u*)(p1 + 32);
                const f32x4 c0 = *(const GAS f32x4*)(rope_c + pos * 32 + 8 * i8), c1 = *(const GAS f32x4*)(rope_c + pos * 32 + 8 * i8 + 4);
                const f32x4 s0 = *(const GAS f32x4*)(rope_s + pos * 32 + 8 * i8), s1 = *(const GAS f32x4*)(rope_s + pos * 32 + 8 * i8 + 4);
                const float sc = hs < 8 ? 0.125f : 1.f;
                float t1[8] = {bflo(a1.x), bfhi(a1.x), bflo(a1.y), bfhi(a1.y), bflo(a1.z), bfhi(a1.z), bflo(a1.w), bfhi(a1.w)};
                float t2[8] = {bflo(a2.x), bfhi(a2.x), bflo(a2.y), bfhi(a2.y), bflo(a2.z), bfhi(a2.z), bflo(a2.w), bfhi(a2.w)};
                float cc[8] = {c0.x, c0.y, c0.z, c0.w, c1.x, c1.y, c1.z, c1.w}, ss[8] = {s0.x, s0.y, s0.z, s0.w, s1.x, s1.y, s1.z, s1.w};
                float o1[8], o2[8];
#pragma unroll
                for (int q = 0; q < 8; ++q) { o1[q] = (t1[q] * cc[q] - t2[q] * ss[q]) * sc; o2[q] = (t2[q] * cc[q] + t1[q] * ss[q]) * sc; }
                v4u w1, w2; w1.x = pk2(o1[0], o1[1]); w1.y = pk2(o1[2], o1[3]); w1.z = pk2(o1[4], o1[5]); w1.w = pk2(o1[6], o1[7]);
                w2.x = pk2(o2[0], o2[1]); w2.y = pk2(o2[2], o2[3]); w2.z = pk2(o2[4], o2[5]); w2.w = pk2(o2[6], o2[7]);
                *(GAS v4u*)p1 = w1; *(GAS v4u*)(p1 + 32) = w2;
            }
            const float* cw = a.mconv_w + (size_t)l * 5 * 1024; const float* cb = a.mconv_b + (size_t)l * 1024;
            for (int i = gt; i < M * 128; i += NGT) {
                const int m = i >> 7, c8 = (i & 127) * 8, pos = m & (SEQ - 1);
                float acc[8];
#pragma unroll
                for (int q = 0; q < 8; ++q) acc[q] = cb[c8 + q];
#pragma unroll
                for (int j = 0; j < 5; ++j) {
                    const int pp = pos + j - 2;
                    if (pp >= 0 && pp < SEQ) {
                        const v4u xv = *(const GAS v4u*)(PROJ + (size_t)(m + j - 2) * NPROJ + 1536 + c8);
                        const f32x4 w0 = *(const GAS f32x4*)(cw + j * 1024 + c8), w1 = *(const GAS f32x4*)(cw + j * 1024 + c8 + 4);
                        acc[0] += bflo(xv.x) * w0.x; acc[1] += bfhi(xv.x) * w0.y; acc[2] += bflo(xv.y) * w0.z; acc[3] += bfhi(xv.y) * w0.w;
                        acc[4] += bflo(xv.z) * w1.x; acc[5] += bfhi(xv.z) * w1.y; acc[6] += bflo(xv.w) * w1.z; acc[7] += bfhi(xv.w) * w1.w;
                    }
                }
#pragma unroll
                for (int q = 0; q < 8; ++q) acc[q] = acc[q] * sigmoidf_(acc[q]);
                v4u o; o.x = pk2(acc[0], acc[1]); o.y = pk2(acc[2], acc[3]); o.z = pk2(acc[4], acc[5]); o.w = pk2(acc[6], acc[7]);
                *(GAS v4u*)(HN + (size_t)m * 1024 + c8) = o;
            }
        }
        GRID_BAR();
        if (bid < 64) {
            PHASE_PTRS();
            const int b = bid >> 3, h = (bid >> 1) & 3, dir = bid & 1;
            mlstm_scan(lds, HN, PROJ, GATES, HFB + (size_t)dir * M * MW, b, h, dir, tid);
        } else {
            PHASE_PTRS();
            const int NWA = (G - 64) * NWAVES;
            LAS unsigned char* wl = lds + wave * 8192;
            for (int t = (bid - 64) * NWAVES + wave; t < BATCH * AH * 192; t += NWA) {
                const int bh = t / 192, rem = t % 192, br = rem >> 6, ti = rem & 63, b = bh >> 3, h = bh & 7;
                const bf16* base = PROJ + (size_t)b * SEQ * NPROJ + h * 64;
                bf16* obase; int ostride;
                if (br == 0) { obase = O1 + (size_t)b * SEQ * AW + h * 64; ostride = AW; }
                else { obase = PROJ + (size_t)b * SEQ * NPROJ + (br == 1 ? 1536 : 2048) + h * 64; ostride = NPROJ; }
                attn_task(base, obase, ostride, LSE + (size_t)br * M * 8 + (size_t)b * SEQ * 8 + h, br, ti, wl, lane);
            }
        }
        GRID_BAR();
        {
            PHASE_PTRS();
            const float* hg = a.head_g + (size_t)l * MW;
            for (int m = gw; m < M; m += NGW) {
                {
                    const v4u o1 = *(const GAS v4u*)(O1 + (size_t)m * AW + 8 * lane), o2 = *(const GAS v4u*)(PROJ + (size_t)m * NPROJ + 1536 + 8 * lane), o3 = *(const GAS v4u*)(PROJ + (size_t)m * NPROJ + 2048 + 8 * lane);
                    const float l1 = LSE[(size_t)m * 8 + (lane >> 3)], l2 = LSE[(size_t)M * 8 + (size_t)m * 8 + (lane >> 3)], l3 = LSE[(size_t)2 * M * 8 + (size_t)m * 8 + (lane >> 3)];
                    const float lm = fmaxf(l1, fmaxf(l2, l3));
                    float w1 = __expf(l1 - lm), w2 = __expf(l2 - lm), w3 = __expf(l3 - lm); const float wi = 1.f / (w1 + w2 + w3); w1 *= wi; w2 *= wi; w3 *= wi;
                    v4u w;
                    w.x = pk2(w1 * bflo(o1.x) + w2 * bflo(o2.x) + w3 * bflo(o3.x), w1 * bfhi(o1.x) + w2 * bfhi(o2.x) + w3 * bfhi(o3.x));
                    w.y = pk2(w1 * bflo(o1.y) + w2 * bflo(o2.y) + w3 * bflo(o3.y), w1 * bfhi(o1.y) + w2 * bfhi(o2.y) + w3 * bfhi(o3.y));
                    w.z = pk2(w1 * bflo(o1.z) + w2 * bflo(o2.z) + w3 * bflo(o3.z), w1 * bfhi(o1.z) + w2 * bfhi(o2.z) + w3 * bfhi(o3.z));
                    w.w = pk2(w1 * bflo(o1.w) + w2 * bflo(o2.w) + w3 * bflo(o3.w), w1 * bfhi(o1.w) + w2 * bfhi(o2.w) + w3 * bfhi(o3.w));
                    *(GAS v4u*)(HN + (size_t)m * 1024 + 8 * lane) = w;
                }
                const v4u hf = *(const GAS v4u*)(HFB + (size_t)m * MW + 8 * lane), hb = *(const GAS v4u*)(HFB + (size_t)M * MW + (size_t)m * MW + 8 * lane);
                const v4u mo = *(const GAS v4u*)(PROJ + (size_t)m * NPROJ + 3072 + 8 * lane);
                float hm[8] = {bflo(hf.x) + bflo(hb.x), bfhi(hf.x) + bfhi(hb.x), bflo(hf.y) + bflo(hb.y), bfhi(hf.y) + bfhi(hb.y),
                               bflo(hf.z) + bflo(hb.z), bfhi(hf.z) + bfhi(hb.z), bflo(hf.w) + bflo(hb.w), bfhi(hf.w) + bfhi(hb.w)};
                float ov[8] = {bflo(mo.x), bfhi(mo.x), bflo(mo.y), bfhi(mo.y), bflo(mo.z), bfhi(mo.z), bflo(mo.w), bfhi(mo.w)};
                float s = 0.f;
#pragma unroll
                for (int q = 0; q < 8; ++q) s += hm[q] * hm[q];
                s += shx(s, 1, lane); s += shx(s, 2, lane); s += shx(s, 4, lane); s += shx(s, 8, lane);
                const float rs = 1.0f / sqrtf(s * (1.f / 128.f) + EPS);
                const f32x4 g0 = *(const GAS f32x4*)(hg + 8 * lane), g1 = *(const GAS f32x4*)(hg + 8 * lane + 4);
                const float gg[8] = {g0.x, g0.y, g0.z, g0.w, g1.x, g1.y, g1.z, g1.w};
                float o[8];
#pragma unroll
                for (int q = 0; q < 8; ++q) o[q] = hm[q] * rs * gg[q] * sigmoidf_(ov[q]);
                v4u w; w.x = pk2(o[0], o[1]); w.y = pk2(o[2], o[3]); w.z = pk2(o[4], o[5]); w.w = pk2(o[6], o[7]);
                *(GAS v4u*)(HN + (size_t)m * 1024 + 512 + 8 * lane) = w;
            }
        }
        GRID_BAR();
        {
            PHASE_PTRS();
            pg8::Gemm g{HN, Wout_t + (size_t)l * DM * DM, M, DM, DM}; pg8::StaticOrder S; S.init(M, DM, G, bid);
            pg8::EpiF32 E{T, DM, nullptr};
            pg8::gemm_phase<pg8::EpiF32, pg8::StaticOrder, true, true>(lds, g, S, E);
        }
        GRID_BAR();
        {
            PHASE_PTRS();
            f32x4 g1[4], g2[4];
#pragma unroll
            for (int j = 0; j < 4; ++j) { g1[j] = ((const GAS f32x4*)(a.mix_post_g + (size_t)l * DM))[lane + 64 * j]; g2[j] = ((const GAS f32x4*)(a.ffn_pre_g + (size_t)l * DM))[lane + 64 * j]; }
            const float* xin = (l == 0) ? a.x : R;
            for (int m = gw; m < M; m += NGW) {
                f32x4 v[4], xb[4];
#pragma unroll
                for (int j = 0; j < 4; ++j) { v[j] = ((const GAS f32x4*)(T + (size_t)m * DM))[lane + 64 * j]; xb[j] = ((const GAS f32x4*)(xin + (size_t)m * DM))[lane + 64 * j]; }
                rms_row(v, g1, lane);
#pragma unroll
                for (int j = 0; j < 4; ++j) { v[j] = v[j] + xb[j]; ((GAS f32x4*)(R + (size_t)m * DM))[lane + 64 * j] = v[j]; }
                rms_row(v, g2, lane);
                store_row_bf16(HN + (size_t)m * DM, v, lane);
            }
        }
        GRID_BAR();
        {
            PHASE_PTRS();
            pg8::Gemm g{nullptr, Wup_t + (size_t)l * NUP * DM, 68 * 256, NUP, DM}; pg8::StaticOrder S; S.init(68 * 256, NUP, G, bid);
            pg8::EpiFfn E{HB16, a.fconv_w + (size_t)l * 3 * NUP, a.fconv_b + (size_t)l * NUP};
            pg8::AFfn AM{(const char*)(wsl + WS_ZROW), (unsigned)(WS_HN - WS_ZROW)};
            pg8::gemm_phase<pg8::EpiFfn, pg8::StaticOrder, true, true, pg8::AFfn>(lds, g, S, E, AM);
        }
        GRID_BAR();
        {
            PHASE_PTRS();
            pg8::Gemm g{HB16, Wdn_t + (size_t)l * DM * DFF, M, DM, DFF}; pg8::StaticOrder S; S.init(M, DM, G, bid);
            pg8::EpiF32 E{T, DM, nullptr};
            pg8::gemm_phase<pg8::EpiF32, pg8::StaticOrder, true, true>(lds, g, S, E);
        }
        GRID_BAR();
        {
            PHASE_PTRS();
            const bool more = (l + 1 < DEPTH);
            LAS float* wg = (LAS float*)lds;
            if (more) {
                const float* w_in_n = a.w_in + (size_t)(l + 1) * DM * PROJ_COLS;
                gates_fill(wg, w_in_n, tid);
                __syncthreads();
            }
            f32x4 g1[4], g2[4];
#pragma unroll
            for (int j = 0; j < 4; ++j) { g1[j] = ((const GAS f32x4*)(a.ffn_post_g + (size_t)l * DM))[lane + 64 * j];
                g2[j] = more ? ((const GAS f32x4*)(a.mix_pre_g + (size_t)(l + 1) * DM))[lane + 64 * j] : (f32x4){0.f, 0.f, 0.f, 0.f}; }
            for (int m = gw; m < M; m += NGW) {
                f32x4 v[4], xb[4];
#pragma unroll
                for (int j = 0; j < 4; ++j) { v[j] = ((const GAS f32x4*)(T + (size_t)m * DM))[lane + 64 * j]; xb[j] = ((const GAS f32x4*)(R + (size_t)m * DM))[lane + 64 * j]; }
                rms_row(v, g1, lane);
#pragma unroll
                for (int j = 0; j < 4; ++j) { v[j] = v[j] + xb[j]; ((GAS f32x4*)(R + (size_t)m * DM))[lane + 64 * j] = v[j]; }
                if (more) {
                    rms_row(v, g2, lane);
                    store_row_bf16(HN + (size_t)m * DM, v, lane);
                    gates_row(v, wg, a.gate_b + (l + 1) * 16, GATES + (size_t)m * 16, lane);
                }
            }
            __syncthreads();
        }
    }
}

extern "C" void kernel_launch(void* const* d_in, const int* in_sizes, int n_in, void* d_out, int out_size, void* d_ws, size_t ws_size, hipStream_t stream) {
    static int grid = 0;
    if (grid == 0) {
        if (n_in != 15 || in_sizes[0] != M * DM || out_size != M * DM || ws_size < WS_END) { fprintf(stderr, "kernel_launch: unexpected shapes n_in %d in0 %d out %d ws %zu\n", n_in, n_in > 0 ? in_sizes[0] : -1, out_size, ws_size); grid = -1; return; }
        int dev = 0, cus = 0, per_cu = 0;
        hipGetDevice(&dev); hipDeviceGetAttribute(&cus, hipDeviceAttributeMultiprocessorCount, dev);
        if (hipFuncSetAttribute((const void*)hybrid_fwd, hipFuncAttributeMaxDynamicSharedMemorySize, LDS_BYTES) != hipSuccess) { fprintf(stderr, "kernel_launch: hipFuncSetAttribute failed\n"); grid = -1; return; }
        if (hipOccupancyMaxActiveBlocksPerMultiprocessor(&per_cu, (const void*)hybrid_fwd, NTHR, LDS_BYTES) != hipSuccess || per_cu < 1) { fprintf(stderr, "kernel_launch: occupancy query says %d\n", per_cu); per_cu = 1; }
        (void)hipGetLastError();
        grid = cus;
        if (grid > 256) grid = 256;
    }
    if (grid < 0) return;
    if (hipMemsetAsync((char*)d_ws + WS_CTL, 0, CTL_ZERO_BYTES, stream) != hipSuccess) { fprintf(stderr, "kernel_launch: memset failed\n"); return; }
    Args a{};
    a.x = (const float*)d_in[0]; a.mix_pre_g = (const float*)d_in[1]; a.w_in = (const float*)d_in[2]; a.mconv_w = (const float*)d_in[3]; a.mconv_b = (const float*)d_in[4];
    a.gate_b = (const float*)d_in[5]; a.head_g = (const float*)d_in[6]; a.w_out = (const float*)d_in[7]; a.mix_post_g = (const float*)d_in[8]; a.ffn_pre_g = (const float*)d_in[9];
    a.w_up = (const float*)d_in[10]; a.fconv_w = (const float*)d_in[11]; a.fconv_b = (const float*)d_in[12]; a.w_down = (const float*)d_in[13]; a.ffn_post_g = (const float*)d_in[14];
    a.out = (float*)d_out; a.ws = (unsigned char*)d_ws;
    void* args[] = {&a};
    hipError_t e = hipLaunchCooperativeKernel((const void*)hybrid_fwd, dim3(grid), dim3(NTHR), args, LDS_BYTES, stream);
    if (e != hipSuccess) fprintf(stderr, "cooperative launch failed: %s (grid %d)\n", hipGetErrorString(e), grid);
}
```

```cpp
#include <hip/hip_runtime.h>
#include <hip/hip_cooperative_groups.h>
#include <cstdio>
#include <cstdint>
namespace cg = cooperative_groups;
namespace pg8 {
#define PG8_LAS __attribute__((address_space(3)))
typedef unsigned short bf16_t;
typedef short bf16x8 __attribute__((ext_vector_type(8)));
typedef float f32x4 __attribute__((ext_vector_type(4)));
typedef unsigned u32x4 __attribute__((ext_vector_type(4)));
constexpr int BM = 256, BK = 64, HALF = 128, HTB = HALF * BK * 2  , STAGE_BYTES = 8 * HTB, NXCD = 8, WGM = 8;

__host__ __device__ __forceinline__ int lds_byte(int r, int c) { const int st = (r >> 4) * 2 + (c >> 5), rr = r & 15, cc = c & 31, ob = rr * 64 + cc * 2; return st * 1024 + (ob ^ (((ob >> 9) & 1) << 5)); }
__host__ __device__ __forceinline__ void stage_rc(int b, int& R, int& C) { const int st = b / 1024, sb = b % 1024, swz = sb ^ (((sb >> 9) & 1) << 5); R = (st >> 1) * 16 + swz / 64; C = (st & 1) * 32 + (swz % 64) / 2; }
__host__ __device__ __forceinline__ int perm32(int rho) { const int n = rho >> 4, i = rho & 15; return 8 * (i >> 2) + 4 * n + (i & 3); }

struct Unit { int pm, pn; };
struct Gemm { const bf16_t* A; const bf16_t* Bt; int M, N, K; };

struct StaticOrder {
    int nM, nN, nwg, G, c;
    __host__ __device__ void init(int M, int N, int G_, int c_) { nM = M / BM; nN = N / BM; nwg = nM * nN; G = G_; c = c_; }
    __host__ __device__ bool next(int i, Unit& u) const {
        const long L = (long)i * G + c; if (L >= nwg) return false;
        int wgid = (int)L; { const int q = nwg / NXCD, r = nwg % NXCD, xcd = wgid % NXCD, off = wgid / NXCD; wgid = (xcd < r ? xcd * (q + 1) : r * (q + 1) + (xcd - r) * q) + off; }
        const int nig = WGM * nN, gid = wgid / nig, fm = gid * WGM, gsz = (nM - fm) < WGM ? (nM - fm) : WGM;
        u.pm = fm + ((wgid % nig) % gsz); u.pn = (wgid % nig) / gsz; return true;
    }
    __device__ __forceinline__ void a_ready(const Unit&) const {}
    __device__ __forceinline__ void done(const Unit&) const {}
};

__device__ __forceinline__ unsigned cvt_pk_bf16(float lo, float hi) { unsigned r; asm volatile("v_cvt_pk_bf16_f32 %0, %1, %2" : "=v"(r) : "v"(lo), "v"(hi)); return r; }
typedef float f32x2 __attribute__((ext_vector_type(2)));
__device__ __forceinline__ f32x2 gelu_pk(f32x2 v) {
    const f32x2 av = __builtin_elementwise_abs(v), d = av * 0.2316418882f + 1.0f;
    f32x2 t; t.x = __builtin_amdgcn_rcpf(d.x); t.y = __builtin_amdgcn_rcpf(d.y);
    f32x2 q = t * 0.5307027145f + (-0.7265760135f); q = q * t + 0.7107068705f; q = q * t + (-0.142248368f); q = q * t + 0.127414796f; q = q * t;
    const f32x2 s = (v * v) * (-0.72134752044f);
    f32x2 e; e.x = __builtin_amdgcn_exp2f(s.x); e.y = __builtin_amdgcn_exp2f(s.y);
    const f32x2 m = v * (q * e), r = v - m;
    f32x2 o; o.x = v.x < 0.f ? m.x : r.x; o.y = v.y < 0.f ? m.y : r.y; return o;
}

template <int ACT  > struct EpiBf16 {
    static constexpr bool PERM = true, AFTER_DRAIN = false; static_assert(ACT == 0 || ACT == 1, "EpiBf16: ACT is 0 (none) or 1 (gelu_pk)");
    bf16_t* O; int ldc; const float* bias; int split_cols; size_t split_stride; float scale0;
    __device__ __forceinline__ void operator()(const f32x4 (&acc)[2][2][4][2], const Unit& u, int wr, int wc, int fr, int fq) const {
        const int row0 = u.pm * BM + wr * 64 + fr; int colt = u.pn * BM; bf16_t* base = O;
        float sc = 1.f; if (split_cols) { const int t = colt / split_cols; base += (size_t)t * split_stride; colt -= t * split_cols; if (t == 0) sc = scale0; }
        const int col0 = colt + wc * 32 + 8 * fq, bcol0 = u.pn * BM + wc * 32 + 8 * fq;
        f32x4 bv[2][2];
#pragma unroll
        for (int bj = 0; bj < 2; ++bj)
#pragma unroll
            for (int n = 0; n < 2; ++n) bv[bj][n] = bias ? *(const f32x4*)(bias + bcol0 + bj * HALF + 4 * n) : (f32x4){0.f, 0.f, 0.f, 0.f};
#pragma unroll
        for (int ai = 0; ai < 2; ++ai)
#pragma unroll
            for (int m = 0; m < 4; ++m) { bf16_t* rowp = base + (size_t)(row0 + ai * HALF + m * 16) * ldc + col0;
#pragma unroll
                for (int bj = 0; bj < 2; ++bj) { f32x4 v0 = acc[ai][bj][m][0] + bv[bj][0], v1 = acc[ai][bj][m][1] + bv[bj][1];
                    if (ACT == 1) { f32x2 a = gelu_pk((f32x2){v0[0], v0[1]}), b = gelu_pk((f32x2){v0[2], v0[3]}), c = gelu_pk((f32x2){v1[0], v1[1]}), d = gelu_pk((f32x2){v1[2], v1[3]});
                        v0 = (f32x4){a.x, a.y, b.x, b.y}; v1 = (f32x4){c.x, c.y, d.x, d.y}; }
                    v0 = v0 * sc; v1 = v1 * sc; u32x4 w; w.x = cvt_pk_bf16(v0[0], v0[1]); w.y = cvt_pk_bf16(v0[2], v0[3]); w.z = cvt_pk_bf16(v1[0], v1[1]); w.w = cvt_pk_bf16(v1[2], v1[3]);
                    *(u32x4*)(rowp + bj * HALF) = w; } }
    }
};
struct EpiF32 {
    static constexpr bool PERM = false, AFTER_DRAIN = false;
    float* C; int ldc; const float* bias;
    __device__ __forceinline__ void operator()(const f32x4 (&acc)[2][2][4][2], const Unit& u, int wr, int wc, int fr, int fq) const {
        const int row0 = u.pm * BM + wr * 64 + fr, col0 = u.pn * BM + wc * 32 + 4 * fq;
        f32x4 bv[2][2];
#pragma unroll
        for (int bj = 0; bj < 2; ++bj)
#pragma unroll
            for (int n = 0; n < 2; ++n) bv[bj][n] = bias ? *(const f32x4*)(bias + col0 + bj * HALF + n * 16) : (f32x4){0.f, 0.f, 0.f, 0.f};
#pragma unroll
        for (int ai = 0; ai < 2; ++ai)
#pragma unroll
            for (int m = 0; m < 4; ++m) { float* rowp = C + (size_t)(row0 + ai * HALF + m * 16) * ldc + col0;
#pragma unroll
                for (int bj = 0; bj < 2; ++bj)
#pragma unroll
                    for (int n = 0; n < 2; ++n) *(f32x4*)(rowp + bj * HALF + n * 16) = acc[ai][bj][m][n] + bv[bj][n]; }
    }
};
__device__ __forceinline__ float gelu_tanh_f(float x) {
    const float u2 = 1.5957691216057308f * (x + 0.044715f * x * x * x);
    const float e = __expf(u2);
    return x - x / (1.f + e);
}
struct EpiFfn {
    static constexpr bool PERM = true, AFTER_DRAIN = false;
    bf16_t* H; const float* cw; const float* cb;
    __device__ __forceinline__ void operator()(const f32x4 (&acc)[2][2][4][2], const Unit& u, int wr, int wc, int fr, int fq) const {
        int lane = fq * 16 + fr; asm volatile("" : "+v"(lane));
        const int sg = 2 * u.pm + wr, b = sg / 17, j = sg - 17 * b;
        const int i0 = 8 * fr, tok0 = 126 * j - 1 + i0;
        const int colh = u.pn * 128 + wc * 32 + 8 * fq;
        int up = (lane - 1) << 2, dn = (lane + 1) << 2; asm volatile("" : "+v"(up), "+v"(dn));
        unsigned ow[8][2][2];
#pragma unroll
        for (int n = 0; n < 2; ++n) {
            const int c = colh + 4 * n;
            const f32x4 wg0 = *(const f32x4*)(cw + c), wg1 = *(const f32x4*)(cw + 5632 + c), wg2 = *(const f32x4*)(cw + 2 * 5632 + c), bg = *(const f32x4*)(cb + c);
            const f32x4 wv0 = *(const f32x4*)(cw + 2816 + c), wv1 = *(const f32x4*)(cw + 5632 + 2816 + c), wv2 = *(const f32x4*)(cw + 2 * 5632 + 2816 + c), bv = *(const f32x4*)(cb + 2816 + c);
            float hv[8][4];
#pragma unroll
            for (int k = 0; k < 4; ++k) {
                float ug[8], uv[8];
#pragma unroll
                for (int e = 0; e < 8; ++e) { ug[e] = acc[e >> 2][0][e & 3][n][k]; uv[e] = acc[e >> 2][1][e & 3][n][k]; }
                const float gp = __builtin_bit_cast(float, __builtin_amdgcn_ds_bpermute(up, __builtin_bit_cast(int, ug[7])));
                const float gn = __builtin_bit_cast(float, __builtin_amdgcn_ds_bpermute(dn, __builtin_bit_cast(int, ug[0])));
                const float vp = __builtin_bit_cast(float, __builtin_amdgcn_ds_bpermute(up, __builtin_bit_cast(int, uv[7])));
                const float vn = __builtin_bit_cast(float, __builtin_amdgcn_ds_bpermute(dn, __builtin_bit_cast(int, uv[0])));
#pragma unroll
                for (int e = 0; e < 8; ++e) {
                    const float gm = (e == 0) ? gp : ug[e > 0 ? e - 1 : 0], gq = (e == 7) ? gn : ug[e < 7 ? e + 1 : 7];
                    const float vm = (e == 0) ? vp : uv[e > 0 ? e - 1 : 0], vq = (e == 7) ? vn : uv[e < 7 ? e + 1 : 7];
                    const float gc = wg0[k] * gm + wg1[k] * ug[e] + wg2[k] * gq + bg[k], vc = wv0[k] * vm + wv1[k] * uv[e] + wv2[k] * vq + bv[k];
                    hv[e][k] = gelu_tanh_f(gc) * vc;
                }
            }
#pragma unroll
            for (int e = 0; e < 8; ++e) { ow[e][n][0] = cvt_pk_bf16(hv[e][0], hv[e][1]); ow[e][n][1] = cvt_pk_bf16(hv[e][2], hv[e][3]); }
        }
#pragma unroll
        for (int e = 0; e < 8; ++e) {
            const int i = i0 + e, tok = tok0 + e;
            if (i >= 1 && i <= 126 && tok < 2048) {
                u32x4 w; w.x = ow[e][0][0]; w.y = ow[e][0][1]; w.z = ow[e][1][0]; w.w = ow[e][1][1];
                *(u32x4*)(H + (size_t)(b * 2048 + tok) * 2816 + colh) = w;
            }
        }
    }
};
struct APlain { static constexpr bool GATHER = false; const char* base; __device__ __forceinline__ unsigned rowoff(int, int) const { return 0u; } };
struct AFfn { static constexpr bool GATHER = true; const char* base; unsigned hn_off;
    __device__ __forceinline__ unsigned rowoff(int pm, int R) const {
        const int ai = R >> 7, wr = (R >> 6) & 1, m = (R >> 4) & 3, fr = R & 15;
        const int sg = 2 * pm + wr, b = sg / 17, j = sg - 17 * b, tok = 126 * j - 1 + 8 * fr + 4 * ai + m;
        return (tok >= 0 && tok < 2048) ? hn_off + (unsigned)(b * 2048 + tok) * 2048u : 0u; } };
template <class Epi, class Sched, bool ALIGN_EPI = false, bool SP2 = false, class AMap = APlain>
__device__ __forceinline__ void gemm_phase(PG8_LAS unsigned char* lds, const Gemm g, const Sched& S, const Epi& E, const AMap AM = AMap{nullptr}) {
    static_assert(SP2 || !AMap::GATHER, "gathered A rows: SP2 path only");
    int tid_ = threadIdx.x; asm volatile("" : "+v"(tid_));
    const int tid = tid_, wid = __builtin_amdgcn_readfirstlane(tid >> 6), lane = tid & 63, wr = wid >> 2, wc = wid & 3, fr = lane & 15, fq = lane >> 4;
    const int K = g.K, nt = K / BK;
    unsigned voffA[2], voffB[2];
#pragma unroll
    for (int i = 0; i < 2; ++i) { int R, C; stage_rc(tid * 16 + i * 8192, R, C); const int Rb = Epi::PERM ? ((R & ~31) + perm32(R & 31)) : R;
        voffA[i] = (unsigned)(R * K + C) * 2u; voffB[i] = (unsigned)(Rb * K + C) * 2u; }
    const size_t kstep = (size_t)(BK * 2);
    const size_t hstep = (size_t)HALF * K * 2;
    const size_t tstep = 2 * hstep;
    const unsigned ldsw = (unsigned)wid * 1024u;
    const int aoff = lds_byte(wr * 64 + fr, fq * 8), boff = lds_byte(wc * 32 + fr, fq * 8);
#define PG8_SA(b, h) (((b) * 2 + (h)) * HTB)
#define PG8_SB(b, h) ((4 + (b) * 2 + (h)) * HTB)
#define PG8_STAGE(bufoff, gbase, voff) do { _Pragma("unroll") for (int _i = 0; _i < 2; ++_i) \
        __builtin_amdgcn_global_load_lds((const unsigned*)((const char*)(gbase) + (voff)[_i]), (PG8_LAS unsigned*)(lds + (bufoff) + ldsw + _i * 8192), 16, 0, 0); } while (0)
#define PG8_STAGE_A(bufoff, plainptr, kb, vg) do { if constexpr (AMap::GATHER) { PG8_STAGE(bufoff, AM.base + (kb), vg); } else { PG8_STAGE(bufoff, plainptr, voffA); } } while (0)
#define PG8_LDA(dst, b, h) do { _Pragma("unroll") for (int m = 0; m < 4; ++m) _Pragma("unroll") for (int k = 0; k < 2; ++k) dst[m][k] = *(const PG8_LAS bf16x8*)(lds + PG8_SA(b, h) + aoff + m * 2048 + k * 1024); } while (0)
#define PG8_LDB(dst, b, h) do { _Pragma("unroll") for (int n = 0; n < 2; ++n) _Pragma("unroll") for (int k = 0; k < 2; ++k) dst[n][k] = *(const PG8_LAS bf16x8*)(lds + PG8_SB(b, h) + boff + n * 2048 + k * 1024); } while (0)
#define PG8_MMA(ai, bj, At, Bt) do { __builtin_amdgcn_s_setprio(1); _Pragma("unroll") for (int m = 0; m < 4; ++m) _Pragma("unroll") for (int n = 0; n < 2; ++n) _Pragma("unroll") for (int k = 0; k < 2; ++k) \
        acc[ai][bj][m][n] = __builtin_amdgcn_mfma_f32_16x16x32_bf16(Bt[n][k], At[m][k], acc[ai][bj][m][n], 0, 0, 0); __builtin_amdgcn_s_setprio(0); } while (0)
#define PG8_WAIT_V(n) asm volatile("s_waitcnt vmcnt(" #n ")" ::: "memory")
#define PG8_WAIT_L(n) asm volatile("s_waitcnt lgkmcnt(" #n ")" ::: "memory")
#define PG8_BAR __builtin_amdgcn_s_barrier()
#define PG8_SCHED __builtin_amdgcn_sched_barrier(0)
    Unit cur, nxt; int ui = 0;
    if (!S.next(0, cur)) return;
    f32x4 acc[2][2][4][2];
#pragma unroll
    for (int a = 0; a < 2; ++a)
#pragma unroll
        for (int b = 0; b < 2; ++b)
#pragma unroll
            for (int m = 0; m < 4; ++m)
#pragma unroll
                for (int n = 0; n < 2; ++n) acc[a][b][m][n] = (f32x4){0.f, 0.f, 0.f, 0.f};
    bf16x8 At[4][2], B0[2][2], B1[2][2];
    const char* cA = (const char*)g.A + (size_t)cur.pm * tstep; const char* cB = (const char*)g.Bt + (size_t)cur.pn * tstep;
    S.a_ready(cur);
    unsigned vcur[2][2] = {{0u, 0u}, {0u, 0u}}, vnxt[2][2] = {{0u, 0u}, {0u, 0u}};
#define PG8_SETV(v, pm_) do { if constexpr (AMap::GATHER) { _Pragma("unroll") for (int h_ = 0; h_ < 2; ++h_) _Pragma("unroll") for (int i_ = 0; i_ < 2; ++i_) { int R_, C_; stage_rc(tid * 16 + i_ * 8192, R_, C_); v[h_][i_] = AM.rowoff(pm_, 128 * h_ + R_) + (unsigned)C_ * 2u; } } } while (0)
    PG8_SETV(vcur, cur.pm);
    if constexpr (SP2) {
        PG8_STAGE(PG8_SB(0, 0), cB, voffB); PG8_STAGE(PG8_SB(0, 1), cB + hstep, voffB); PG8_STAGE_A(PG8_SA(0, 0), cA, 0, vcur[0]); PG8_STAGE_A(PG8_SA(0, 1), cA + hstep, 0, vcur[1]);
        if (wr == 1) PG8_BAR;
        PG8_WAIT_V(2); PG8_BAR;
        PG8_STAGE(PG8_SB(1, 0), cB + kstep, voffB); PG8_STAGE_A(PG8_SA(1, 0), cA + kstep, kstep, vcur[0]); PG8_STAGE(PG8_SB(1, 1), cB + hstep + kstep, voffB);
        PG8_WAIT_V(6); PG8_BAR;
    } else {
        PG8_STAGE(PG8_SB(0, 0), cB, voffB); PG8_STAGE(PG8_SA(0, 0), cA, voffA); PG8_STAGE(PG8_SB(0, 1), cB + hstep, voffB); PG8_STAGE(PG8_SA(0, 1), cA + hstep, voffA);
        if (wr == 1) PG8_BAR;
        PG8_WAIT_V(4); PG8_BAR;
        PG8_STAGE(PG8_SB(1, 0), cB + kstep, voffB); PG8_STAGE(PG8_SA(1, 0), cA + kstep, voffA); PG8_STAGE(PG8_SB(1, 1), cB + hstep + kstep, voffB);
        PG8_WAIT_V(6); PG8_BAR;
    }
    for (;;) {
        const bool has_next = S.next(ui + 1, nxt);
        if (has_next) PG8_SETV(vnxt, nxt.pm);
        const char* nA = has_next ? (const char*)g.A + (size_t)nxt.pm * tstep : cA; const char* nB = has_next ? (const char*)g.Bt + (size_t)nxt.pn * tstep : cB;
        for (int t = 0; t < nt; t += 2) {
            const bool last = (t == nt - 2);
            const char* a1 = cA + (size_t)(t + 1) * kstep;
            const char* a2 = last ? nA : cA + (size_t)(t + 2) * kstep; const char* b2 = last ? nB : cB + (size_t)(t + 2) * kstep;
            const char* a3 = a2 + kstep; const char* b3 = b2 + kstep;
            if (last && has_next) S.a_ready(nxt);
            const size_t k1 = (size_t)(t + 1) * kstep, k2 = last ? (size_t)0 : (size_t)(t + 2) * kstep; const bool usen = last && has_next;
            unsigned vs[2][2];
#pragma unroll
            for (int h_ = 0; h_ < 2; ++h_)
#pragma unroll
                for (int i_ = 0; i_ < 2; ++i_) vs[h_][i_] = usen ? vnxt[h_][i_] : vcur[h_][i_];
            (void)k1; (void)k2;
            if constexpr (SP2) {
            PG8_LDB(B0, 0, 0); PG8_LDB(B1, 0, 1); PG8_SCHED; PG8_LDA(At, 0, 0); PG8_STAGE_A(PG8_SA(1, 1), a1 + hstep, k1, vcur[1]);
            PG8_WAIT_V(8); PG8_WAIT_L(0); PG8_BAR; PG8_MMA(0, 0, At, B0); PG8_MMA(0, 1, At, B1); PG8_BAR; PG8_SCHED;
            PG8_LDA(At, 0, 1); PG8_STAGE(PG8_SB(0, 0), b2, voffB); PG8_STAGE(PG8_SB(0, 1), b2 + hstep, voffB); PG8_STAGE_A(PG8_SA(0, 0), a2, k2, vs[0]);
            PG8_WAIT_V(8); PG8_WAIT_L(0); PG8_BAR; PG8_MMA(1, 0, At, B0); PG8_MMA(1, 1, At, B1); PG8_BAR; PG8_SCHED;
            PG8_LDB(B0, 1, 0); PG8_LDB(B1, 1, 1); PG8_SCHED; PG8_LDA(At, 1, 0); PG8_STAGE_A(PG8_SA(0, 1), a2 + hstep, k2, vs[1]);
            PG8_WAIT_V(8); PG8_WAIT_L(0); PG8_BAR; PG8_MMA(0, 0, At, B0); PG8_MMA(0, 1, At, B1); PG8_BAR; PG8_SCHED;
            PG8_LDA(At, 1, 1); PG8_STAGE(PG8_SB(1, 0), b3, voffB); PG8_STAGE(PG8_SB(1, 1), b3 + hstep, voffB); PG8_STAGE_A(PG8_SA(1, 0), a3, k2 + kstep, vs[0]);
            PG8_WAIT_V(8); PG8_WAIT_L(0); PG8_BAR; PG8_MMA(1, 0, At, B0); PG8_MMA(1, 1, At, B1); PG8_BAR; PG8_SCHED;
            } else {
            PG8_LDB(B0, 0, 0); PG8_SCHED; PG8_LDA(At, 0, 0); PG8_STAGE(PG8_SA(1, 1), a1 + hstep, voffA);
            PG8_WAIT_L(8); PG8_BAR; PG8_WAIT_L(0); PG8_MMA(0, 0, At, B0); PG8_BAR; PG8_SCHED;
            PG8_LDB(B1, 0, 1); PG8_STAGE(PG8_SB(0, 0), b2, voffB);
            PG8_BAR; PG8_WAIT_L(0); PG8_MMA(0, 1, At, B1); PG8_BAR;
            PG8_LDA(At, 0, 1); PG8_STAGE(PG8_SA(0, 0), a2, voffA);
            PG8_BAR; PG8_WAIT_L(0); PG8_MMA(1, 0, At, B0); PG8_BAR; PG8_SCHED;
            PG8_STAGE(PG8_SB(0, 1), b2 + hstep, voffB);
            PG8_WAIT_V(6); PG8_BAR; PG8_MMA(1, 1, At, B1); PG8_BAR;
            PG8_LDB(B0, 1, 0); PG8_SCHED; PG8_LDA(At, 1, 0); PG8_STAGE(PG8_SA(0, 1), a2 + hstep, voffA);
            PG8_WAIT_L(8); PG8_BAR; PG8_WAIT_L(0); PG8_MMA(0, 0, At, B0); PG8_BAR; PG8_SCHED;
            PG8_LDB(B1, 1, 1); PG8_STAGE(PG8_SB(1, 0), b3, voffB);
            PG8_BAR; PG8_WAIT_L(0); PG8_MMA(0, 1, At, B1); PG8_BAR;
            PG8_LDA(At, 1, 1); PG8_STAGE(PG8_SA(1, 0), a3, voffA);
            PG8_BAR; PG8_WAIT_L(0); PG8_MMA(1, 0, At, B0); PG8_BAR; PG8_SCHED;
            PG8_STAGE(PG8_SB(1, 1), b3 + hstep, voffB);
            PG8_WAIT_V(6); PG8_BAR; PG8_MMA(1, 1, At, B1); PG8_BAR;
            }
        }
        if constexpr (ALIGN_EPI) { if (wr == 0) PG8_BAR; }
        if constexpr (!Epi::AFTER_DRAIN) { E(acc, cur, wr, wc, fr, fq); S.done(cur); }
        if (!has_next) break;
#pragma unroll
        for (int a = 0; a < 2; ++a)
#pragma unroll
            for (int b = 0; b < 2; ++b)
#pragma unroll
                for (int m = 0; m < 4; ++m)
#pragma unroll
                    for (int n = 0; n < 2; ++n) acc[a][b][m][n] = (f32x4){0.f, 0.f, 0.f, 0.f};
        cur = nxt; cA = nA; cB = nB; ++ui;
#pragma unroll
        for (int h_ = 0; h_ < 2; ++h_)
#pragma unroll
            for (int i_ = 0; i_ < 2; ++i_) vcur[h_][i_] = vnxt[h_][i_];
        if constexpr (ALIGN_EPI) { if (wr == 1) PG8_BAR; }
    }
    PG8_WAIT_V(0);
    if constexpr (!ALIGN_EPI) { if (wr == 0) PG8_BAR; }
    PG8_BAR;
    if constexpr (Epi::AFTER_DRAIN) { E.fused(acc, cur, wr, wc, fr, fq, lds, wid, lane); S.done(cur); }
#undef PG8_SA
#undef PG8_SB
#undef PG8_STAGE
#undef PG8_STAGE_A
#undef PG8_SETV
#undef PG8_LDA
#undef PG8_LDB
#undef PG8_MMA
#undef PG8_WAIT_V
#undef PG8_WAIT_L
#undef PG8_BAR
#undef PG8_SCHED
}
}
#define GAS __attribute__((address_space(1)))
#define LAS __attribute__((address_space(3)))
typedef unsigned short bf16;
typedef unsigned v4u __attribute__((ext_vector_type(4)));
typedef float f32x4 __attribute__((ext_vector_type(4)));
typedef short bf16x8 __attribute__((ext_vector_type(8)));
typedef GAS unsigned gu32;
typedef GAS unsigned long long gu64;
#define RLX_AGENT __ATOMIC_RELAXED, __HIP_MEMORY_SCOPE_AGENT
#define LDS_WAIT() asm volatile("s_waitcnt lgkmcnt(0)" ::: "memory")
#define VM_WAIT() asm volatile("s_waitcnt vmcnt(0)" ::: "memory")
__device__ __forceinline__ unsigned long long rt() { return __builtin_amdgcn_s_memrealtime(); }
__device__ __forceinline__ unsigned f2bf(float f) { unsigned u = __builtin_bit_cast(unsigned, f); return (u + 0x7fffu + ((u >> 16) & 1u)) >> 16; }
__device__ __forceinline__ unsigned pk2(float lo, float hi) { return f2bf(lo) | (f2bf(hi) << 16); }

#define XB_TMO      128
#define XB_XCNT(j)  (256  + 64 * (j))
#define XB_XSUB(j)  (1280 + 64 * (j))
#define XB_XGEN(j)  (2304 + 64 * (j))
#define XB_TOP      3328
#define XB_TOPGEN   3392
#define XCD_BAR_WORDS 3456
#define XB_SPIN_CAP (1u << 18)

__device__ __forceinline__ unsigned xb_ld(unsigned* p)              { return __hip_atomic_load(p, __ATOMIC_RELAXED, __HIP_MEMORY_SCOPE_AGENT); }
__device__ __forceinline__ unsigned xb_add(unsigned* p, unsigned v) { return __hip_atomic_fetch_add(p, v, __ATOMIC_RELAXED, __HIP_MEMORY_SCOPE_AGENT); }
__device__ __forceinline__ unsigned xb_xcc_id() { return (unsigned)__builtin_amdgcn_s_getreg((3 << 11) | 20) & 0xFu; }
#define XB_SPIN(cond, bar) do { unsigned _sp = 0; while (cond) { __builtin_amdgcn_s_sleep(1); \
    if ((++_sp & 255u) == 0u) { if (xb_ld(&(bar)[XB_TMO])) break; if (_sp > XB_SPIN_CAP) { atomicAdd(&(bar)[XB_TMO], 1u); break; } } } } while (0)

struct XcdBarrier {
    unsigned* bar; unsigned x;
    volatile LAS unsigned* st;
};

__device__ __forceinline__ XcdBarrier xcd_barrier_post(unsigned* bar, volatile LAS unsigned* st) {
    XcdBarrier b; b.bar = bar; b.x = xb_xcc_id(); b.st = st;
    if (threadIdx.x == 0) (void)xb_add(&bar[XB_XCNT(b.x)], 1u);
    return b;
}
__device__ __forceinline__ void xcd_barrier_complete(unsigned* bar, unsigned x, unsigned& nloc, unsigned& nx) {
    const unsigned G = gridDim.x * gridDim.y * gridDim.z;
    unsigned sum, cnt, mine, sp = 0u;
    for (;;) {
        sum = 0u; cnt = 0u; mine = 0u;
#pragma unroll
        for (unsigned j = 0; j < 16; ++j) { const unsigned c = xb_ld(&bar[XB_XCNT(j)]); sum += c; cnt += (c > 0u) ? 1u : 0u; mine = (j == x) ? c : mine; }
        if (sum == G) break;
        __builtin_amdgcn_s_sleep(1);
        if ((++sp & 255u) == 0u) { if (xb_ld(&bar[XB_TMO])) break; if (sp > XB_SPIN_CAP) { atomicAdd(&bar[XB_TMO], 1u); break; } }
    }
    nloc = mine > 0u ? mine : 1u; nx = cnt > 0u ? cnt : 1u;
}

__device__ __forceinline__ void xcd_barrier(const XcdBarrier& b) {
    asm volatile("s_waitcnt vmcnt(0)" ::: "memory");
    __syncthreads();
    if (threadIdx.x == 0) {
        unsigned* bar = b.bar;
        __builtin_amdgcn_s_waitcnt(0);
        unsigned nloc = b.st[0], nx = b.st[1];
        if (nloc == 0u) { xcd_barrier_complete(bar, b.x, nloc, nx); b.st[0] = nloc; b.st[1] = nx; }
        const unsigned old = xb_add(&bar[XB_XSUB(b.x)], 1u);
        const unsigned gen = old / nloc;
        if (old + 1u == (gen + 1u) * nloc) {
            __builtin_amdgcn_fence(__ATOMIC_RELEASE, "agent");
            asm volatile("s_waitcnt vmcnt(0)" ::: "memory");
            const unsigned og = xb_add(&bar[XB_TOP], 1u);
            const unsigned tg = og / nx;
            if (og + 1u == (tg + 1u) * nx) xb_add(&bar[XB_TOPGEN], 1u);
            else XB_SPIN(xb_ld(&bar[XB_TOPGEN]) == tg, bar);
            __builtin_amdgcn_fence(__ATOMIC_ACQUIRE, "agent");
            xb_add(&bar[XB_XGEN(b.x)], 1u);
            asm volatile("s_waitcnt vmcnt(0)" ::: "memory");
        } else {
            XB_SPIN(xb_ld(&bar[XB_XGEN(b.x)]) == gen, bar);
            __builtin_amdgcn_fence(__ATOMIC_ACQUIRE, "agent");
            asm volatile("s_waitcnt vmcnt(0)" ::: "memory");
        }
    }
    __syncthreads();
}

constexpr int NWAVES = 8, NTHR = 512;
constexpr int BATCH = 8, SEQ = 2048, DM = 1024, M = BATCH * SEQ, DEPTH = 2;
constexpr int AW = 512, AH = 8, AD = 64;
constexpr int MW = 512, MH = 4, MD = 128;
constexpr int PROJ_COLS = 3600, NPROJ = 3584;
constexpr int DFF = 2816, NUP = 2 * DFF;
constexpr float EPS = 1e-6f;
constexpr size_t MiB = 1u << 20;
constexpr size_t WS_CTL = 0, CTL_ZERO_BYTES = 1 * MiB;
constexpr size_t WS_WIN = 1 * MiB;
constexpr size_t WS_WOUT = 15 * MiB;
constexpr size_t WS_WUP = 19 * MiB;
constexpr size_t WS_WDN = 41 * MiB;
constexpr size_t WS_ROPE = 52 * MiB;
constexpr size_t WS_GATES = 52 * MiB + 512 * 1024;
constexpr size_t WS_ZROW = 53 * MiB + 512 * 1024;
constexpr size_t WS_HN = 54 * MiB;
constexpr size_t WS_SCR = 86 * MiB;
constexpr size_t WS_PROJ = WS_SCR;
constexpr size_t WS_HFB = 198 * MiB;
constexpr size_t WS_H = WS_SCR;
constexpr size_t WS_U = 174 * MiB;
constexpr size_t WS_T = 174 * MiB;
constexpr size_t WS_O1 = 230 * MiB;
constexpr size_t WS_LSE = 246 * MiB;
constexpr size_t WS_NLOC = 248 * MiB;
constexpr size_t WS_SCAL = 248 * MiB + 512 * 1024;
constexpr size_t WS_MIN = WS_SCAL + 8192;
constexpr size_t WS_END = 256 * MiB;
constexpr int CW_BAR = 4096;
constexpr int RING_BYTES = 131072, LDSCTL_OFF = RING_BYTES, MISC_OFF = LDSCTL_OFF + 320, LDS_BYTES = 147456;

struct Args {
    const float* x; const float* mix_pre_g; const float* w_in; const float* mconv_w; const float* mconv_b; const float* gate_b; const float* head_g;
    const float* w_out; const float* mix_post_g; const float* ffn_pre_g; const float* w_up; const float* fconv_w; const float* fconv_b; const float* w_down; const float* ffn_post_g;
    float* out; unsigned char* ws;
};

__device__ __forceinline__ float shx(float v, int mask, int lane) { return __builtin_bit_cast(float, __builtin_amdgcn_ds_bpermute((lane ^ mask) << 2, __builtin_bit_cast(int, v))); }
__device__ __forceinline__ float shup(float v, int d, int lane) { return __builtin_bit_cast(float, __builtin_amdgcn_ds_bpermute((lane - d) << 2, __builtin_bit_cast(int, v))); }
__device__ __forceinline__ float rdlane(float v, int l) { return __builtin_bit_cast(float, __builtin_amdgcn_readlane(__builtin_bit_cast(int, v), l)); }
__device__ __forceinline__ float wave_sum(float v, int lane) {
#pragma unroll
    for (int o = 1; o < 64; o <<= 1) v += shx(v, o, lane);
    return v;
}
__device__ __forceinline__ int lndv(int v) { asm volatile("" : "+v"(v)); return v; }
template <class T> __device__ __forceinline__ T* lnd(T* p) { asm volatile("" : "+s"(p)); return p; }
__device__ __forceinline__ float bf2f(unsigned short b) { return __builtin_bit_cast(float, (unsigned)b << 16); }
__device__ __forceinline__ float bflo(unsigned w) { return __builtin_bit_cast(float, w << 16); }
__device__ __forceinline__ float bfhi(unsigned w) { return __builtin_bit_cast(float, w & 0xffff0000u); }

template <bool UPMAP = false> __device__ __forceinline__ void transpose_item(const float* W, int K, int ldw, int ncols, bf16* WT, LAS float* scr, int item, int lane) {
    const int nblk = ncols / 64, kb = item / nblk, nb = item % nblk, k0 = 64 * kb, n0 = 64 * nb;
    const int d0 = UPMAP ? (n0 < DFF ? 256 * (n0 >> 7) + (n0 & 127) : 256 * ((n0 - DFF) >> 7) + 128 + ((n0 - DFF) & 127)) : n0;
    f32x4 v[16];
    const int kr = lane >> 4, n4 = lane & 15;
#pragma unroll
    for (int i = 0; i < 16; ++i) v[i] = *(const GAS f32x4*)(W + (size_t)(k0 + 4 * i + kr) * ldw + n0 + 4 * n4);
#pragma unroll
    for (int i = 0; i < 16; ++i) { const int k = 4 * i + kr; *(LAS f32x4*)(scr + k * 64 + 4 * (n4 ^ ((k >> 3) & 7))) = v[i]; }
    LDS_WAIT(); asm volatile("" ::: "memory");
    const int nlo = lane & 3, kc = (lane >> 2) & 7, hf = lane >> 5;
#pragma unroll
    for (int j = 0; j < 8; ++j) {
        const int nhi = 2 * j + hf, n = 4 * nhi + nlo;
        const LAS float* s = scr + (8 * kc) * 64 + 4 * (nhi ^ kc) + nlo;
        v4u o; o.x = pk2(s[0 * 64], s[1 * 64]); o.y = pk2(s[2 * 64], s[3 * 64]); o.z = pk2(s[4 * 64], s[5 * 64]); o.w = pk2(s[6 * 64], s[7 * 64]);
        *(GAS v4u*)(WT + (size_t)(d0 + n) * K + k0 + 8 * kc) = o;
    }
    LDS_WAIT(); asm volatile("" ::: "memory");
}

__device__ __forceinline__ void rms_row(f32x4 (&v)[4], const f32x4 (&g)[4], int lane) {
    float s = 0.f;
#pragma unroll
    for (int j = 0; j < 4; ++j) s += (v[j].x * v[j].x + v[j].y * v[j].y) + (v[j].z * v[j].z + v[j].w * v[j].w);
    const float rs = 1.0f / sqrtf(wave_sum(s, lane) * (1.f / DM) + EPS);
#pragma unroll
    for (int j = 0; j < 4; ++j) v[j] = v[j] * rs * g[j];
}
__device__ __forceinline__ void store_row_bf16(bf16* orow, const f32x4 (&v)[4], int lane) {
    GAS unsigned long long* o8 = (GAS unsigned long long*)orow + lane;
#pragma unroll
    for (int j = 0; j < 4; ++j) o8[64 * j] = (unsigned long long)pk2(v[j].x, v[j].y) | ((unsigned long long)pk2(v[j].z, v[j].w) << 32);
}
__device__ __forceinline__ void gates_fill(LAS float* wg, const float* w_in_l, int tid) {
    for (int i = tid; i < DM * 16; i += NTHR) { const int k = i >> 4, q = i & 15, j = k >> 8, ln = (k >> 2) & 63, c = k & 3;
        wg[((4 * j + c) * 64 + ln) * 20 + q] = w_in_l[(size_t)k * PROJ_COLS + NPROJ + q]; }
}
__device__ __forceinline__ void gates_row(const f32x4 (&y)[4], const LAS float* wg, const float* gb, float* grow, int lane) {
    float p[16];
#pragma unroll
    for (int q = 0; q < 16; ++q) p[q] = 0.f;
#pragma unroll
    for (int j = 0; j < 4; ++j)
#pragma unroll
        for (int c = 0; c < 4; ++c) {
            const float yk = y[j][c];
            const LAS f32x4* w4 = (const LAS f32x4*)(wg + ((4 * j + c) * 64 + lane) * 20);
#pragma unroll
            for (int q = 0; q < 4; ++q) { const f32x4 w = w4[q]; p[4 * q + 0] += yk * w.x; p[4 * q + 1] += yk * w.y; p[4 * q + 2] += yk * w.z; p[4 * q + 3] += yk * w.w; }
        }
    float a8[8], a4[4], a2[2], a1;
    { const bool hi = (lane & 32) != 0;
#pragma unroll
      for (int i = 0; i < 8; ++i) { const float snd = hi ? p[i] : p[i + 8], kp = hi ? p[i + 8] : p[i]; a8[i] = kp + shx(snd, 32, lane); } }
    { const bool hi = (lane & 16) != 0;
#pragma unroll
      for (int i = 0; i < 4; ++i) { const float snd = hi ? a8[i] : a8[i + 4], kp = hi ? a8[i + 4] : a8[i]; a4[i] = kp + shx(snd, 16, lane); } }
    { const bool hi = (lane & 8) != 0;
#pragma unroll
      for (int i = 0; i < 2; ++i) { const float snd = hi ? a4[i] : a4[i + 2], kp = hi ? a4[i + 2] : a4[i]; a2[i] = kp + shx(snd, 8, lane); } }
    { const bool hi = (lane & 4) != 0; const float snd = hi ? a2[0] : a2[1], kp = hi ? a2[1] : a2[0]; a1 = kp + shx(snd, 4, lane); }
    a1 += shx(a1, 1, lane); a1 += shx(a1, 2, lane);
    const int gi = ((lane >> 5) & 1) * 8 + ((lane >> 4) & 1) * 4 + ((lane >> 3) & 1) * 2 + ((lane >> 2) & 1);
    if ((lane & 3) == 0) grow[gi] = a1 + gb[gi];
}

__device__ __forceinline__ float gelu_tanh(float x) {
    const float u = 0.7978845608028654f * (x + 0.044715f * x * x * x);
    const float e = __expf(2.f * u);
    const float th = 1.f - 2.f / (1.f + e);
    return 0.5f * x * (1.f + th);
}
__device__ __forceinline__ float sigmoidf_(float x) { return 1.f / (1.f + __expf(-x)); }
__device__ __forceinline__ float log_sigmoid(float x) { return fminf(x, 0.f) - log1pf(__expf(-fabsf(x))); }


typedef short s16x4 __attribute__((ext_vector_type(4)));
typedef float f32x16 __attribute__((ext_vector_type(16)));
typedef float f32x2_t __attribute__((ext_vector_type(2))); typedef __bf16 bf16x2_t __attribute__((ext_vector_type(2)));
__device__ __forceinline__ unsigned cvtpk(float lo, float hi) { f32x2_t v = {lo, hi}; bf16x2_t b = __builtin_convertvector(v, bf16x2_t); return __builtin_bit_cast(unsigned, b); }
__device__ __forceinline__ s16x4 vtr(const LAS unsigned char* p) { return __builtin_bit_cast(s16x4, __builtin_amdgcn_ds_read_tr16_b64_v4i16((LAS s16x4*)p)); }
#define MFMA32(a, b, c) __builtin_amdgcn_mfma_f32_32x32x16_bf16((a), (b), (c), 0, 0, 0)
__device__ __forceinline__ bf16x8 pack8(const f32x16& x, int s8) {
    v4u p; p.x = cvtpk(x[s8 + 0], x[s8 + 1]); p.y = cvtpk(x[s8 + 2], x[s8 + 3]); p.z = cvtpk(x[s8 + 4], x[s8 + 5]); p.w = cvtpk(x[s8 + 6], x[s8 + 7]);
    return __builtin_bit_cast(bf16x8, p);
}
__device__ __forceinline__ void attn_task(const bf16* base, bf16* obase, int ostride, float* lsep, int br, int ti, LAS unsigned char* wl, int lane) {
    const int r_l = lane & 31, hh = lane >> 5;
    int r, rho, a, nsub;
    if (br == 0) { r = 1; rho = 0; a = ti; nsub = 2048; } else if (br == 1) { r = 4; rho = ti >> 4; a = ti & 15; nsub = 512; } else { r = 16; rho = ti >> 2; a = ti & 3; nsub = 128; }
    const int q0 = 32 * a;
    bf16x8 qf[4];
    { const bf16* qrow = base + (size_t)(rho + r * (q0 + r_l)) * NPROJ + 8 * hh;
#pragma unroll
      for (int s = 0; s < 4; ++s) qf[s] = *(const GAS bf16x8*)(qrow + 16 * s); }
    f32x16 S[5];
    float mx = -1e30f;
#pragma unroll
    for (int kt = 0; kt < 5; ++kt) {
        const int ks0 = q0 - 64 + 32 * kt;
        if (ks0 + 32 <= 0 || ks0 >= nsub) {
#pragma unroll
            for (int reg = 0; reg < 16; ++reg) S[kt][reg] = -1e30f;
        } else {
            const int kr = min(max(ks0 + r_l, 0), nsub - 1);
            const bf16* krow = base + (size_t)(rho + r * kr) * NPROJ + 512 + 8 * hh;
            bf16x8 kf[4];
#pragma unroll
            for (int s = 0; s < 4; ++s) kf[s] = *(const GAS bf16x8*)(krow + 16 * s);
            f32x16 acc;
#pragma unroll
            for (int reg = 0; reg < 16; ++reg) acc[reg] = 0.f;
#pragma unroll
            for (int s = 0; s < 4; ++s) acc = MFMA32(kf[s], qf[s], acc);
            const int kb = ks0 + 4 * hh, dq = kb - (q0 + r_l);
#pragma unroll
            for (int reg = 0; reg < 16; ++reg) {
                const int cr = (reg & 3) + 8 * (reg >> 2); const int d = dq + cr, ks = kb + cr;
                const bool ok = (d >= -64) && (d <= 64) && (ks >= 0) && (ks < nsub);
                const float v = ok ? acc[reg] : -1e30f; acc[reg] = v; mx = fmaxf(mx, v);
            }
            S[kt] = acc;
        }
    }
    mx = fmaxf(mx, shx(mx, 32, lane));
    float l = 0.f;
#pragma unroll
    for (int kt = 0; kt < 5; ++kt)
#pragma unroll
        for (int reg = 0; reg < 16; ++reg) { const float p = __expf(S[kt][reg] - mx); S[kt][reg] = p; l += p; }
    l += shx(l, 32, lane);
    f32x16 O0, O1;
#pragma unroll
    for (int reg = 0; reg < 16; ++reg) { O0[reg] = 0.f; O1[reg] = 0.f; }
    const int rowi = lane >> 3, chv = lane & 7, blk = (lane >> 4) & 1, qq = (lane & 15) >> 2, pp = lane & 3;
#pragma unroll
    for (int kt = 0; kt < 5; ++kt) {
        const int ks0 = q0 - 64 + 32 * kt;
        if (ks0 + 32 <= 0 || ks0 >= nsub) continue;
        v4u vv[4];
#pragma unroll
        for (int i = 0; i < 4; ++i) { const int kr = min(max(ks0 + 8 * i + rowi, 0), nsub - 1); vv[i] = *(const GAS v4u*)(base + (size_t)(rho + r * kr) * NPROJ + 1024 + 8 * chv); }
#pragma unroll
        for (int i = 0; i < 4; ++i) { const int row = 8 * i + rowi; *(LAS v4u*)(wl + 128 * row + 16 * (chv ^ (((row >> 1) & 1) << 2))) = vv[i]; }
#pragma unroll
        for (int s = 0; s < 2; ++s) {
            const bf16x8 A = pack8(S[kt], 8 * s);
            const int row0 = 16 * s + 4 * hh + qq, sw = ((row0 >> 1) & 1) << 2;
#pragma unroll
            for (int c = 0; c < 2; ++c) {
                const int ch = (4 * c + 2 * blk + (pp >> 1)) ^ sw;
                const LAS unsigned char* p0 = wl + 128 * row0 + 16 * ch + 8 * (pp & 1);
                const s16x4 lo = vtr(p0), hi = vtr(p0 + 8 * 128);
                const bf16x8 B = __builtin_shufflevector(lo, hi, 0, 1, 2, 3, 4, 5, 6, 7);
                if (c == 0) O0 = MFMA32(A, B, O0); else O1 = MFMA32(A, B, O1);
            }
        }
    }
    LAS float* lb = (LAS float*)(wl + 4096);
    if (lane < 32) lb[lane] = 1.f / l;
    f32x4 li4[4];
#pragma unroll
    for (int g = 0; g < 4; ++g) li4[g] = *(const LAS f32x4*)(lb + 4 * hh + 8 * g);
#pragma unroll
    for (int reg = 0; reg < 16; ++reg) {
        const float sc = li4[reg >> 2][reg & 3]; const int qs = q0 + (reg & 3) + 8 * (reg >> 2) + 4 * hh;
        bf16* orow = obase + (size_t)(rho + r * qs) * ostride;
        orow[r_l] = (bf16)f2bf(O0[reg] * sc); orow[32 + r_l] = (bf16)f2bf(O1[reg] * sc);
    }
    if (lane < 32) lsep[(size_t)(rho + r * (q0 + lane)) * 8] = mx + __logf(l);
}


constexpr int ML_Q = 0, ML_K = 32768, ML_V = 65536, ML_VEC = 131584;
enum { MV_RT = 0, MV_A, MV_G, MV_EMT, MV_WEXP, MV_HSC, MV_GSC, MV_NIN, MV_PER };
constexpr int ML_VSET = 512 * MV_PER;
static_assert(ML_VEC + 2 * ML_VSET <= LDS_BYTES, "mLSTM LDS map");
constexpr int HM_PITCH = 132;
__device__ __forceinline__ int xsw(int row) { return ((row & 3) << 2) | ((row >> 2) & 3); }
__device__ __forceinline__ bf16x8 ml_rowfrag(const LAS unsigned char* img, int rowbase, int ks, int r_l, int hh, int xr) {
    return *(const LAS bf16x8*)(img + 256 * (rowbase + r_l) + 16 * ((2 * ks + hh) ^ xr));
}
template <bool PERM> __device__ __forceinline__ bf16x8 ml_trfrag(const LAS unsigned char* img, int rowbase, int c, int hh, int blk, int qq, int pp) {
    const int chb = 4 * c + 2 * blk + (pp >> 1);
    const int r0 = rowbase + (PERM ? 4 * hh : 8 * hh) + qq, r1 = r0 + (PERM ? 8 : 4);
    const int x0 = (qq << 2) | ((PERM ? hh : 2 * hh) & 3), x1 = (qq << 2) | ((PERM ? 2 + hh : 2 * hh + 1) & 3);
    const s16x4 lo = vtr(img + 256 * r0 + 16 * (chb ^ x0) + 8 * (pp & 1)), hi = vtr(img + 256 * r1 + 16 * (chb ^ x1) + 8 * (pp & 1));
    return __builtin_shufflevector(lo, hi, 0, 1, 2, 3, 4, 5, 6, 7);
}
__device__ __forceinline__ void ml_tile_load(v4u (&r)[4], const bf16* src, int pitch, int tid) {
    const int lrow = tid >> 4, lch = tid & 15;
#pragma unroll
    for (int k4 = 0; k4 < 4; ++k4) r[k4] = *(const GAS v4u*)(src + (size_t)(lrow + 32 * k4) * pitch + 8 * lch);
}
__device__ __forceinline__ void ml_tile_store(LAS unsigned char* img, const v4u (&r)[4], int tid) {
    const int lrow = tid >> 4, lch = tid & 15;
#pragma unroll
    for (int k4 = 0; k4 < 4; ++k4) { const int t = lrow + 32 * k4; *(LAS v4u*)(img + 256 * t + 16 * (lch ^ xsw(t))) = r[k4]; }
}
__device__ __forceinline__ void ml_chunk_vectors(LAS float* vs, const float* GATES, int b, int h, int dir, int p, float mst, int lane, float& blast_o, float& mloc_o) {
    const int tau0 = 2 * lane, i0 = dir ? 127 - tau0 : tau0, i1 = dir ? i0 - 1 : i0 + 1;
    const float* g0 = GATES + ((size_t)b * SEQ + 128 * p + i0) * 16 + (2 * dir) * 4 + h; const float* g1 = GATES + ((size_t)b * SEQ + 128 * p + i1) * 16 + (2 * dir) * 4 + h;
    const float li0 = g0[0], lf0 = log_sigmoid(g0[4]), li1 = g1[0], lf1 = log_sigmoid(g1[4]);
    float inc = lf0 + lf1;
#pragma unroll
    for (int d = 1; d < 64; d <<= 1) { const float o = shup(inc, d, lane); if (lane >= d) inc += o; }
    const float bc1 = inc, bc0 = inc - lf1;
    const float a0 = li0 - bc0, a1 = li1 - bc1;
    float im = fmaxf(a0, a1);
#pragma unroll
    for (int d = 1; d < 64; d <<= 1) { const float o = shup(im, d, lane); if (lane >= d) im = fmaxf(im, o); }
    float em = shup(im, 1, lane); if (lane == 0) em = -3.0e38f;
    const float cm0 = fmaxf(em, a0), cm1 = im;
    const float mt0 = fmaxf(bc0 + mst, bc0 + cm0), mt1 = fmaxf(bc1 + mst, bc1 + cm1);
    const float blast = rdlane(inc, 63), cref = rdlane(im, 63);
    vs[MV_RT * 128 + i0] = bc0 - mt0; vs[MV_RT * 128 + i1] = bc1 - mt1;
    vs[MV_A * 128 + i0] = a0; vs[MV_A * 128 + i1] = a1;
    vs[MV_G * 128 + i0] = __expf(bc0 + mst - mt0) * 0.08838834764831845f; vs[MV_G * 128 + i1] = __expf(bc1 + mst - mt1) * 0.08838834764831845f;
    vs[MV_EMT * 128 + i0] = __expf(-mt0); vs[MV_EMT * 128 + i1] = __expf(-mt1);
    vs[MV_WEXP * 128 + i0] = __expf(a0 - cref); vs[MV_WEXP * 128 + i1] = __expf(a1 - cref);
    blast_o = blast; mloc_o = blast + cref;
}

__device__ __forceinline__ void mlstm_pass1(LAS unsigned char* lds, const bf16* QK, const bf16* PROJ, const float* GATES, bf16* UT, float* NLOC, float* SCAL, int item, int tid) {
    const int lane = tid & 63, wave = __builtin_amdgcn_readfirstlane(tid >> 6), tt = wave >> 1, fh = wave & 1;
    const int b = item >> 6, h = (item >> 4) & 3, p = item & 15;
    const size_t row0 = (size_t)b * SEQ + 128 * p;
    { v4u tk[4], tv[4];
      ml_tile_load(tk, QK + row0 * 1024 + 512 + h * 128, 1024, tid); ml_tile_load(tv, PROJ + row0 * NPROJ + 2560 + h * 128, NPROJ, tid);
      if (wave < 2) { float bl, ml; ml_chunk_vectors((LAS float*)(lds + ML_VEC + wave * ML_VSET), GATES, b, h, wave, p, 0.f, lane, bl, ml);
          const int sc = (b * 4 + h) * 2 + wave, c = wave ? 15 - p : p; if (lane == 0) { SCAL[(sc * 16 + c) * 2] = bl; SCAL[(sc * 16 + c) * 2 + 1] = ml; } }
      ml_tile_store(lds + ML_K, tk, tid); ml_tile_store(lds + ML_V, tv, tid); }
    __syncthreads();
    f32x16 U[2][2];
#pragma unroll
    for (int d = 0; d < 2; ++d)
#pragma unroll
        for (int cl = 0; cl < 2; ++cl)
#pragma unroll
            for (int i = 0; i < 16; ++i) U[d][cl][i] = 0.f;
    float nsum0 = 0.f, nsum1 = 0.f;
#pragma unroll
    for (int ks = 0; ks < 8; ++ks) {
        const int ln_ = lndv(lane); const int hh = ln_ >> 5, blk = (ln_ >> 4) & 1, qq = (ln_ & 15) >> 2, pp = ln_ & 3;
        const bf16x8 kr = ml_trfrag<false>(lds + ML_K, 16 * ks, tt, hh, blk, qq, pp);
        const bf16x8 v0 = ml_trfrag<false>(lds + ML_V, 16 * ks, 2 * fh + 0, hh, blk, qq, pp), v1 = ml_trfrag<false>(lds + ML_V, 16 * ks, 2 * fh + 1, hh, blk, qq, pp);
        const v4u ku = __builtin_bit_cast(v4u, kr);
        const float k0 = bflo(ku.x), k1 = bfhi(ku.x), k2 = bflo(ku.y), k3 = bfhi(ku.y), k4 = bflo(ku.z), k5 = bfhi(ku.z), k6 = bflo(ku.w), k7 = bfhi(ku.w);
#pragma unroll
        for (int d = 0; d < 2; ++d) {
            const LAS float* we = (const LAS float*)(lds + ML_VEC + d * ML_VSET) + MV_WEXP * 128 + 16 * ks + 8 * hh;
            const f32x4 w0 = *(const LAS f32x4*)we, w1 = *(const LAS f32x4*)(we + 4);
            const float e0 = k0 * w0.x, e1 = k1 * w0.y, e2 = k2 * w0.z, e3 = k3 * w0.w, e4 = k4 * w1.x, e5 = k5 * w1.y, e6 = k6 * w1.z, e7 = k7 * w1.w;
            const float ns = ((e0 + e1) + (e2 + e3)) + ((e4 + e5) + (e6 + e7));
            if (d == 0) nsum0 += ns; else nsum1 += ns;
            v4u au; au.x = cvtpk(e0, e1); au.y = cvtpk(e2, e3); au.z = cvtpk(e4, e5); au.w = cvtpk(e6, e7);
            const bf16x8 A = __builtin_bit_cast(bf16x8, au);
            U[d][0] = MFMA32(A, v0, U[d][0]); U[d][1] = MFMA32(A, v1, U[d][1]);
        }
    }
    {
        const int ln_ = lndv(lane); const int r_l = ln_ & 31, hh = ln_ >> 5;
        nsum0 += shx(nsum0, 32, ln_); nsum1 += shx(nsum1, 32, ln_);
#pragma unroll
        for (int d = 0; d < 2; ++d) {
            const int sc = (b * 4 + h) * 2 + d, c = d ? 15 - p : p;
            if (fh == 0 && ln_ < 32) NLOC[(size_t)(sc * 16 + c) * 128 + 32 * tt + ln_] = d ? nsum1 : nsum0;
            bf16* ut = UT + (size_t)(sc * 16 + c) * 16384;
#pragma unroll
            for (int cl = 0; cl < 2; ++cl) {
                const int f = 32 * (2 * fh + cl) + r_l;
#pragma unroll
                for (int g = 0; g < 4; ++g) {
                    const int e = 32 * tt + 8 * g + 4 * hh;
                    const unsigned long long w = (unsigned long long)cvtpk(U[d][cl][4 * g], U[d][cl][4 * g + 1]) | ((unsigned long long)cvtpk(U[d][cl][4 * g + 2], U[d][cl][4 * g + 3]) << 32);
                    *(GAS unsigned long long*)(ut + f * 128 + e) = w;
                }
            }
        }
    }
    __syncthreads();
}

__device__ __forceinline__ void mlstm_pass2(bf16* UT, float* NLOC, const float* SCAL, float* MIN, int gt) {
    const int sc = gt >> 11, fe = gt & 2047;
    float dcy[16], wgt[16];
    { float m = 0.f;
#pragma unroll
      for (int c = 0; c < 16; ++c) { const float bl = SCAL[(sc * 16 + c) * 2], ml = SCAL[(sc * 16 + c) * 2 + 1]; const float mn = fmaxf(bl + m, ml);
          if (fe == 0) MIN[sc * 16 + c] = m;
          dcy[c] = __expf(bl + m - mn); wgt[c] = __expf(ml - mn); m = mn; } }
    v4u u[16];
    bf16* base = UT + (size_t)sc * 16 * 16384 + fe * 8;
#pragma unroll
    for (int c = 0; c < 16; ++c) u[c] = *(const GAS v4u*)(base + (size_t)c * 16384);
    float s[8];
#pragma unroll
    for (int i = 0; i < 8; ++i) s[i] = 0.f;
#pragma unroll
    for (int c = 0; c < 16; ++c) {
        v4u o; o.x = pk2(s[0], s[1]); o.y = pk2(s[2], s[3]); o.z = pk2(s[4], s[5]); o.w = pk2(s[6], s[7]);
        *(GAS v4u*)(base + (size_t)c * 16384) = o;
        const float d = dcy[c], w = wgt[c];
        s[0] = d * s[0] + w * bflo(u[c].x); s[1] = d * s[1] + w * bfhi(u[c].x); s[2] = d * s[2] + w * bflo(u[c].y); s[3] = d * s[3] + w * bfhi(u[c].y);
        s[4] = d * s[4] + w * bflo(u[c].z); s[5] = d * s[5] + w * bfhi(u[c].z); s[6] = d * s[6] + w * bflo(u[c].w); s[7] = d * s[7] + w * bfhi(u[c].w);
    }
    if (fe < 128) {
        float* nb = NLOC + (size_t)sc * 16 * 128 + fe; float ns = 0.f;
#pragma unroll
        for (int c = 0; c < 16; ++c) { const float x = nb[c * 128]; nb[c * 128] = ns; ns = dcy[c] * ns + wgt[c] * x; }
    }
}

__device__ __forceinline__ void mlstm_pass3(LAS unsigned char* lds, const bf16* QK, const bf16* PROJ, const float* GATES, const bf16* UT, const float* NLOC, const float* MIN, const float* head_g, bf16* MIX,
                                            const bf16* O1, const float* LSE, int item, int tid) {
    const int lane = tid & 63, wave = __builtin_amdgcn_readfirstlane(tid >> 6), tt = wave >> 1, fh = wave & 1;
    const int b = item >> 6, h = (item >> 4) & 3, p = item & 15;
    const size_t row0 = (size_t)b * SEQ + 128 * p;
    const int sc0 = (b * 4 + h) * 2;
    v4u cf[4], cb[4];
    {
        v4u tq[4], tk[4], tv[4];
        ml_tile_load(tq, QK + row0 * 1024 + h * 128, 1024, tid); ml_tile_load(tk, QK + row0 * 1024 + 512 + h * 128, 1024, tid); ml_tile_load(tv, PROJ + row0 * NPROJ + 2560 + h * 128, NPROJ, tid);
        if (wave < 2) { const int sc = sc0 + wave, c = wave ? 15 - p : p; float bl, ml; LAS float* vs = (LAS float*)(lds + ML_VEC + wave * ML_VSET);
            ml_chunk_vectors(vs, GATES, b, h, wave, p, MIN[sc * 16 + c], lane, bl, ml);
            vs[MV_NIN * 128 + lane] = NLOC[(size_t)(sc * 16 + c) * 128 + lane]; vs[MV_NIN * 128 + 64 + lane] = NLOC[(size_t)(sc * 16 + c) * 128 + 64 + lane]; }
        ml_tile_store(lds + ML_Q, tq, tid); ml_tile_store(lds + ML_K, tk, tid); ml_tile_store(lds + ML_V, tv, tid);
        ml_tile_load(cf, UT + (size_t)((sc0 + 0) * 16 + p) * 16384, 128, tid); ml_tile_load(cb, UT + (size_t)((sc0 + 1) * 16 + 15 - p) * 16384, 128, tid);
    }
    __syncthreads();
    const LAS float* vf = (const LAS float*)(lds + ML_VEC); const LAS float* vb = (const LAS float*)(lds + ML_VEC + ML_VSET);
    bf16x8 qf[8];
    float qn_f, qn_b;
    { const int ln_ = lndv(lane); const int r_l = ln_ & 31, hh = ln_ >> 5, t = 32 * tt + r_l, xt = xsw(t), xr = xsw(r_l);
      float s0 = 0.f, s1 = 0.f;
#pragma unroll
      for (int c8 = 0; c8 < 8; ++c8) { const int ch = 8 * hh + c8;
          const v4u qv = *(const LAS v4u*)(lds + ML_Q + 256 * t + 16 * (ch ^ xt));
          const float q0 = bflo(qv.x), q1 = bfhi(qv.x), q2 = bflo(qv.y), q3 = bfhi(qv.y), q4 = bflo(qv.z), q5 = bfhi(qv.z), q6 = bflo(qv.w), q7 = bfhi(qv.w);
          const f32x4 n0 = *(const LAS f32x4*)(vf + MV_NIN * 128 + 8 * ch), n1 = *(const LAS f32x4*)(vf + MV_NIN * 128 + 8 * ch + 4);
          const f32x4 m0 = *(const LAS f32x4*)(vb + MV_NIN * 128 + 8 * ch), m1 = *(const LAS f32x4*)(vb + MV_NIN * 128 + 8 * ch + 4);
          s0 += q0 * n0.x + q1 * n0.y + q2 * n0.z + q3 * n0.w + q4 * n1.x + q5 * n1.y + q6 * n1.z + q7 * n1.w;
          s1 += q0 * m0.x + q1 * m0.y + q2 * m0.z + q3 * m0.w + q4 * m1.x + q5 * m1.y + q6 * m1.z + q7 * m1.w; }
      qn_f = s0 + shx(s0, 32, ln_); qn_b = s1 + shx(s1, 32, ln_);
#pragma unroll
      for (int ks = 0; ks < 8; ++ks) qf[ks] = ml_rowfrag(lds + ML_Q, 32 * tt, ks, r_l, hh, xr); }
    f32x16 NF0, NF1, NB0, NB1;
#pragma unroll
    for (int i = 0; i < 16; ++i) { NF0[i] = 0.f; NF1[i] = 0.f; NB0[i] = 0.f; NB1[i] = 0.f; }
    float den_f = 0.f, den_b = 0.f;
#pragma unroll
    for (int st = 0; st < 4; ++st) {
        const int ln_ = lndv(lane); const int r_l = ln_ & 31, hh = ln_ >> 5, blk = (ln_ >> 4) & 1, qq = (ln_ & 15) >> 2, pp = ln_ & 3, xr = xsw(r_l);
        f32x16 acc;
#pragma unroll
        for (int i = 0; i < 16; ++i) acc[i] = 0.f;
#pragma unroll
        for (int ks = 0; ks < 8; ++ks) acc = MFMA32(ml_rowfrag(lds + ML_K, 32 * st, ks, r_l, hh, xr), qf[ks], acc);
        if (st <= tt) {
            const float rt = vf[MV_RT * 128 + 32 * tt + r_l];
            f32x4 av[4];
#pragma unroll
            for (int g = 0; g < 4; ++g) av[g] = *(const LAS f32x4*)(vf + MV_A * 128 + 32 * st + 4 * hh + 8 * g);
            f32x16 P;
#pragma unroll
            for (int reg = 0; reg < 16; ++reg) { const int cr = (reg & 3) + 8 * (reg >> 2) + 4 * hh; const bool ok = (st < tt) || (cr <= r_l);
                const float pv = ok ? acc[reg] * 0.08838834764831845f * __expf(rt + av[reg >> 2][reg & 3]) : 0.f; P[reg] = pv; den_f += pv; }
#pragma unroll
            for (int s2 = 0; s2 < 2; ++s2) { const bf16x8 A = pack8(P, 8 * s2);
                NF0 = MFMA32(A, ml_trfrag<true>(lds + ML_V, 32 * st + 16 * s2, 2 * fh + 0, hh, blk, qq, pp), NF0);
                NF1 = MFMA32(A, ml_trfrag<true>(lds + ML_V, 32 * st + 16 * s2, 2 * fh + 1, hh, blk, qq, pp), NF1); }
        }
        if (st >= tt) {
            const float rt = vb[MV_RT * 128 + 32 * tt + r_l];
            f32x4 av[4];
#pragma unroll
            for (int g = 0; g < 4; ++g) av[g] = *(const LAS f32x4*)(vb + MV_A * 128 + 32 * st + 4 * hh + 8 * g);
            f32x16 P;
#pragma unroll
            for (int reg = 0; reg < 16; ++reg) { const int cr = (reg & 3) + 8 * (reg >> 2) + 4 * hh; const bool ok = (st > tt) || (cr >= r_l);
                const float pv = ok ? acc[reg] * 0.08838834764831845f * __expf(rt + av[reg >> 2][reg & 3]) : 0.f; P[reg] = pv; den_b += pv; }
#pragma unroll
            for (int s2 = 0; s2 < 2; ++s2) { const bf16x8 A = pack8(P, 8 * s2);
                NB0 = MFMA32(A, ml_trfrag<true>(lds + ML_V, 32 * st + 16 * s2, 2 * fh + 0, hh, blk, qq, pp), NB0);
                NB1 = MFMA32(A, ml_trfrag<true>(lds + ML_V, 32 * st + 16 * s2, 2 * fh + 1, hh, blk, qq, pp), NB1); }
        }
    }
    f32x16 H0, H1;
    {
        const int ln_ = lndv(lane); const int r_l = ln_ & 31, hh = ln_ >> 5, t = 32 * tt + r_l;
        den_f += shx(den_f, 32, ln_); den_b += shx(den_b, 32, ln_);
        LAS float* wf = (LAS float*)(lds + ML_VEC); LAS float* wb = (LAS float*)(lds + ML_VEC + ML_VSET);
        { const float gs = wf[MV_G * 128 + t]; const float inv = 1.f / fmaxf(fabsf(den_f + gs * qn_f), wf[MV_EMT * 128 + t]); wf[MV_HSC * 128 + t] = inv; wf[MV_GSC * 128 + t] = gs * inv; }
        { const float gs = wb[MV_G * 128 + t]; const float inv = 1.f / fmaxf(fabsf(den_b + gs * qn_b), wb[MV_EMT * 128 + t]); wb[MV_HSC * 128 + t] = inv; wb[MV_GSC * 128 + t] = gs * inv; }
        f32x4 hf4[4], hb4[4];
#pragma unroll
        for (int g = 0; g < 4; ++g) { hf4[g] = *(const LAS f32x4*)(wf + MV_HSC * 128 + 32 * tt + 4 * hh + 8 * g); hb4[g] = *(const LAS f32x4*)(wb + MV_HSC * 128 + 32 * tt + 4 * hh + 8 * g); }
#pragma unroll
        for (int reg = 0; reg < 16; ++reg) { const float a_ = hf4[reg >> 2][reg & 3], b_ = hb4[reg >> 2][reg & 3]; H0[reg] = NF0[reg] * a_ + NB0[reg] * b_; H1[reg] = NF1[reg] * a_ + NB1[reg] * b_; }
    }
    __syncthreads();
    ml_tile_store(lds + ML_K, cf, tid); ml_tile_store(lds + ML_V, cb, tid);
    __syncthreads();
#pragma unroll
    for (int d = 0; d < 2; ++d) {
        const int ln_ = lndv(lane); const int r_l = ln_ & 31, hh = ln_ >> 5, xr = xsw(r_l);
        const LAS unsigned char* img = lds + (d ? ML_V : ML_K);
        f32x16 Q0, Q1;
#pragma unroll
        for (int i = 0; i < 16; ++i) { Q0[i] = 0.f; Q1[i] = 0.f; }
#pragma unroll
        for (int ks = 0; ks < 8; ++ks) {
            Q0 = MFMA32(qf[ks], ml_rowfrag(img, 32 * (2 * fh + 0), ks, r_l, hh, xr), Q0);
            Q1 = MFMA32(qf[ks], ml_rowfrag(img, 32 * (2 * fh + 1), ks, r_l, hh, xr), Q1);
        }
        const LAS float* wv = (const LAS float*)(lds + ML_VEC + d * ML_VSET);
        f32x4 g4[4];
#pragma unroll
        for (int g = 0; g < 4; ++g) g4[g] = *(const LAS f32x4*)(wv + MV_GSC * 128 + 32 * tt + 4 * hh + 8 * g);
#pragma unroll
        for (int reg = 0; reg < 16; ++reg) { const float gv = g4[reg >> 2][reg & 3]; H0[reg] += Q0[reg] * gv; H1[reg] += Q1[reg] * gv; }
    }
    __syncthreads();
    {
        const int ln_ = lndv(lane); const int r_l = ln_ & 31, hh = ln_ >> 5;
        LAS float* hm = (LAS float*)lds;
#pragma unroll
        for (int reg = 0; reg < 16; ++reg) { const int t = 32 * tt + (reg & 3) + 8 * (reg >> 2) + 4 * hh;
            hm[t * HM_PITCH + 64 * fh + r_l] = H0[reg]; hm[t * HM_PITCH + 64 * fh + 32 + r_l] = H1[reg]; }
    }
    __syncthreads();
    {
        const int tl = lndv(tid); const int t = tl >> 2, q4 = tl & 3;
        const LAS float* hr = (const LAS float*)lds + t * HM_PITCH + 32 * q4;
        f32x4 x[8]; float ss = 0.f;
#pragma unroll
        for (int i = 0; i < 8; ++i) { x[i] = *(const LAS f32x4*)(hr + 4 * i); ss += (x[i].x * x[i].x + x[i].y * x[i].y) + (x[i].z * x[i].z + x[i].w * x[i].w); }
        ss += shx(ss, 1, tl & 63); ss += shx(ss, 2, tl & 63);
        const float rs = 1.0f / sqrtf(ss * (1.f / 128.f) + EPS);
        const float* hg = head_g + h * 128 + 32 * q4;
        const bf16* mo = PROJ + (row0 + t) * NPROJ + 3072 + h * 128 + 32 * q4;
        bf16* out = MIX + (row0 + t) * 1024 + 512 + h * 128 + 32 * q4;
#pragma unroll
        for (int i = 0; i < 4; ++i) {
            const v4u mv = *(const GAS v4u*)(mo + 8 * i);
            const f32x4 g0 = *(const GAS f32x4*)(hg + 8 * i), g1 = *(const GAS f32x4*)(hg + 8 * i + 4);
            const f32x4 a_ = x[2 * i], b_ = x[2 * i + 1];
            v4u o;
            o.x = pk2(a_.x * rs * g0.x * sigmoidf_(bflo(mv.x)), a_.y * rs * g0.y * sigmoidf_(bfhi(mv.x)));
            o.y = pk2(a_.z * rs * g0.z * sigmoidf_(bflo(mv.y)), a_.w * rs * g0.w * sigmoidf_(bfhi(mv.y)));
            o.z = pk2(b_.x * rs * g1.x * sigmoidf_(bflo(mv.z)), b_.y * rs * g1.y * sigmoidf_(bfhi(mv.z)));
            o.w = pk2(b_.z * rs * g1.z * sigmoidf_(bflo(mv.w)), b_.w * rs * g1.w * sigmoidf_(bfhi(mv.w)));
            *(GAS v4u*)(out + 8 * i) = o;
        }
        {
            const size_t m = row0 + t; const int ah = 2 * h + (q4 >> 1), col = 128 * h + 32 * q4;
            const float l1 = LSE[m * 8 + ah], l2 = LSE[(size_t)M * 8 + m * 8 + ah], l3 = LSE[(size_t)2 * M * 8 + m * 8 + ah];
            const float lm = fmaxf(l1, fmaxf(l2, l3));
            float w1 = __expf(l1 - lm), w2 = __expf(l2 - lm), w3 = __expf(l3 - lm); const float wi = 1.f / (w1 + w2 + w3); w1 *= wi; w2 *= wi; w3 *= wi;
#pragma unroll
            for (int i = 0; i < 4; ++i) {
                const v4u o1 = *(const GAS v4u*)(O1 + m * AW + col + 8 * i), o2 = *(const GAS v4u*)(PROJ + m * NPROJ + 1536 + col + 8 * i), o3 = *(const GAS v4u*)(PROJ + m * NPROJ + 2048 + col + 8 * i);
                v4u w;
                w.x = pk2(w1 * bflo(o1.x) + w2 * bflo(o2.x) + w3 * bflo(o3.x), w1 * bfhi(o1.x) + w2 * bfhi(o2.x) + w3 * bfhi(o3.x));
                w.y = pk2(w1 * bflo(o1.y) + w2 * bflo(o2.y) + w3 * bflo(o3.y), w1 * bfhi(o1.y) + w2 * bfhi(o2.y) + w3 * bfhi(o3.y));
                w.z = pk2(w1 * bflo(o1.z) + w2 * bflo(o2.z) + w3 * bflo(o3.z), w1 * bfhi(o1.z) + w2 * bfhi(o2.z) + w3 * bfhi(o3.z));
                w.w = pk2(w1 * bflo(o1.w) + w2 * bflo(o2.w) + w3 * bflo(o3.w), w1 * bfhi(o1.w) + w2 * bfhi(o2.w) + w3 * bfhi(o3.w));
                *(GAS v4u*)(MIX + m * 1024 + col + 8 * i) = w;
            }
        }
    }
    __syncthreads();
}

#define PHASE_PTRS() const int tid = lndv((int)threadIdx.x), lane = tid & 63, wave = __builtin_amdgcn_readfirstlane(tid >> 6); const int gw = bid * NWAVES + wave, gt = bid * NTHR + tid; (void)lane; (void)gw; (void)gt; \
    Args a = a0; a.x = lnd(a.x); a.mix_pre_g = lnd(a.mix_pre_g); a.w_in = lnd(a.w_in); a.mconv_w = lnd(a.mconv_w); a.mconv_b = lnd(a.mconv_b); a.gate_b = lnd(a.gate_b); \
    a.head_g = lnd(a.head_g); a.w_out = lnd(a.w_out); a.mix_post_g = lnd(a.mix_post_g); a.ffn_pre_g = lnd(a.ffn_pre_g); a.w_up = lnd(a.w_up); a.fconv_w = lnd(a.fconv_w); a.fconv_b = lnd(a.fconv_b); \
    a.w_down = lnd(a.w_down); a.ffn_post_g = lnd(a.ffn_post_g); unsigned char* wsl = lnd(a.ws); \
    bf16* Win_t = (bf16*)(wsl + WS_WIN); bf16* Wout_t = (bf16*)(wsl + WS_WOUT); bf16* Wup_t = (bf16*)(wsl + WS_WUP); bf16* Wdn_t = (bf16*)(wsl + WS_WDN); \
    float* rope_c = (float*)(wsl + WS_ROPE); float* rope_s = rope_c + SEQ * 32; float* GATES = (float*)(wsl + WS_GATES); \
    bf16* HN = (bf16*)(wsl + WS_HN); bf16* PROJ = (bf16*)(wsl + WS_PROJ); bf16* HFB = (bf16*)(wsl + WS_HFB); bf16* HB16 = (bf16*)(wsl + WS_H); bf16* UB = (bf16*)(wsl + WS_U); \
    float* T = (float*)(wsl + WS_T); float* R = lnd(a.out); bf16* O1 = (bf16*)(wsl + WS_O1); float* LSE = (float*)(wsl + WS_LSE); (void)O1; (void)LSE; float* NLOC = (float*)(wsl + WS_NLOC); float* SCAL = (float*)(wsl + WS_SCAL); float* MINV = (float*)(wsl + WS_MIN); (void)NLOC; (void)SCAL; (void)MINV; \
    (void)Win_t; (void)Wout_t; (void)Wup_t; (void)Wdn_t; (void)rope_c; (void)rope_s; (void)GATES; (void)HN; (void)PROJ; (void)HFB; (void)HB16; (void)UB; (void)T; (void)R;
__global__ void __launch_bounds__(NTHR, 2) hybrid_fwd(Args a0) {
    extern __shared__ __attribute__((aligned(16))) unsigned char lds_raw[];
    LAS unsigned char* lds = (LAS unsigned char*)lds_raw;
    volatile LAS unsigned* MISC = (volatile LAS unsigned*)(lds + MISC_OFF);
    const int tid = threadIdx.x, lane = tid & 63, wave = __builtin_amdgcn_readfirstlane(tid >> 6);
    const int G = gridDim.x, bid = blockIdx.x;
    unsigned char* ws = a0.ws;
    gu32* ctl = (gu32*)(ws + WS_CTL);
    for (int u = tid; u < (LDS_BYTES - LDSCTL_OFF) / 4; u += NTHR) ((LAS unsigned*)(lds + LDSCTL_OFF))[u] = 0u;
    __syncthreads();
    XcdBarrier bar = xcd_barrier_post((unsigned*)(ctl + CW_BAR), MISC + 8);
#define GRID_BAR() xcd_barrier(bar)
    const int gw = bid * NWAVES + wave, NGW = G * NWAVES;
    const int gt = bid * NTHR + tid, NGT = G * NTHR;


    {
            PHASE_PTRS();
        LAS float* scr = (LAS float*)(lds + wave * 16384);
        constexpr int I_IN = (DM / 64) * (NPROJ / 64), I_OUT = (DM / 64) * (DM / 64), I_UP = (DM / 64) * (NUP / 64), I_DN = (DFF / 64) * (DM / 64);
        constexpr int PER_L = I_IN + I_OUT + I_UP + I_DN;
        for (int it = gw; it < DEPTH * PER_L; it += NGW) {
            const int l = it / PER_L; int r = it % PER_L;
            if (r < I_IN) { transpose_item(a.w_in + (size_t)l * DM * PROJ_COLS, DM, PROJ_COLS, NPROJ, Win_t + (size_t)l * NPROJ * DM, scr, r, lane); continue; } r -= I_IN;
            if (r < I_OUT) { transpose_item(a.w_out + (size_t)l * DM * DM, DM, DM, DM, Wout_t + (size_t)l * DM * DM, scr, r, lane); continue; } r -= I_OUT;
            if (r < I_UP) { transpose_item<true>(a.w_up + (size_t)l * DM * NUP, DM, NUP, NUP, Wup_t + (size_t)l * NUP * DM, scr, r, lane); continue; } r -= I_UP;
            transpose_item(a.w_down + (size_t)l * DFF * DM, DFF, DM, DM, Wdn_t + (size_t)l * DM * DFF, scr, r, lane);
        }
        for (int i = gt; i < SEQ * 32; i += NGT) {
            const int pos = i >> 5, fi = i & 31;
            const float inv = powf(10000.0f, -(float)(2 * fi) / 64.0f);
            const float ang = (float)pos * inv;
            const double ad = (double)ang; const double kk = rint(ad * 0.15915494309189535); const float rr = (float)(ad - kk * 6.283185307179586);
            rope_c[i] = cosf(rr); rope_s[i] = sinf(rr);
        }
        if (gt < 512) ((GAS unsigned*)(wsl + WS_ZROW))[gt] = 0u;
    }
    __syncthreads();
    for (int l = 0; l < DEPTH; ++l) {
        if (l == 0) {
            PHASE_PTRS();
            const float* w_in_l = a.w_in + (size_t)l * DM * PROJ_COLS;
            LAS float* wg = (LAS float*)lds;
            gates_fill(wg, w_in_l, tid);
            __syncthreads();
            f32x4 g[4];
#pragma unroll
            for (int j = 0; j < 4; ++j) g[j] = ((const GAS f32x4*)(a.mix_pre_g + (size_t)l * DM))[lane + 64 * j];
            for (int m = gw; m < M; m += NGW) {
                f32x4 v[4];
#pragma unroll
                for (int j = 0; j < 4; ++j) v[j] = ((const GAS f32x4*)(a.x + (size_t)m * DM))[lane + 64 * j];
                rms_row(v, g, lane);
                store_row_bf16(HN + (size_t)m * DM, v, lane);
                gates_row(v, wg, a.gate_b + l * 16, GATES + (size_t)m * 16, lane);
            }
            __syncthreads();
        }
        if (l == 0) { cg::this_grid().sync(); } else { GRID_BAR(); }

        {
            PHASE_PTRS();
            pg8::Gemm g{HN, Win_t + (size_t)l * NPROJ * DM, M, NPROJ, DM}; pg8::StaticOrder S; S.init(M, NPROJ, G, bid);
            pg8::EpiBf16<0> E{PROJ, NPROJ, nullptr, 0, 0, 1.f};
            pg8::gemm_phase<pg8::EpiBf16<0>, pg8::StaticOrder, true, true>(lds, g, S, E);
        }
        GRID_BAR();
        {
            PHASE_PTRS();
            for (int i = gt; i < M * 64; i += NGT) {
                const int m = i >> 6, hs = (i >> 2) & 15, i8 = i & 3, pos = m & (SEQ - 1);
                bf16* p1 = PROJ + (size_t)m * NPROJ + hs * 64 + 8 * i8;
                const v4u a1 = *(const GAS v4u*)p1, a2 = *(const GAS v4u*)(p1 + 32);
                const f32x4 c0 = *(const GAS f32x4*)(rope_c + pos * 32 + 8 * i8), c1 = *(const GAS f32x4*)(rope_c + pos * 32 + 8 * i8 + 4);
                const f32x4 s0 = *(const GAS f32x4*)(rope_s + pos * 32 + 8 * i8), s1 = *(const GAS f32x4*)(rope_s + pos * 32 + 8 * i8 + 4);
                const float sc = hs < 8 ? 0.125f : 1.f;
                float t1[8] = {bflo(a1.x), bfhi(a1.x), bflo(a1.y), bfhi(a1.y), bflo(a1.z), bfhi(a1.z), bflo(a1.w), bfhi(a1.w)};
                float t2[8] = {bflo(a2.x), bfhi(a2.x), bflo(a2.y), bfhi(a2.y), bflo(a2.z), bfhi(a2.z), bflo(a2.w), bfhi(a2.w)};
                float cc[8] = {c0.x, c0.y, c0.z, c0.w, c1.x, c1.y, c1.z, c1.w}, ss[8] = {s0.x, s0.y, s0.z, s0.w, s1.x, s1.y, s1.z, s1.w};
                float o1[8], o2[8];
#pragma unroll
                for (int q = 0; q < 8; ++q) { o1[q] = (t1[q] * cc[q] - t2[q] * ss[q]) * sc; o2[q] = (t2[q] * cc[q] + t1[q] * ss[q]) * sc; }
                v4u w1, w2; w1.x = pk2(o1[0], o1[1]); w1.y = pk2(o1[2], o1[3]); w1.z = pk2(o1[4], o1[5]); w1.w = pk2(o1[6], o1[7]);
                w2.x = pk2(o2[0], o2[1]); w2.y = pk2(o2[2], o2[3]); w2.z = pk2(o2[4], o2[5]); w2.w = pk2(o2[6], o2[7]);
                *(GAS v4u*)p1 = w1; *(GAS v4u*)(p1 + 32) = w2;
            }
            const float* cw = a.mconv_w + (size_t)l * 5 * 1024; const float* cb = a.mconv_b + (size_t)l * 1024;
            for (int i = gt; i < M * 128; i += NGT) {
                const int m = i >> 7, c8 = (i & 127) * 8, pos = m & (SEQ - 1);
                float acc[8];
#pragma unroll
                for (int q = 0; q < 8; ++q) acc[q] = cb[c8 + q];
#pragma unroll
                for (int j = 0; j < 5; ++j) {
                    const int pp = pos + j - 2;
                    if (pp >= 0 && pp < SEQ) {
                        const v4u xv = *(const GAS v4u*)(PROJ + (size_t)(m + j - 2) * NPROJ + 1536 + c8);
                        const f32x4 w0 = *(const GAS f32x4*)(cw + j * 1024 + c8), w1 = *(const GAS f32x4*)(cw + j * 1024 + c8 + 4);
                        acc[0] += bflo(xv.x) * w0.x; acc[1] += bfhi(xv.x) * w0.y; acc[2] += bflo(xv.y) * w0.z; acc[3] += bfhi(xv.y) * w0.w;
                        acc[4] += bflo(xv.z) * w1.x; acc[5] += bfhi(xv.z) * w1.y; acc[6] += bflo(xv.w) * w1.z; acc[7] += bfhi(xv.w) * w1.w;
                    }
                }
#pragma unroll
                for (int q = 0; q < 8; ++q) acc[q] = acc[q] * sigmoidf_(acc[q]);
                v4u o; o.x = pk2(acc[0], acc[1]); o.y = pk2(acc[2], acc[3]); o.z = pk2(acc[4], acc[5]); o.w = pk2(acc[6], acc[7]);
                *(GAS v4u*)(HN + (size_t)m * 1024 + c8) = o;
            }
        }
        GRID_BAR();
        {
            PHASE_PTRS();
            for (int item = bid; item < BATCH * MH * 16; item += G) mlstm_pass1(lds, HN, PROJ, GATES, HFB, NLOC, SCAL, item, tid);
            LAS unsigned char* wl = lds + wave * 8192;
            for (int t = bid * NWAVES + wave; t < BATCH * AH * 192; t += G * NWAVES) {
                const int bh = t / 192, rem = t % 192, br = rem >> 6, ti = rem & 63, b = bh >> 3, h = bh & 7;
                const bf16* base = PROJ + (size_t)b * SEQ * NPROJ + h * 64;
                bf16* obase; int ostride;
                if (br == 0) { obase = O1 + (size_t)b * SEQ * AW + h * 64; ostride = AW; }
                else { obase = PROJ + (size_t)b * SEQ * NPROJ + (br == 1 ? 1536 : 2048) + h * 64; ostride = NPROJ; }
                attn_task(base, obase, ostride, LSE + (size_t)br * M * 8 + (size_t)b * SEQ * 8 + h, br, ti, wl, lane);
            }
        }
        GRID_BAR();
        {
            PHASE_PTRS();
            for (int g = gt; g < 64 * 2048; g += NGT) mlstm_pass2(HFB, NLOC, SCAL, MINV, g);
        }
        GRID_BAR();
        {
            PHASE_PTRS();
            for (int item = bid; item < BATCH * MH * 16; item += G) mlstm_pass3(lds, HN, PROJ, GATES, HFB, NLOC, MINV, a.head_g + (size_t)l * MW, HN, O1, LSE, item, tid);
        }
        GRID_BAR();
        {
            PHASE_PTRS();
            pg8::Gemm g{HN, Wout_t + (size_t)l * DM * DM, M, DM, DM}; pg8::StaticOrder S; S.init(M, DM, G, bid);
            pg8::EpiF32 E{T, DM, nullptr};
            pg8::gemm_phase<pg8::EpiF32, pg8::StaticOrder, true, true>(lds, g, S, E);
        }
        GRID_BAR();
        {
            PHASE_PTRS();
            f32x4 g1[4], g2[4];
#pragma unroll
            for (int j = 0; j < 4; ++j) { g1[j] = ((const GAS f32x4*)(a.mix_post_g + (size_t)l * DM))[lane + 64 * j]; g2[j] = ((const GAS f32x4*)(a.ffn_pre_g + (size_t)l * DM))[lane + 64 * j]; }
            const float* xin = (l == 0) ? a.x : R;
            for (int m = gw; m < M; m += NGW) {
                f32x4 v[4], xb[4];
#pragma unroll
                for (int j = 0; j < 4; ++j) { v[j] = ((const GAS f32x4*)(T + (size_t)m * DM))[lane + 64 * j]; xb[j] = ((const GAS f32x4*)(xin + (size_t)m * DM))[lane + 64 * j]; }
                rms_row(v, g1, lane);
#pragma unroll
                for (int j = 0; j < 4; ++j) { v[j] = v[j] + xb[j]; ((GAS f32x4*)(R + (size_t)m * DM))[lane + 64 * j] = v[j]; }
                rms_row(v, g2, lane);
                store_row_bf16(HN + (size_t)m * DM, v, lane);
            }
        }
        GRID_BAR();
        {
            PHASE_PTRS();
            pg8::Gemm g{nullptr, Wup_t + (size_t)l * NUP * DM, 68 * 256, NUP, DM}; pg8::StaticOrder S; S.init(68 * 256, NUP, G, bid);
            pg8::EpiFfn E{HB16, a.fconv_w + (size_t)l * 3 * NUP, a.fconv_b + (size_t)l * NUP};
            pg8::AFfn AM{(const char*)(wsl + WS_ZROW), (unsigned)(WS_HN - WS_ZROW)};
            pg8::gemm_phase<pg8::EpiFfn, pg8::StaticOrder, true, true, pg8::AFfn>(lds, g, S, E, AM);
        }
        GRID_BAR();
        {
            PHASE_PTRS();
            pg8::Gemm g{HB16, Wdn_t + (size_t)l * DM * DFF, M, DM, DFF}; pg8::StaticOrder S; S.init(M, DM, G, bid);
            pg8::EpiF32 E{T, DM, nullptr};
            pg8::gemm_phase<pg8::EpiF32, pg8::StaticOrder, true, true>(lds, g, S, E);
        }
        GRID_BAR();
        {
            PHASE_PTRS();
            const bool more = (l + 1 < DEPTH);
            LAS float* wg = (LAS float*)lds;
            if (more) {
                const float* w_in_n = a.w_in + (size_t)(l + 1) * DM * PROJ_COLS;
                gates_fill(wg, w_in_n, tid);
                __syncthreads();
            }
            f32x4 g1[4], g2[4];
#pragma unroll
            for (int j = 0; j < 4; ++j) { g1[j] = ((const GAS f32x4*)(a.ffn_post_g + (size_t)l * DM))[lane + 64 * j];
                g2[j] = more ? ((const GAS f32x4*)(a.mix_pre_g + (size_t)(l + 1) * DM))[lane + 64 * j] : (f32x4){0.f, 0.f, 0.f, 0.f}; }
            for (int m = gw; m < M; m += NGW) {
                f32x4 v[4], xb[4];
#pragma unroll
                for (int j = 0; j < 4; ++j) { v[j] = ((const GAS f32x4*)(T + (size_t)m * DM))[lane + 64 * j]; xb[j] = ((const GAS f32x4*)(R + (size_t)m * DM))[lane + 64 * j]; }
                rms_row(v, g1, lane);
#pragma unroll
                for (int j = 0; j < 4; ++j) { v[j] = v[j] + xb[j]; ((GAS f32x4*)(R + (size_t)m * DM))[lane + 64 * j] = v[j]; }
                if (more) {
                    rms_row(v, g2, lane);
                    store_row_bf16(HN + (size_t)m * DM, v, lane);
                    gates_row(v, wg, a.gate_b + (l + 1) * 16, GATES + (size_t)m * 16, lane);
                }
            }
            __syncthreads();
        }
    }
}

extern "C" void kernel_launch(void* const* d_in, const int* in_sizes, int n_in, void* d_out, int out_size, void* d_ws, size_t ws_size, hipStream_t stream) {
    static int grid = 0;
    if (grid == 0) {
        if (n_in != 15 || in_sizes[0] != M * DM || out_size != M * DM || ws_size < WS_END) { fprintf(stderr, "kernel_launch: unexpected shapes n_in %d in0 %d out %d ws %zu\n", n_in, n_in > 0 ? in_sizes[0] : -1, out_size, ws_size); grid = -1; return; }
        int dev = 0, cus = 0, per_cu = 0;
        hipGetDevice(&dev); hipDeviceGetAttribute(&cus, hipDeviceAttributeMultiprocessorCount, dev);
        if (hipFuncSetAttribute((const void*)hybrid_fwd, hipFuncAttributeMaxDynamicSharedMemorySize, LDS_BYTES) != hipSuccess) { fprintf(stderr, "kernel_launch: hipFuncSetAttribute failed\n"); grid = -1; return; }
        if (hipOccupancyMaxActiveBlocksPerMultiprocessor(&per_cu, (const void*)hybrid_fwd, NTHR, LDS_BYTES) != hipSuccess || per_cu < 1) { fprintf(stderr, "kernel_launch: occupancy query says %d\n", per_cu); per_cu = 1; }
        (void)hipGetLastError();
        grid = cus;
        if (grid > 256) grid = 256;
    }
    if (grid < 0) return;
    if (hipMemsetAsync((char*)d_ws + WS_CTL, 0, CTL_ZERO_BYTES, stream) != hipSuccess) { fprintf(stderr, "kernel_launch: memset failed\n"); return; }
    Args a{};
    a.x = (const float*)d_in[0]; a.mix_pre_g = (const float*)d_in[1]; a.w_in = (const float*)d_in[2]; a.mconv_w = (const float*)d_in[3]; a.mconv_b = (const float*)d_in[4];
    a.gate_b = (const float*)d_in[5]; a.head_g = (const float*)d_in[6]; a.w_out = (const float*)d_in[7]; a.mix_post_g = (const float*)d_in[8]; a.ffn_pre_g = (const float*)d_in[9];
    a.w_up = (const float*)d_in[10]; a.fconv_w = (const float*)d_in[11]; a.fconv_b = (const float*)d_in[12]; a.w_down = (const float*)d_in[13]; a.ffn_post_g = (const float*)d_in[14];
    a.out = (float*)d_out; a.ws = (unsigned char*)d_ws;
    void* args[] = {&a};
    hipError_t e = hipLaunchCooperativeKernel((const void*)hybrid_fwd, dim3(grid), dim3(NTHR), args, LDS_BYTES, stream);
    if (e != hipSuccess) fprintf(stderr, "cooperative launch failed: %s (grid %d)\n", hipGetErrorString(e), grid);
}
```
